# Optimizing an MI355X kernel written in HIP

```python
import jax, jax.numpy as jnp
from jax import lax
import numpy as np

D_MODEL = 1024
BATCH = 2
SEQ = 8192
DEPTH = 1

RET_HEADS = 4
RET_V_DIM = D_MODEL // 2 // RET_HEADS
RET_QK_DIM = RET_V_DIM // 2
RET_CHUNK = 128
ATT_HEAD_DIM = 64
ATT_HEADS = D_MODEL // 2 // ATT_HEAD_DIM
DILATED_CONFIGS = ((128, 1), (512, 4), (2048, 16))
N_EXPERTS = 16
EC_CAPACITY_FACTOR = 2
D_FF_EXPERT = 2048

RET_QK_W = RET_HEADS * RET_QK_DIM
RET_V_W = RET_HEADS * RET_V_DIM
ATT_W = ATT_HEADS * ATT_HEAD_DIM
MIX_WIDTH = RET_V_W + ATT_W
IN_PROJ_WIDTH = 2 * RET_QK_W + 2 * RET_V_W + 3 * ATT_W
RMS_EPS = 1e-6
GN_EPS = 1e-5
MASK_VALUE = -1e30

kernel_name = "hybrid_retention_dilated_attn_ec_moe"


def rmsnorm(x, g):
    xf = x.astype(jnp.float32)
    y = xf * lax.rsqrt(jnp.mean(xf * xf, axis=-1, keepdims=True) + RMS_EPS)
    return (y * g.astype(jnp.float32)).astype(x.dtype)


def alibi_slopes(n):
    return 2.0 ** (-8.0 * (jnp.arange(n, dtype=jnp.float32) + 1.0) / n)


def retention_scan(q, k, v, log_gamma, inclusive):
    B, H, S, dk = q.shape
    dv = v.shape[-1]
    C = RET_CHUNK
    n = S // C
    qc = q.reshape(B, H, n, C, dk)
    kc = k.reshape(B, H, n, C, dk)
    vc = v.reshape(B, H, n, C, dv)
    pos = jnp.arange(C, dtype=jnp.float32)
    rel = pos[:, None] - pos[None, :]
    mask = (rel >= 0) if inclusive else (rel > 0)
    lg = log_gamma[:, None, None]
    intra_decay = jnp.where(mask[None], jnp.exp(lg * jnp.where(mask, rel, 0.0)[None]), 0.0)
    scores = jnp.einsum('bhnid,bhnjd->bhnij', qc, kc) * intra_decay[None, :, None]
    o = jnp.einsum('bhnij,bhnjv->bhniv', scores, vc)
    k_tail = kc * jnp.exp(log_gamma[:, None] * (C - 1.0 - pos))[None, :, None, :, None]
    kv = jnp.einsum('bhnjd,bhnjv->nbhdv', k_tail, vc)
    chunk_decay = jnp.exp(log_gamma * C)[None, :, None, None]

    def step(state, kv_n):
        return chunk_decay * state + kv_n, state

    _, prev = lax.scan(step, jnp.zeros((B, H, dk, dv), jnp.float32), kv)
    q_head = qc * jnp.exp(log_gamma[:, None] * (pos + 1.0))[None, :, None, :, None]
    o = o + jnp.einsum('bhnid,nbhdv->bhniv', q_head, prev)
    return o.reshape(B, H, S, dv)


def bidirectional_retention(q, k, v, logit_fwd, logit_bwd):
    qf, kf, vf = q.astype(jnp.float32), k.astype(jnp.float32), v.astype(jnp.float32)
    lg_f = jax.nn.log_sigmoid(logit_fwd.astype(jnp.float32))
    lg_b = jax.nn.log_sigmoid(logit_bwd.astype(jnp.float32))
    y_f = retention_scan(qf, kf, vf, lg_f, True)
    y_b = jnp.flip(retention_scan(jnp.flip(qf, 2), jnp.flip(kf, 2), jnp.flip(vf, 2), lg_b, False), 2)
    y = y_f + y_b
    mu = jnp.mean(y, axis=-1, keepdims=True)
    var = jnp.mean(jnp.square(y - mu), axis=-1, keepdims=True)
    return (y - mu) * lax.rsqrt(var + GN_EPS)


def banded_attention(q, k, v, half, slopes):
    N, H, L, dh = q.shape
    W = half
    nb = -(-L // W)
    pad = nb * W - L
    qb = jnp.pad(q, ((0, 0), (0, 0), (0, pad), (0, 0))).reshape(N, H, nb, W, dh)

    def windows(t):
        tb = jnp.pad(t, ((0, 0), (0, 0), (W, pad + W), (0, 0))).reshape(N, H, nb + 2, W, dh)
        return jnp.concatenate([tb[:, :, :-2], tb[:, :, 1:-1], tb[:, :, 2:]], axis=3)

    kw, vw = windows(k), windows(v)
    qpos = jnp.arange(nb * W).reshape(nb, W)
    kpos = jnp.arange(nb)[:, None] * W - W + jnp.arange(3 * W)[None, :]
    dist = jnp.abs(kpos[:, None, :] - qpos[:, :, None])
    valid = (dist <= W) & (kpos[:, None, :] >= 0) & (kpos[:, None, :] < L)
    s = jnp.einsum('nhbqd,nhbkd->nhbqk', qb, kw).astype(jnp.float32) * (dh ** -0.5)
    s = s - slopes[None, :, None, None, None] * dist.astype(jnp.float32)[None, None]
    s = jnp.where(valid[None, None], s, MASK_VALUE)
    lse = jax.nn.logsumexp(s, axis=-1)
    p = jnp.exp(s - lse[..., None])
    o = jnp.einsum('nhbqk,nhbkd->nhbqd', p, vw.astype(jnp.float32))
    return o.reshape(N, H, nb * W, dh)[:, :, :L], lse.reshape(N, H, nb * W)[:, :, :L]


def dilated_attention(q, k, v, window, dilation, slopes):
    B, H, S, dh = q.shape
    L = S // dilation

    def to_sub(t):
        return t.reshape(B, H, L, dilation, dh).transpose(0, 3, 1, 2, 4).reshape(B * dilation, H, L, dh)

    o, lse = banded_attention(to_sub(q), to_sub(k), to_sub(v), window // (2 * dilation), slopes * dilation)
    o = o.reshape(B, dilation, H, L, dh).transpose(0, 2, 3, 1, 4).reshape(B, H, S, dh)
    lse = lse.reshape(B, dilation, H, L).transpose(0, 2, 3, 1).reshape(B, H, S)
    return o, lse


def expert_choice_moe(h, w_router, w_gate, w_up, w_down):
    B, S, D = h.shape
    E = w_router.shape[-1]
    cap = EC_CAPACITY_FACTOR * S // E
    affinity = jax.nn.softmax((h @ w_router).astype(jnp.float32), axis=-1)
    gates, idx = lax.top_k(jnp.swapaxes(affinity, 1, 2), cap)
    flat_idx = idx.reshape(B, E * cap)
    b_idx = jnp.arange(B)[:, None]
    xe = h[b_idx, flat_idx].reshape(B, E, cap, D)
    a = jnp.einsum('becd,edf->becf', xe, w_gate)
    u = jnp.einsum('becd,edf->becf', xe, w_up)
    ye = jnp.einsum('becf,efd->becd', jax.nn.silu(a) * u, w_down)
    ye = ye * gates[..., None].astype(ye.dtype)
    out = jnp.zeros_like(h).at[b_idx, flat_idx].add(ye.reshape(B, E * cap, D).astype(h.dtype))
    return out


def setup_inputs(seed: int = 0) -> dict:
    key = jax.random.key(seed)
    ks = jax.random.split(key, 20)
    f32 = jnp.float32
    D, F, E = D_MODEL, D_FF_EXPERT, N_EXPERTS
    nrm = lambda k, shape, s: jax.random.normal(k, shape, f32) * s
    base_logit = jnp.log(2.0 ** (5.0 + jnp.arange(RET_HEADS, dtype=f32)) - 1.0)
    return {
        "x": nrm(ks[0], (BATCH, SEQ, D), 1.0),
        "c": nrm(ks[1], (BATCH, D), 1.0),
        "w_ada": nrm(ks[2], (DEPTH, D, 6 * D), 0.5 * D ** -0.5),
        "b_ada": nrm(ks[3], (DEPTH, 6 * D), 0.01),
        "g_pre_mix": 1.0 + nrm(ks[4], (DEPTH, D), 0.01),
        "g_post_mix": 1.0 + nrm(ks[5], (DEPTH, D), 0.01),
        "g_pre_ffn": 1.0 + nrm(ks[6], (DEPTH, D), 0.01),
        "g_post_ffn": 1.0 + nrm(ks[7], (DEPTH, D), 0.01),
        "w_in": nrm(ks[8], (DEPTH, D, IN_PROJ_WIDTH), D ** -0.5),
        "ret_decay_fwd": base_logit[None] + nrm(ks[9], (DEPTH, RET_HEADS), 0.1),
        "ret_decay_bwd": base_logit[None] + nrm(ks[10], (DEPTH, RET_HEADS), 0.1),
        "w_out": nrm(ks[11], (DEPTH, MIX_WIDTH, D), MIX_WIDTH ** -0.5),
        "w_router": nrm(ks[12], (DEPTH, D, E), D ** -0.5),
        "w_gate_e": nrm(ks[13], (DEPTH, E, D, F), D ** -0.5),
        "w_up_e": nrm(ks[14], (DEPTH, E, D, F), D ** -0.5),
        "w_down_e": nrm(ks[15], (DEPTH, E, F, D), F ** -0.5),
    }


def reference(x, c, w_ada, b_ada, g_pre_mix, g_post_mix, g_pre_ffn, g_post_ffn, w_in,
              ret_decay_fwd, ret_decay_bwd, w_out, w_router, w_gate_e, w_up_e, w_down_e):
    B, S, D = x.shape
    slopes = alibi_slopes(ATT_HEADS)
    split_at = np.cumsum([RET_QK_W, RET_QK_W, RET_V_W, RET_V_W, ATT_W, ATT_W]).tolist()

    def heads(t, n_heads):
        return t.reshape(B, S, n_heads, -1).transpose(0, 2, 1, 3)

    for l in range(DEPTH):
        mod = jax.nn.silu(c) @ w_ada[l] + b_ada[l]
        shift_m, scale_m, gate_m, shift_f, scale_f, gate_f = [m[:, None, :] for m in jnp.split(mod, 6, axis=-1)]

        h = rmsnorm(x, g_pre_mix[l]) * (1.0 + scale_m) + shift_m
        proj = h @ w_in[l]
        rq, rk, rv, rg, aq, ak, av = jnp.split(proj, split_at, axis=-1)

        y_ret = bidirectional_retention(heads(rq, RET_HEADS), heads(rk, RET_HEADS) * (RET_QK_DIM ** -0.5),
                                        heads(rv, RET_HEADS), ret_decay_fwd[l], ret_decay_bwd[l])
        y_ret = y_ret.transpose(0, 2, 1, 3).reshape(B, S, RET_V_W).astype(x.dtype)
        y_ret = jax.nn.silu(rg) * y_ret

        qh, kh, vh = heads(aq, ATT_HEADS), heads(ak, ATT_HEADS), heads(av, ATT_HEADS)
        results = [dilated_attention(qh, kh, vh, w, d, slopes) for (w, d) in DILATED_CONFIGS]
        outs = jnp.stack([r[0] for r in results])
        lses = jnp.stack([r[1] for r in results])
        mix_w = jax.nn.softmax(lses, axis=0)
        y_att = jnp.sum(mix_w[..., None] * outs, axis=0)
        y_att = y_att.transpose(0, 2, 1, 3).reshape(B, S, ATT_W).astype(x.dtype)

        mixed = jnp.concatenate([y_ret, y_att], axis=-1) @ w_out[l]
        x = x + gate_m * rmsnorm(mixed, g_post_mix[l])

        h = rmsnorm(x, g_pre_ffn[l]) * (1.0 + scale_f) + shift_f
        moe = expert_choice_moe(h, w_router[l], w_gate_e[l], w_up_e[l], w_down_e[l])
        x = x + gate_f * rmsnorm(moe, g_post_ffn[l])
    return x
```

```cpp
#include <hip/hip_runtime.h>
#include <cstdio>
#include <cstdint>
namespace pg8 {
#define PG8_LAS __attribute__((address_space(3)))
typedef unsigned short bf16_t;
typedef short bf16x8 __attribute__((ext_vector_type(8)));
typedef float f32x4 __attribute__((ext_vector_type(4)));
typedef unsigned u32x4 __attribute__((ext_vector_type(4)));
constexpr int BM = 256, BK = 64, HALF = 128, HTB = HALF * BK * 2  , STAGE_BYTES = 8 * HTB, NXCD = 8, WGM = 8;

__host__ __device__ __forceinline__ int lds_byte(int r, int c) { const int st = (r >> 4) * 2 + (c >> 5), rr = r & 15, cc = c & 31, ob = rr * 64 + cc * 2; return st * 1024 + (ob ^ (((ob >> 9) & 1) << 5)); }
__host__ __device__ __forceinline__ void stage_rc(int b, int& R, int& C) { const int st = b / 1024, sb = b % 1024, swz = sb ^ (((sb >> 9) & 1) << 5); R = (st >> 1) * 16 + swz / 64; C = (st & 1) * 32 + (swz % 64) / 2; }
__host__ __device__ __forceinline__ int perm32(int rho) { const int n = rho >> 4, i = rho & 15; return 8 * (i >> 2) + 4 * n + (i & 3); }

struct Unit { int pm, pn; };
struct Gemm { const bf16_t* A; const bf16_t* Bt; int M, N, K; };

struct StaticOrder {
    int nM, nN, nwg, G, c;
    __host__ __device__ void init(int M, int N, int G_, int c_) { nM = M / BM; nN = N / BM; nwg = nM * nN; G = G_; c = c_; }
    __host__ __device__ bool next(int i, Unit& u) const {
        const long L = (long)i * G + c; if (L >= nwg) return false;
        int wgid = (int)L; { const int q = nwg / NXCD, r = nwg % NXCD, xcd = wgid % NXCD, off = wgid / NXCD; wgid = (xcd < r ? xcd * (q + 1) : r * (q + 1) + (xcd - r) * q) + off; }
        const int nig = WGM * nN, gid = wgid / nig, fm = gid * WGM, gsz = (nM - fm) < WGM ? (nM - fm) : WGM;
        u.pm = fm + ((wgid % nig) % gsz); u.pn = (wgid % nig) / gsz; return true;
    }
    __device__ __forceinline__ void a_ready(const Unit&) const {}
    __device__ __forceinline__ void done(const Unit&) const {}
};

__device__ __forceinline__ unsigned cvt_pk_bf16(float lo, float hi) { unsigned r; asm volatile("v_cvt_pk_bf16_f32 %0, %1, %2" : "=v"(r) : "v"(lo), "v"(hi)); return r; }
typedef float f32x2 __attribute__((ext_vector_type(2)));
typedef unsigned u32x2 __attribute__((ext_vector_type(2)));
constexpr float LOG2E_F = 1.4426950408889634f;
struct EpiF32 {
    static constexpr bool PERM = false, AFTER_DRAIN = false;
    float* C; int ldc;
    __device__ __forceinline__ void operator()(const f32x4 (&acc)[2][2][4][2], const Unit& u, int wr, int wc, int fr, int fq) const {
        const int row0 = u.pm * BM + wr * 64 + fr, col0 = u.pn * BM + wc * 32 + 4 * fq;
#pragma unroll
        for (int ai = 0; ai < 2; ++ai)
#pragma unroll
            for (int m = 0; m < 4; ++m) { float* rowp = C + (size_t)(row0 + ai * HALF + m * 16) * ldc + col0;
#pragma unroll
                for (int bj = 0; bj < 2; ++bj)
#pragma unroll
                    for (int n = 0; n < 2; ++n) *(f32x4*)(rowp + bj * HALF + n * 16) = acc[ai][bj][m][n]; }
    }
};
struct EpiBf16S {
    static constexpr bool PERM = true, AFTER_DRAIN = false;
    bf16_t* O; int ldc; int pn_mask; float s_rk, s_aq; int proj;
    __device__ __forceinline__ void operator()(const f32x4 (&acc)[2][2][4][2], const Unit& u, int wr, int wc, int fr, int fq) const {
        const int pn = u.pn & pn_mask;
        const int row0 = u.pm * BM + wr * 64 + fr, col0 = pn * BM + wc * 32 + 8 * fq;
        float sc = 1.f; if (proj) sc = (pn == 1) ? s_rk : ((pn == 6 || pn == 7) ? s_aq : 1.f);
#pragma unroll
        for (int ai = 0; ai < 2; ++ai)
#pragma unroll
            for (int m = 0; m < 4; ++m) { bf16_t* rowp = O + (size_t)(row0 + ai * HALF + m * 16) * ldc + col0;
#pragma unroll
                for (int bj = 0; bj < 2; ++bj) { const f32x4 v0 = acc[ai][bj][m][0] * sc, v1 = acc[ai][bj][m][1] * sc;
                    u32x4 w; w.x = cvt_pk_bf16(v0[0], v0[1]); w.y = cvt_pk_bf16(v0[2], v0[3]); w.z = cvt_pk_bf16(v1[0], v1[1]); w.w = cvt_pk_bf16(v1[2], v1[3]);
                    *(u32x4*)(rowp + bj * HALF) = w; } }
    }
};
struct EpiSwiGLU {
    static constexpr bool PERM = true, AFTER_DRAIN = false;
    bf16_t* O; int ldc;
    __device__ __forceinline__ float act(float g, float up) const { return g * up * __builtin_amdgcn_rcpf(1.f + __builtin_amdgcn_exp2f(-g * LOG2E_F)); }
    __device__ __forceinline__ void operator()(const f32x4 (&acc)[2][2][4][2], const Unit& u, int wr, int wc, int fr, int fq) const {
        const int row0 = u.pm * BM + wr * 64 + fr, col0 = (u.pn & 15) * HALF + wc * 32 + 8 * fq;
#pragma unroll
        for (int ai = 0; ai < 2; ++ai)
#pragma unroll
            for (int m = 0; m < 4; ++m) { bf16_t* rowp = O + (size_t)(row0 + ai * HALF + m * 16) * ldc + col0;
                const f32x4 g0 = acc[ai][0][m][0], g1 = acc[ai][0][m][1], u0 = acc[ai][1][m][0], u1 = acc[ai][1][m][1];
                u32x4 w; w.x = cvt_pk_bf16(act(g0[0], u0[0]), act(g0[1], u0[1])); w.y = cvt_pk_bf16(act(g0[2], u0[2]), act(g0[3], u0[3]));
                w.z = cvt_pk_bf16(act(g1[0], u1[0]), act(g1[1], u1[1])); w.w = cvt_pk_bf16(act(g1[2], u1[2]), act(g1[3], u1[3]));
                *(u32x4*)rowp = w; }
    }
};
struct MoeOrder {
    int ntile, G, vcu;
    __device__ __forceinline__ bool next(int i, Unit& u) const {
        const int total = 16 * 8 * ntile; int L;
        if ((G & 7) == 0) { const int g8 = G >> 3, x = vcu / g8, c = vcu % g8, share = total >> 3, l = i * g8 + c; if (l >= share) return false; L = x * share + l; }
        else { L = i * G + vcu; if (L >= total) return false; }
        const int e = L / (8 * ntile), rem = L % (8 * ntile);
        u.pm = e * 8 + (rem & 7); u.pn = e * ntile + (rem >> 3); return true;
    }
    __device__ __forceinline__ void a_ready(const Unit&) const {}
    __device__ __forceinline__ void done(const Unit&) const {}
};
template <class Epi, class Sched, bool ALIGN_EPI = false, bool SP2 = false>
__device__ __forceinline__ void gemm_phase(PG8_LAS unsigned char* lds, const Gemm g, const Sched& S, const Epi& E) {
    const int tid = threadIdx.x, wid = __builtin_amdgcn_readfirstlane(tid >> 6), lane = tid & 63, wr = wid >> 2, wc = wid & 3, fr = lane & 15, fq = lane >> 4;
    const int K = g.K, nt = K / BK;
    unsigned voffA[2], voffB[2];
#pragma unroll
    for (int i = 0; i < 2; ++i) { int R, C; stage_rc(tid * 16 + i * 8192, R, C); const int Rb = Epi::PERM ? ((R & ~31) + perm32(R & 31)) : R;
        voffA[i] = (unsigned)(R * K + C) * 2u; voffB[i] = (unsigned)(Rb * K + C) * 2u; }
    const size_t kstep = (size_t)(BK * 2);
    const size_t hstep = (size_t)HALF * K * 2;
    const size_t tstep = 2 * hstep;
    const unsigned ldsw = (unsigned)wid * 1024u;
    const int aoff = lds_byte(wr * 64 + fr, fq * 8), boff = lds_byte(wc * 32 + fr, fq * 8);
#define PG8_SA(b, h) (((b) * 2 + (h)) * HTB)
#define PG8_SB(b, h) ((4 + (b) * 2 + (h)) * HTB)
#define PG8_STAGE(bufoff, gbase, voff) do { _Pragma("unroll") for (int _i = 0; _i < 2; ++_i) \
        __builtin_amdgcn_global_load_lds((const unsigned*)((const char*)(gbase) + (voff)[_i]), (PG8_LAS unsigned*)(lds + (bufoff) + ldsw + _i * 8192), 16, 0, 0); } while (0)
#define PG8_LDA(dst, b, h) do { _Pragma("unroll") for (int m = 0; m < 4; ++m) _Pragma("unroll") for (int k = 0; k < 2; ++k) dst[m][k] = *(const PG8_LAS bf16x8*)(lds + PG8_SA(b, h) + aoff + m * 2048 + k * 1024); } while (0)
#define PG8_LDB(dst, b, h) do { _Pragma("unroll") for (int n = 0; n < 2; ++n) _Pragma("unroll") for (int k = 0; k < 2; ++k) dst[n][k] = *(const PG8_LAS bf16x8*)(lds + PG8_SB(b, h) + boff + n * 2048 + k * 1024); } while (0)
#define PG8_MMA(ai, bj, At, Bt) do { __builtin_amdgcn_s_setprio(1); _Pragma("unroll") for (int m = 0; m < 4; ++m) _Pragma("unroll") for (int n = 0; n < 2; ++n) _Pragma("unroll") for (int k = 0; k < 2; ++k) \
        acc[ai][bj][m][n] = __builtin_amdgcn_mfma_f32_16x16x32_bf16(Bt[n][k], At[m][k], acc[ai][bj][m][n], 0, 0, 0); __builtin_amdgcn_s_setprio(0); } while (0)
#define PG8_WAIT_V(n) asm volatile("s_waitcnt vmcnt(" #n ")" ::: "memory")
#define PG8_WAIT_L(n) asm volatile("s_waitcnt lgkmcnt(" #n ")" ::: "memory")
#define PG8_BAR __builtin_amdgcn_s_barrier()
#define PG8_SCHED __builtin_amdgcn_sched_barrier(0)
    Unit cur, nxt; int ui = 0;
    if (!S.next(0, cur)) return;
    f32x4 acc[2][2][4][2];
#pragma unroll
    for (int a = 0; a < 2; ++a)
#pragma unroll
        for (int b = 0; b < 2; ++b)
#pragma unroll
            for (int m = 0; m < 4; ++m)
#pragma unroll
                for (int n = 0; n < 2; ++n) acc[a][b][m][n] = (f32x4){0.f, 0.f, 0.f, 0.f};
    bf16x8 At[4][2], B0[2][2], B1[2][2];
    const char* cA = (const char*)g.A + (size_t)cur.pm * tstep; const char* cB = (const char*)g.Bt + (size_t)cur.pn * tstep;
    S.a_ready(cur);
    if constexpr (SP2) {
        PG8_STAGE(PG8_SB(0, 0), cB, voffB); PG8_STAGE(PG8_SB(0, 1), cB + hstep, voffB); PG8_STAGE(PG8_SA(0, 0), cA, voffA); PG8_STAGE(PG8_SA(0, 1), cA + hstep, voffA);
        if (wr == 1) PG8_BAR;
        PG8_WAIT_V(2); PG8_BAR;
        PG8_STAGE(PG8_SB(1, 0), cB + kstep, voffB); PG8_STAGE(PG8_SA(1, 0), cA + kstep, voffA); PG8_STAGE(PG8_SB(1, 1), cB + hstep + kstep, voffB);
        PG8_WAIT_V(6); PG8_BAR;
    } else {
        PG8_STAGE(PG8_SB(0, 0), cB, voffB); PG8_STAGE(PG8_SA(0, 0), cA, voffA); PG8_STAGE(PG8_SB(0, 1), cB + hstep, voffB); PG8_STAGE(PG8_SA(0, 1), cA + hstep, voffA);
        if (wr == 1) PG8_BAR;
        PG8_WAIT_V(4); PG8_BAR;
        PG8_STAGE(PG8_SB(1, 0), cB + kstep, voffB); PG8_STAGE(PG8_SA(1, 0), cA + kstep, voffA); PG8_STAGE(PG8_SB(1, 1), cB + hstep + kstep, voffB);
        PG8_WAIT_V(6); PG8_BAR;
    }
    for (;;) {
        const bool has_next = S.next(ui + 1, nxt);
        const char* nA = has_next ? (const char*)g.A + (size_t)nxt.pm * tstep : cA; const char* nB = has_next ? (const char*)g.Bt + (size_t)nxt.pn * tstep : cB;
        for (int t = 0; t < nt; t += 2) {
            const bool last = (t == nt - 2);
            const char* a1 = cA + (size_t)(t + 1) * kstep;
            const char* a2 = last ? nA : cA + (size_t)(t + 2) * kstep; const char* b2 = last ? nB : cB + (size_t)(t + 2) * kstep;
            const char* a3 = a2 + kstep; const char* b3 = b2 + kstep;
            if (last && has_next) S.a_ready(nxt);
            if constexpr (SP2) {
            PG8_LDB(B0, 0, 0); PG8_LDB(B1, 0, 1); PG8_SCHED; PG8_LDA(At, 0, 0); PG8_STAGE(PG8_SA(1, 1), a1 + hstep, voffA);
            PG8_WAIT_V(8); PG8_WAIT_L(0); PG8_BAR; PG8_MMA(0, 0, At, B0); PG8_MMA(0, 1, At, B1); PG8_BAR; PG8_SCHED;
            PG8_LDA(At, 0, 1); PG8_STAGE(PG8_SB(0, 0), b2, voffB); PG8_STAGE(PG8_SB(0, 1), b2 + hstep, voffB); PG8_STAGE(PG8_SA(0, 0), a2, voffA);
            PG8_WAIT_V(8); PG8_WAIT_L(0); PG8_BAR; PG8_MMA(1, 0, At, B0); PG8_MMA(1, 1, At, B1); PG8_BAR; PG8_SCHED;
            PG8_LDB(B0, 1, 0); PG8_LDB(B1, 1, 1); PG8_SCHED; PG8_LDA(At, 1, 0); PG8_STAGE(PG8_SA(0, 1), a2 + hstep, voffA);
            PG8_WAIT_V(8); PG8_WAIT_L(0); PG8_BAR; PG8_MMA(0, 0, At, B0); PG8_MMA(0, 1, At, B1); PG8_BAR; PG8_SCHED;
            PG8_LDA(At, 1, 1); PG8_STAGE(PG8_SB(1, 0), b3, voffB); PG8_STAGE(PG8_SB(1, 1), b3 + hstep, voffB); PG8_STAGE(PG8_SA(1, 0), a3, voffA);
            PG8_WAIT_V(8); PG8_WAIT_L(0); PG8_BAR; PG8_MMA(1, 0, At, B0); PG8_MMA(1, 1, At, B1); PG8_BAR; PG8_SCHED;
            } else {
            PG8_LDB(B0, 0, 0); PG8_SCHED; PG8_LDA(At, 0, 0); PG8_STAGE(PG8_SA(1, 1), a1 + hstep, voffA);
            PG8_WAIT_L(8); PG8_BAR; PG8_WAIT_L(0); PG8_MMA(0, 0, At, B0); PG8_BAR; PG8_SCHED;
            PG8_LDB(B1, 0, 1); PG8_STAGE(PG8_SB(0, 0), b2, voffB);
            PG8_BAR; PG8_WAIT_L(0); PG8_MMA(0, 1, At, B1); PG8_BAR;
            PG8_LDA(At, 0, 1); PG8_STAGE(PG8_SA(0, 0), a2, voffA);
            PG8_BAR; PG8_WAIT_L(0); PG8_MMA(1, 0, At, B0); PG8_BAR; PG8_SCHED;
            PG8_STAGE(PG8_SB(0, 1), b2 + hstep, voffB);
            PG8_WAIT_V(6); PG8_BAR; PG8_MMA(1, 1, At, B1); PG8_BAR;
            PG8_LDB(B0, 1, 0); PG8_SCHED; PG8_LDA(At, 1, 0); PG8_STAGE(PG8_SA(0, 1), a2 + hstep, voffA);
            PG8_WAIT_L(8); PG8_BAR; PG8_WAIT_L(0); PG8_MMA(0, 0, At, B0); PG8_BAR; PG8_SCHED;
            PG8_LDB(B1, 1, 1); PG8_STAGE(PG8_SB(1, 0), b3, voffB);
            PG8_BAR; PG8_WAIT_L(0); PG8_MMA(0, 1, At, B1); PG8_BAR;
            PG8_LDA(At, 1, 1); PG8_STAGE(PG8_SA(1, 0), a3, voffA);
            PG8_BAR; PG8_WAIT_L(0); PG8_MMA(1, 0, At, B0); PG8_BAR; PG8_SCHED;
            PG8_STAGE(PG8_SB(1, 1), b3 + hstep, voffB);
            PG8_WAIT_V(6); PG8_BAR; PG8_MMA(1, 1, At, B1); PG8_BAR;
            }
        }
        if constexpr (ALIGN_EPI) { if (wr == 0) PG8_BAR; }
        if constexpr (!Epi::AFTER_DRAIN) { E(acc, cur, wr, wc, fr, fq); S.done(cur); }
        if (!has_next) break;
#pragma unroll
        for (int a = 0; a < 2; ++a)
#pragma unroll
            for (int b = 0; b < 2; ++b)
#pragma unroll
                for (int m = 0; m < 4; ++m)
#pragma unroll
                    for (int n = 0; n < 2; ++n) acc[a][b][m][n] = (f32x4){0.f, 0.f, 0.f, 0.f};
        cur = nxt; cA = nA; cB = nB; ++ui;
        if constexpr (ALIGN_EPI) { if (wr == 1) PG8_BAR; }
    }
    PG8_WAIT_V(0);
    if constexpr (!ALIGN_EPI) { if (wr == 0) PG8_BAR; }
    PG8_BAR;
    if constexpr (Epi::AFTER_DRAIN) { E.fused(acc, cur, wr, wc, fr, fq, lds, wid, lane); S.done(cur); }
#undef PG8_SA
#undef PG8_SB
#undef PG8_STAGE
#undef PG8_LDA
#undef PG8_LDB
#undef PG8_MMA
#undef PG8_WAIT_V
#undef PG8_WAIT_L
#undef PG8_BAR
#undef PG8_SCHED
}
}
constexpr int BATCH = 2, SEQ = 8192, DM = 1024, MTOK = BATCH * SEQ;
constexpr int RH = 4, RQK = 64, RV = 128, CHK = 128, NCH = SEQ / CHK;
constexpr int AH = 8, AD = 64;
constexpr int NE = 16, CAP = 1024, FF = 2048, NSLOT = NE * BATCH * CAP;
constexpr int NPROJ = 3072;
constexpr int C_RQ = 0, C_RK = 256, C_RV = 512, C_RG = 1024, C_AQ = 1536, C_AK = 2048, C_AV = 2560;
constexpr float RMS_EPS = 1e-6f, GN_EPS = 1e-5f;
constexpr float LOG2E = 1.4426950408889634f;
constexpr int NWAVES = 8;
#ifndef MK_ONE_LAUNCH
#define MK_ONE_LAUNCH 0
#endif
constexpr int NPHASE = 13;
constexpr size_t MiB = 1u << 20;
constexpr size_t WS_CTL = 0, CTL_ZERO_BYTES = 1 * MiB;
constexpr size_t WS_MOD = 1 * MiB;
constexpr size_t WS_AFF = 2 * MiB;
constexpr size_t WS_TOK = 3 * MiB;
constexpr size_t WS_GATEV = 3 * MiB + 128 * 1024;
constexpr size_t WS_SLOTOF = 3 * MiB + 256 * 1024;
constexpr size_t WS_LSE = 5 * MiB;
constexpr size_t WS_WIN = 8 * MiB;
constexpr size_t WS_WOUT = 14 * MiB;
constexpr size_t WS_WGU = 16 * MiB;
constexpr size_t WS_WDN = 144 * MiB;
constexpr size_t WS_XN = 208 * MiB;
constexpr size_t WS_R = 240 * MiB;
constexpr size_t WS_PROJ = WS_R;
constexpr size_t WS_KV = WS_R + 96 * MiB;
constexpr size_t WS_PREV = WS_R + 128 * MiB;
constexpr size_t WS_ATTO = WS_R + 144 * MiB;
constexpr size_t WS_Y = WS_R + 192 * MiB;
constexpr size_t WS_MIXED = WS_R;
constexpr size_t WS_XE = WS_R + 64 * MiB;
constexpr size_t WS_HH = WS_R + 128 * MiB;
constexpr size_t WS_YE = WS_R;
constexpr size_t WS_END = WS_R + 256 * MiB;
constexpr int CW_BAR = 4096;
constexpr int RING_BYTES = 131072;
constexpr int LDSCTL_OFF = RING_BYTES, MISC_OFF = LDSCTL_OFF + 320;
constexpr int LDS_BYTES = 147456;

#define GAS __attribute__((address_space(1)))
#define LAS __attribute__((address_space(3)))
typedef unsigned short bf16;
typedef unsigned v4u __attribute__((ext_vector_type(4)));
typedef unsigned v2u __attribute__((ext_vector_type(2)));
typedef float f32x4 __attribute__((ext_vector_type(4)));
typedef float f32x16 __attribute__((ext_vector_type(16)));
typedef short bf16x8 __attribute__((ext_vector_type(8)));
typedef short s16x4 __attribute__((ext_vector_type(4)));
typedef GAS unsigned gu32;
#define RLX_AGENT __ATOMIC_RELAXED, __HIP_MEMORY_SCOPE_AGENT
#define LDS_WAIT() asm volatile("s_waitcnt lgkmcnt(0)" ::: "memory")
typedef float f32x2_t __attribute__((ext_vector_type(2))); typedef __bf16 bf16x2_t __attribute__((ext_vector_type(2)));
__device__ __forceinline__ unsigned pk2(float lo, float hi) { f32x2_t v = {lo, hi}; bf16x2_t b = __builtin_convertvector(v, bf16x2_t); return __builtin_bit_cast(unsigned, b); }
__device__ __forceinline__ float bflo(unsigned w) { return __uint_as_float(w << 16); }
__device__ __forceinline__ float bfhi(unsigned w) { return __uint_as_float(w & 0xffff0000u); }
__device__ __forceinline__ float ex2(float x) { return __builtin_amdgcn_exp2f(x); }
__device__ __forceinline__ int crow(int r, int hi) { return (r & 3) + 8 * (r >> 2) + 4 * hi; }
__device__ __forceinline__ s16x4 vtr(const LAS unsigned char* p) { typedef short v4i16_t __attribute__((ext_vector_type(4))); return __builtin_bit_cast(s16x4, __builtin_amdgcn_ds_read_tr16_b64_v4i16((LAS v4i16_t*)p)); }
__device__ __forceinline__ bf16x8 cat8(s16x4 a, s16x4 b) { return (bf16x8){a[0], a[1], a[2], a[3], b[0], b[1], b[2], b[3]}; }
__device__ __forceinline__ float wave_sum(float v) {
#pragma unroll
    for (int o = 1; o < 64; o <<= 1) v += __shfl_xor(v, o);
    return v;
}
#define XB_TMO      128
#define XB_XCNT(j)  (256  + 64 * (j))
#define XB_XSUB(j)  (1280 + 64 * (j))
#define XB_XGEN(j)  (2304 + 64 * (j))
#define XB_TOP      3328
#define XB_TOPGEN   3392
#define XCD_BAR_WORDS 3456
#define XB_SPIN_CAP (1u << 18)

__device__ __forceinline__ unsigned xb_ld(unsigned* p)              { return __hip_atomic_load(p, __ATOMIC_RELAXED, __HIP_MEMORY_SCOPE_AGENT); }
__device__ __forceinline__ unsigned xb_add(unsigned* p, unsigned v) { return __hip_atomic_fetch_add(p, v, __ATOMIC_RELAXED, __HIP_MEMORY_SCOPE_AGENT); }
__device__ __forceinline__ unsigned xb_xcc_id() { return (unsigned)__builtin_amdgcn_s_getreg((3 << 11) | 20) & 0xFu; }
#define XB_SPIN(cond, bar) do { unsigned _sp = 0; while (cond) { __builtin_amdgcn_s_sleep(1); \
    if ((++_sp & 255u) == 0u) { if (xb_ld(&(bar)[XB_TMO])) break; if (_sp > XB_SPIN_CAP) { atomicAdd(&(bar)[XB_TMO], 1u); break; } } } } while (0)

struct XcdBarrier {
    unsigned* bar; unsigned x;
    volatile LAS unsigned* st;
};

__device__ __forceinline__ XcdBarrier xcd_barrier_post(unsigned* bar, volatile LAS unsigned* st) {
    XcdBarrier b; b.bar = bar; b.x = xb_xcc_id(); b.st = st;
    if (threadIdx.x == 0) (void)xb_add(&bar[XB_XCNT(b.x)], 1u);
    return b;
}
__device__ __forceinline__ void xcd_barrier_complete(unsigned* bar, unsigned x, unsigned& nloc, unsigned& nx) {
    const unsigned G = gridDim.x * gridDim.y * gridDim.z;
    unsigned sum, cnt, mine, sp = 0u;
    for (;;) {
        sum = 0u; cnt = 0u; mine = 0u;
#pragma unroll
        for (unsigned j = 0; j < 16; ++j) { const unsigned c = xb_ld(&bar[XB_XCNT(j)]); sum += c; cnt += (c > 0u) ? 1u : 0u; mine = (j == x) ? c : mine; }
        if (sum == G) break;
        __builtin_amdgcn_s_sleep(1);
        if ((++sp & 255u) == 0u) { if (xb_ld(&bar[XB_TMO])) break; if (sp > XB_SPIN_CAP) { atomicAdd(&bar[XB_TMO], 1u); break; } }
    }
    nloc = mine > 0u ? mine : 1u; nx = cnt > 0u ? cnt : 1u;
}

__device__ __forceinline__ void xcd_barrier(const XcdBarrier& b) {
    asm volatile("s_waitcnt vmcnt(0)" ::: "memory");
    __syncthreads();
    if (threadIdx.x == 0) {
        unsigned* bar = b.bar;
        __builtin_amdgcn_s_waitcnt(0);
        unsigned nloc = b.st[0], nx = b.st[1];
        if (nloc == 0u) { xcd_barrier_complete(bar, b.x, nloc, nx); b.st[0] = nloc; b.st[1] = nx; }
        const unsigned old = xb_add(&bar[XB_XSUB(b.x)], 1u);
        const unsigned gen = old / nloc;
        if (old + 1u == (gen + 1u) * nloc) {
            __builtin_amdgcn_fence(__ATOMIC_RELEASE, "agent");
            asm volatile("s_waitcnt vmcnt(0)" ::: "memory");
            const unsigned og = xb_add(&bar[XB_TOP], 1u);
            const unsigned tg = og / nx;
            if (og + 1u == (tg + 1u) * nx) xb_add(&bar[XB_TOPGEN], 1u);
            else XB_SPIN(xb_ld(&bar[XB_TOPGEN]) == tg, bar);
            __builtin_amdgcn_fence(__ATOMIC_ACQUIRE, "agent");
            xb_add(&bar[XB_XGEN(b.x)], 1u);
            asm volatile("s_waitcnt vmcnt(0)" ::: "memory");
        } else {
            XB_SPIN(xb_ld(&bar[XB_XGEN(b.x)]) == gen, bar);
            __builtin_amdgcn_fence(__ATOMIC_ACQUIRE, "agent");
            asm volatile("s_waitcnt vmcnt(0)" ::: "memory");
        }
    }
    __syncthreads();
}
struct Frame {
    LAS unsigned char* lds;
    volatile LAS unsigned* MISC;
    gu32* ctl;
    int tid, lane, wave;
    int vcu, G;
    const float *x, *c, *w_ada, *b_ada, *g_pre_mix, *g_post_mix, *g_pre_ffn, *g_post_ffn, *w_in, *dec_f, *dec_b, *w_out, *w_router, *w_gate, *w_up, *w_down;
    float* out;
    float *MOD, *AFF, *GATEV, *LSE, *KV, *MIXED;
    int *TOK, *SLOTOF;
    bf16 *WIN, *WOUT, *WGU, *WDN, *XN, *PROJ, *PREV, *ATTO, *Y, *XE, *HH, *YE;
};

__device__ __forceinline__ void p0_transpose_item(const float* W, int K, int N, bf16* WT, int k0, int n0, int drow0, LAS float* scr, int lane) {
#pragma unroll 8
    for (int i = 0; i < 32; ++i) { const int kk = 2 * i + (lane >> 5); scr[kk * 33 + (lane & 31)] = W[(size_t)(k0 + kk) * N + n0 + (lane & 31)]; }
    LDS_WAIT(); asm volatile("" ::: "memory");
    const int c = lane & 7;
#pragma unroll
    for (int j = 0; j < 4; ++j) { const int n = (lane >> 3) + 8 * j; const LAS float* s = scr + (8 * c) * 33 + n;
        v4u o; o.x = pk2(s[0 * 33], s[1 * 33]); o.y = pk2(s[2 * 33], s[3 * 33]); o.z = pk2(s[4 * 33], s[5 * 33]); o.w = pk2(s[6 * 33], s[7 * 33]);
        *(GAS v4u*)(WT + (size_t)(drow0 + n) * K + k0 + 8 * c) = o; }
    LDS_WAIT(); asm volatile("" ::: "memory");
}
__device__ __forceinline__ void phase_p0a(Frame& F) {
    LAS float* sc = (LAS float*)(F.lds + 98304);
    for (int i = F.tid; i < 2 * DM; i += NWAVES * 64) { const float v = F.c[i]; sc[i] = v / (1.f + __expf(-v)); }
    __syncthreads();
    { const int gwm = F.wave * F.G + F.vcu;
      for (int it = gwm; it < 6 * DM / 16; it += F.G * NWAVES) {
        const int col = it * 16 + (F.lane & 15), kq = F.lane >> 4; float a0 = 0.f, a1 = 0.f;
#pragma unroll 8
        for (int k = kq; k < DM; k += 4) { const float w = F.w_ada[(size_t)k * (6 * DM) + col]; a0 += sc[k] * w; a1 += sc[DM + k] * w; }
        a0 += __shfl_xor(a0, 16); a0 += __shfl_xor(a0, 32); a1 += __shfl_xor(a1, 16); a1 += __shfl_xor(a1, 32);
        if (kq == 0) { const float bb = F.b_ada[col]; F.MOD[col] = a0 + bb; F.MOD[6 * DM + col] = a1 + bb; }
      } }
    LAS float* scr = (LAS float*)(F.lds + F.wave * 12288);
    const int gw = F.vcu * NWAVES + F.wave, NGW = F.G * NWAVES;
    constexpr int I_IN = (DM / 64) * (NPROJ / 32), I_OUT = (DM / 64) * (DM / 32), I_G1 = (DM / 64) * (FF / 32), I_G = NE * I_G1, I_D1 = (FF / 64) * (DM / 32), I_D = NE * I_D1;
    constexpr int NITEMS = I_IN + I_OUT + 2 * I_G + I_D;
    for (int it = gw; it < NITEMS; it += NGW) {
        int r = it;
        if (r < I_IN) { const int nblk = NPROJ / 32, kb = r / nblk, nb = r % nblk; p0_transpose_item(F.w_in, DM, NPROJ, F.WIN, 64 * kb, 32 * nb, 32 * nb, scr, F.lane); continue; } r -= I_IN;
        if (r < I_OUT) { const int nblk = DM / 32, kb = r / nblk, nb = r % nblk; p0_transpose_item(F.w_out, DM, DM, F.WOUT, 64 * kb, 32 * nb, 32 * nb, scr, F.lane); continue; } r -= I_OUT;
        if (r < 2 * I_G) { const int half = r / I_G; r -= half * I_G; const int e = r / I_G1, q = r % I_G1, nblk = FF / 32, kb = q / nblk, nb = q % nblk, n0 = 32 * nb;
            const float* W = (half ? F.w_up : F.w_gate) + (size_t)e * DM * FF;
            p0_transpose_item(W, DM, FF, F.WGU + (size_t)e * (2 * FF) * DM, 64 * kb, n0, (n0 >> 7) * 256 + half * 128 + (n0 & 127), scr, F.lane); continue; } r -= 2 * I_G;
        { const int e = r / I_D1, q = r % I_D1, nblk = DM / 32, kb = q / nblk, nb = q % nblk;
          p0_transpose_item(F.w_down + (size_t)e * FF * DM, FF, DM, F.WDN + (size_t)e * DM * FF, 64 * kb, 32 * nb, 32 * nb, scr, F.lane); }
    }
}
__device__ __forceinline__ void phase_p0b(Frame& F) {
    const int gw = F.vcu * NWAVES + F.wave, NGW = F.G * NWAVES;
    for (int m = gw; m < MTOK; m += NGW) {
        const int b = m / SEQ; const float* mod = F.MOD + b * 6 * DM;
        const GAS f32x4* xr = (const GAS f32x4*)(F.x + (size_t)m * DM) + F.lane;
        f32x4 v[4]; float s = 0.f;
#pragma unroll
        for (int j = 0; j < 4; ++j) { v[j] = xr[64 * j]; s += (v[j].x * v[j].x + v[j].y * v[j].y) + (v[j].z * v[j].z + v[j].w * v[j].w); }
        const float r = 1.f / sqrtf(wave_sum(s) * (1.f / DM) + RMS_EPS);
        GAS v2u* o8 = (GAS v2u*)(F.XN + (size_t)m * DM) + F.lane;
#pragma unroll
        for (int j = 0; j < 4; ++j) { const int c = 4 * F.lane + 256 * j;
            const f32x4 g = *(const f32x4*)(F.g_pre_mix + c), sc = *(const f32x4*)(mod + DM + c), sh = *(const f32x4*)(mod + c);
            const f32x4 h = v[j] * r * g * (sc + 1.f) + sh;
            v2u w; w.x = pk2(h.x, h.y); w.y = pk2(h.z, h.w); o8[64 * j] = w; }
    }
}
__device__ __forceinline__ float lg2_sigmoid(float x) { return -log1pf(__expf(-x)) * LOG2E; }
__device__ __forceinline__ void attn_unit(Frame& F, int b, int h, int cfg, int r, int qblk) {
    const int d = (cfg == 0) ? 1 : ((cfg == 1) ? 4 : 16), L = SEQ / d;
    const int tid = F.tid, wave = F.wave; int lane = F.lane; asm volatile("" : "+v"(lane));
    const int i = lane & 31, hi = lane >> 5;
    const bf16* P = F.PROJ + (size_t)b * SEQ * NPROJ;
    const int wl0 = 256 * qblk - 64;
    LAS unsigned char* Vl = F.lds;
#pragma unroll
    for (int p = 0; p < 6; ++p) {
        const int kidx = p * 64 + (tid >> 3), ch = tid & 7;
        int l = wl0 + kidx; l = l < 0 ? 0 : (l > L - 1 ? L - 1 : l);
        const v4u val = *(const v4u*)(P + (size_t)(l * d + r) * NPROJ + C_AV + h * AD + ch * 8);
        *(LAS v4u*)(Vl + (ch >> 2) * (384 * 64) + (kidx >> 3) * 512 + (kidx & 7) * 64 + (ch & 3) * 16) = val;
    }
    __syncthreads();
    const int lw0 = 256 * qblk + 32 * wave - 64;
    const int ql = 256 * qblk + 32 * wave + i;
    bf16x8 qf[4];
    { const bf16* qp = P + (size_t)(ql * d + r) * NPROJ + C_AQ + h * AD + hi * 8;
#pragma unroll
      for (int s = 0; s < 4; ++s) qf[s] = *(const bf16x8*)(qp + 16 * s); }
    f32x16 acc[5];
    bf16x8 kf[2][4];
#define ATT_LOADK(T, buf) do { int kl_ = lw0 + 32 * (T) + i; kl_ = kl_ < 0 ? 0 : (kl_ > L - 1 ? L - 1 : kl_); const bf16* kp_ = P + (size_t)(kl_ * d + r) * NPROJ + C_AK + h * AD + hi * 8; \
        _Pragma("unroll") for (int s_ = 0; s_ < 4; ++s_) kf[buf][s_] = *(const bf16x8*)(kp_ + 16 * s_); } while (0)
    ATT_LOADK(0, 0);
#pragma unroll
    for (int T = 0; T < 5; ++T) {
        if (T + 1 < 5) ATT_LOADK(T + 1, (T + 1) & 1);
        asm volatile("" ::: "memory");
        f32x16 a = {};
#pragma unroll
        for (int s = 0; s < 4; ++s) a = __builtin_amdgcn_mfma_f32_32x32x16_bf16(kf[T & 1][s], qf[s], a, 0, 0, 0);
        acc[T] = a;
    }
#undef ATT_LOADK
    const float slope2 = ex2(-(float)(h + 1)) * (float)d * LOG2E;
    float mx = -3.0e38f;
#pragma unroll
    for (int T = 0; T < 5; ++T)
#pragma unroll
        for (int rr = 0; rr < 16; ++rr) {
            const int j = 32 * T + crow(rr, hi); int dist = i + 64 - j; dist = dist < 0 ? -dist : dist; const int kl = lw0 + j;
            const bool valid = (dist <= 64) && (kl >= 0) && (kl < L);
            const float sv = valid ? acc[T][rr] - slope2 * (float)dist : -1.0e30f;
            acc[T][rr] = sv; mx = fmaxf(mx, sv);
        }
    mx = fmaxf(mx, __shfl_xor(mx, 32));
    float lsum = 0.f;
#pragma unroll
    for (int T = 0; T < 5; ++T)
#pragma unroll
        for (int rr = 0; rr < 16; ++rr) { const float p = ex2(acc[T][rr] - mx); acc[T][rr] = p; lsum += p; }
    lsum += __shfl_xor(lsum, 32);
    f32x16 o[2]; o[0] = f32x16{}; o[1] = f32x16{};
    const LAS unsigned char* vb = Vl + ((lane >> 4) & 1) * 32 + (lane & 3) * 8 + (4 * hi + ((lane & 15) >> 2)) * 64;
#pragma unroll
    for (int T = 0; T < 5; ++T)
#pragma unroll
        for (int u = 0; u < 2; ++u) {
            v4u pw; pw.x = pk2(acc[T][8 * u + 0], acc[T][8 * u + 1]); pw.y = pk2(acc[T][8 * u + 2], acc[T][8 * u + 3]); pw.z = pk2(acc[T][8 * u + 4], acc[T][8 * u + 5]); pw.w = pk2(acc[T][8 * u + 6], acc[T][8 * u + 7]);
            const bf16x8 pb = __builtin_bit_cast(bf16x8, pw);
            const int kbase = 32 * wave + 32 * T + 16 * u;
#pragma unroll
            for (int dt = 0; dt < 2; ++dt) {
                const LAS unsigned char* a = vb + dt * (384 * 64) + (kbase >> 3) * 512;
                const bf16x8 va = cat8(vtr(a), vtr(a + 512));
                o[dt] = __builtin_amdgcn_mfma_f32_32x32x16_bf16(va, pb, o[dt], 0, 0, 0);
            }
            asm volatile("" ::: "memory");
        }
    const float inv = 1.f / lsum;
    const size_t row = (size_t)b * SEQ + (size_t)(ql * d + r);
    bf16* op = F.ATTO + ((size_t)cfg * MTOK + row) * (AH * AD) + h * AD;
#pragma unroll
    for (int dt = 0; dt < 2; ++dt)
#pragma unroll
        for (int g = 0; g < 4; ++g) { v2u w; w.x = pk2(o[dt][4 * g] * inv, o[dt][4 * g + 1] * inv); w.y = pk2(o[dt][4 * g + 2] * inv, o[dt][4 * g + 3] * inv);
            *(v2u*)(op + 32 * dt + 8 * g + 4 * hi) = w; }
    if (hi == 0) F.LSE[((size_t)cfg * MTOK + row) * AH + h] = mx + __builtin_amdgcn_logf(lsum);
    __syncthreads();
}
__device__ __forceinline__ void kv_unit(Frame& F, int b, int h, int n) {
    const int tid = F.tid, wave = F.wave; int lane = F.lane; asm volatile("" : "+v"(lane));
    const int hi = lane >> 5;
    const float lgf = lg2_sigmoid(F.dec_f[h]), lgb = lg2_sigmoid(F.dec_b[h]);
    const size_t row0 = (size_t)b * SEQ + (size_t)n * CHK;
    LAS unsigned char* Vl = F.lds;
    LAS unsigned char* Kl = F.lds + 32768;
#pragma unroll
    for (int p = 0; p < 4; ++p) { const int idx = p * 512 + tid, key = idx >> 4, ch = idx & 15;
        const v4u val = *(const v4u*)(F.PROJ + (row0 + key) * NPROJ + C_RV + h * RV + ch * 8);
        *(LAS v4u*)(Vl + (ch >> 2) * (128 * 64) + (key >> 3) * 512 + (key & 7) * 64 + (ch & 3) * 16) = val; }
#pragma unroll
    for (int p = 0; p < 2; ++p) { const int idx = p * 512 + tid, key = idx >> 3, ch = idx & 7;
        const v4u val = *(const v4u*)(F.PROJ + (row0 + key) * NPROJ + C_RK + h * RQK + ch * 8);
        const float sf = ex2(lgf * (float)(127 - key)), sb = ex2(lgb * (float)key);
        v4u wf, wb;
        wf.x = pk2(bflo(val.x) * sf, bfhi(val.x) * sf); wf.y = pk2(bflo(val.y) * sf, bfhi(val.y) * sf); wf.z = pk2(bflo(val.z) * sf, bfhi(val.z) * sf); wf.w = pk2(bflo(val.w) * sf, bfhi(val.w) * sf);
        wb.x = pk2(bflo(val.x) * sb, bfhi(val.x) * sb); wb.y = pk2(bflo(val.y) * sb, bfhi(val.y) * sb); wb.z = pk2(bflo(val.z) * sb, bfhi(val.z) * sb); wb.w = pk2(bflo(val.w) * sb, bfhi(val.w) * sb);
        const int off = (ch >> 2) * (128 * 64) + (key >> 3) * 512 + (key & 7) * 64 + (ch & 3) * 16;
        *(LAS v4u*)(Kl + off) = wf; *(LAS v4u*)(Kl + 16384 + off) = wb; }
    __syncthreads();
    const int dir = wave >> 2, dvt = wave & 3;
    const int lofs = ((lane >> 4) & 1) * 32 + (lane & 3) * 8 + (4 * hi + ((lane & 15) >> 2)) * 64;
    const LAS unsigned char* va = Vl + dvt * (128 * 64) + lofs;
    float* kvout = F.KV + ((size_t)(((b * RH + h) * 2 + dir) * NCH + n)) * (RV * RQK);
#pragma unroll
    for (int dkt = 0; dkt < 2; ++dkt) {
        const LAS unsigned char* ka = Kl + dir * 16384 + dkt * (128 * 64) + lofs;
        f32x16 a = {};
#pragma unroll
        for (int s = 0; s < 8; ++s) {
            const bf16x8 A = cat8(vtr(va + s * 1024), vtr(va + s * 1024 + 512));
            const bf16x8 B = cat8(vtr(ka + s * 1024), vtr(ka + s * 1024 + 512));
            a = __builtin_amdgcn_mfma_f32_32x32x16_bf16(A, B, a, 0, 0, 0);
        }
#pragma unroll
        for (int rr = 0; rr < 16; ++rr) kvout[(32 * dvt + crow(rr, hi)) * RQK + 32 * dkt + (lane & 31)] = a[rr];
    }
    __syncthreads();
}
__device__ __forceinline__ void phase_p2(Frame& F) {
    constexpr int NATT = BATCH * AH * 3 * (SEQ / 256);
    for (int u = F.vcu; u < NATT; u += F.G) {
        const int blk = u & 31, h = (u >> 5) & 7, b = (u >> 8) & 1, cfg = u >> 9;
        const int d = (cfg == 0) ? 1 : ((cfg == 1) ? 4 : 16), nq = (SEQ / d) / 256;
        attn_unit(F, b, h, cfg, blk / nq, blk % nq);
    }
    constexpr int NKV = BATCH * RH * NCH;
    for (int u = F.vcu; u < NKV; u += F.G) kv_unit(F, u >> 8, (u >> 6) & 3, u & 63);
}
__device__ __forceinline__ void phase_p3(Frame& F) {
    for (int g = F.vcu * (NWAVES * 64) + F.tid; g < BATCH * RH * 2 * (RV * RQK); g += F.G * NWAVES * 64) {
        const int bhd = g >> 13, e = g & 8191, dir = bhd & 1, h = (bhd >> 1) & 3;
        const float lam = ex2(128.f * lg2_sigmoid(dir ? F.dec_b[h] : F.dec_f[h]));
        const float* kv = F.KV + (size_t)bhd * NCH * 8192 + e; bf16* pv = F.PREV + (size_t)bhd * NCH * 8192 + e;
        float st = 0.f;
        for (int n0 = 0; n0 < NCH; n0 += 8) {
            float v[8];
#pragma unroll
            for (int k = 0; k < 8; ++k) { const int n = dir ? (NCH - 1 - (n0 + k)) : (n0 + k); v[k] = kv[(size_t)n * 8192]; }
#pragma unroll
            for (int k = 0; k < 8; ++k) { const int n = dir ? (NCH - 1 - (n0 + k)) : (n0 + k); pv[(size_t)n * 8192] = (bf16)(pk2(st, 0.f) & 0xffffu); st = lam * st + v[k]; }
        }
    }
    const int gw = F.vcu * NWAVES + F.wave, NGW = F.G * NWAVES;
    for (int m = gw; m < MTOK; m += NGW) {
        const int hd = F.lane >> 3, part = F.lane & 7;
        const float l0 = F.LSE[(size_t)m * AH + hd], l1 = F.LSE[((size_t)MTOK + m) * AH + hd], l2 = F.LSE[((size_t)2 * MTOK + m) * AH + hd];
        const float mx = fmaxf(l0, fmaxf(l1, l2)); float w0 = ex2(l0 - mx), w1 = ex2(l1 - mx), w2 = ex2(l2 - mx); const float inv = 1.f / (w0 + w1 + w2); w0 *= inv; w1 *= inv; w2 *= inv;
        const v4u a = *(const v4u*)(F.ATTO + (size_t)m * 512 + F.lane * 8), bq = *(const v4u*)(F.ATTO + ((size_t)MTOK + m) * 512 + F.lane * 8), cq = *(const v4u*)(F.ATTO + ((size_t)2 * MTOK + m) * 512 + F.lane * 8);
        (void)part;
        v4u o;
        o.x = pk2(w0 * bflo(a.x) + w1 * bflo(bq.x) + w2 * bflo(cq.x), w0 * bfhi(a.x) + w1 * bfhi(bq.x) + w2 * bfhi(cq.x));
        o.y = pk2(w0 * bflo(a.y) + w1 * bflo(bq.y) + w2 * bflo(cq.y), w0 * bfhi(a.y) + w1 * bfhi(bq.y) + w2 * bfhi(cq.y));
        o.z = pk2(w0 * bflo(a.z) + w1 * bflo(bq.z) + w2 * bflo(cq.z), w0 * bfhi(a.z) + w1 * bfhi(bq.z) + w2 * bfhi(cq.z));
        o.w = pk2(w0 * bflo(a.w) + w1 * bflo(bq.w) + w2 * bflo(cq.w), w0 * bfhi(a.w) + w1 * bfhi(bq.w) + w2 * bfhi(cq.w));
        *(v4u*)(F.Y + (size_t)m * DM + 512 + F.lane * 8) = o;
    }
}
__device__ __forceinline__ bf16x8 scale8(bf16x8 q, float s) {
    const v4u w = __builtin_bit_cast(v4u, q); v4u o;
    o.x = pk2(bflo(w.x) * s, bfhi(w.x) * s); o.y = pk2(bflo(w.y) * s, bfhi(w.y) * s); o.z = pk2(bflo(w.z) * s, bfhi(w.z) * s); o.w = pk2(bflo(w.w) * s, bfhi(w.w) * s);
    return __builtin_bit_cast(bf16x8, o);
}
__device__ __forceinline__ void ret_pair(Frame& F, int pair) {
    const int tid = F.tid, wave = F.wave; int lane = F.lane; asm volatile("" : "+v"(lane));
    const int i = lane & 31, hi = lane >> 5, grp = wave >> 2, w4 = wave & 3;
    const int cid = 2 * pair + grp, n = cid & 63, h = (cid >> 6) & 3, b = cid >> 8;
    const float lgf = lg2_sigmoid(F.dec_f[h]), lgb = lg2_sigmoid(F.dec_b[h]);
    const size_t row0 = (size_t)b * SEQ + (size_t)n * CHK;
    LAS unsigned char* Vl = F.lds + grp * 32768;
#pragma unroll
    for (int p = 0; p < 8; ++p) { const int idx = p * 256 + (tid & 255), key = idx >> 4, ch = idx & 15;
        const v4u val = *(const v4u*)(F.PROJ + (row0 + key) * NPROJ + C_RV + h * RV + ch * 8);
        *(LAS v4u*)(Vl + (ch >> 2) * (128 * 64) + (key >> 3) * 512 + (key & 7) * 64 + (ch & 3) * 16) = val; }
    __syncthreads();
    const int qi = 32 * w4 + i; const size_t qrow = row0 + qi;
    bf16x8 qf[4];
    { const bf16* qp = F.PROJ + qrow * NPROJ + C_RQ + h * RQK + hi * 8;
#pragma unroll
      for (int s = 0; s < 4; ++s) qf[s] = *(const bf16x8*)(qp + 16 * s); }
    f32x16 acc[4];
    bf16x8 kf[2][4];
#define RET_LOADK(T, buf) do { const bf16* kp_ = F.PROJ + (row0 + 32 * (T) + i) * NPROJ + C_RK + h * RQK + hi * 8; \
        _Pragma("unroll") for (int s_ = 0; s_ < 4; ++s_) kf[buf][s_] = *(const bf16x8*)(kp_ + 16 * s_); } while (0)
    RET_LOADK(0, 0);
#pragma unroll
    for (int T = 0; T < 4; ++T) {
        if (T + 1 < 4) RET_LOADK(T + 1, (T + 1) & 1);
        asm volatile("" ::: "memory");
        f32x16 a = {};
#pragma unroll
        for (int s = 0; s < 4; ++s) a = __builtin_amdgcn_mfma_f32_32x32x16_bf16(kf[T & 1][s], qf[s], a, 0, 0, 0);
        acc[T] = a;
    }
#undef RET_LOADK
#pragma unroll
    for (int T = 0; T < 4; ++T)
#pragma unroll
        for (int rr = 0; rr < 16; ++rr) { const int rel = qi - (32 * T + crow(rr, hi)); const float e = rel >= 0 ? lgf * (float)rel : -lgb * (float)rel; acc[T][rr] *= ex2(e); }
    f32x16 o[4]; o[0] = f32x16{}; o[1] = f32x16{}; o[2] = f32x16{}; o[3] = f32x16{};
    const LAS unsigned char* vb = Vl + ((lane >> 4) & 1) * 32 + (lane & 3) * 8 + (4 * hi + ((lane & 15) >> 2)) * 64;
#pragma unroll
    for (int T = 0; T < 4; ++T)
#pragma unroll
        for (int u = 0; u < 2; ++u) {
            v4u pw; pw.x = pk2(acc[T][8 * u + 0], acc[T][8 * u + 1]); pw.y = pk2(acc[T][8 * u + 2], acc[T][8 * u + 3]); pw.z = pk2(acc[T][8 * u + 4], acc[T][8 * u + 5]); pw.w = pk2(acc[T][8 * u + 6], acc[T][8 * u + 7]);
            const bf16x8 pb = __builtin_bit_cast(bf16x8, pw);
#pragma unroll
            for (int dvt = 0; dvt < 4; ++dvt) {
                const LAS unsigned char* a = vb + dvt * (128 * 64) + (4 * T + 2 * u) * 512;
                o[dvt] = __builtin_amdgcn_mfma_f32_32x32x16_bf16(cat8(vtr(a), vtr(a + 512)), pb, o[dvt], 0, 0, 0);
            }
            asm volatile("" ::: "memory");
        }
    {
        const float sf = ex2(lgf * (float)(qi + 1)), sb = ex2(lgb * (float)(CHK - qi));
        const bf16* pf = F.PREV + ((size_t)(((b * RH + h) * 2 + 0) * NCH + n)) * (RV * RQK) + (size_t)i * RQK + hi * 8;
        const bf16* pb_ = F.PREV + ((size_t)(((b * RH + h) * 2 + 1) * NCH + n)) * (RV * RQK) + (size_t)i * RQK + hi * 8;
#pragma unroll
        for (int s = 0; s < 4; ++s) {
            const bf16x8 qs_f = scale8(qf[s], sf), qs_b = scale8(qf[s], sb);
#pragma unroll
            for (int dvt = 0; dvt < 4; ++dvt) {
                const bf16x8 af = *(const bf16x8*)(pf + dvt * 32 * RQK + 16 * s), ab = *(const bf16x8*)(pb_ + dvt * 32 * RQK + 16 * s);
                o[dvt] = __builtin_amdgcn_mfma_f32_32x32x16_bf16(af, qs_f, o[dvt], 0, 0, 0);
                o[dvt] = __builtin_amdgcn_mfma_f32_32x32x16_bf16(ab, qs_b, o[dvt], 0, 0, 0);
            }
            asm volatile("" ::: "memory");
        }
    }
    float s1 = 0.f;
#pragma unroll
    for (int dvt = 0; dvt < 4; ++dvt)
#pragma unroll
        for (int rr = 0; rr < 16; ++rr) s1 += o[dvt][rr];
    s1 += __shfl_xor(s1, 32); const float mean = s1 * (1.f / RV);
    float s2 = 0.f;
#pragma unroll
    for (int dvt = 0; dvt < 4; ++dvt)
#pragma unroll
        for (int rr = 0; rr < 16; ++rr) { const float dlt = o[dvt][rr] - mean; s2 += dlt * dlt; }
    s2 += __shfl_xor(s2, 32); const float rstd = 1.f / sqrtf(s2 * (1.f / RV) + GN_EPS);
    const bf16* gp = F.PROJ + qrow * NPROJ + C_RG + h * RV; bf16* yp = F.Y + qrow * DM + h * RV;
#pragma unroll
    for (int dvt = 0; dvt < 4; ++dvt)
#pragma unroll
        for (int g = 0; g < 4; ++g) { const int dv = 32 * dvt + 8 * g + 4 * hi; const v2u gw = *(const v2u*)(gp + dv);
            float gv[4] = {bflo(gw.x), bfhi(gw.x), bflo(gw.y), bfhi(gw.y)}; float yv[4];
#pragma unroll
            for (int k = 0; k < 4; ++k) { const float sg = gv[k] * __builtin_amdgcn_rcpf(1.f + ex2(-gv[k] * LOG2E)); yv[k] = sg * (o[dvt][4 * g + k] - mean) * rstd; }
            v2u w; w.x = pk2(yv[0], yv[1]); w.y = pk2(yv[2], yv[3]); *(v2u*)(yp + dv) = w; }
    __syncthreads();
}
__device__ __forceinline__ void phase_p4(Frame& F) { for (int p = F.vcu; p < BATCH * RH * NCH / 2; p += F.G) ret_pair(F, p); }
constexpr int WR_PITCH = DM + 4;
__device__ __forceinline__ void phase_p6(Frame& F) {
    LAS float* wr = (LAS float*)F.lds;
    for (int idx = F.tid; idx < DM * NE; idx += NWAVES * 64) wr[(idx & 15) * WR_PITCH + (idx >> 4)] = F.w_router[idx];
    __syncthreads();
    const int gw = F.vcu * NWAVES + F.wave, NGW = F.G * NWAVES, lane = F.lane;
    for (int m = gw; m < MTOK; m += NGW) {
        const int b = m / SEQ, spos = m % SEQ; const float* mod = F.MOD + b * 6 * DM;
        const GAS f32x4* mr = (const GAS f32x4*)(F.MIXED + (size_t)m * DM) + lane;
        const GAS f32x4* xr = (const GAS f32x4*)(F.x + (size_t)m * DM) + lane;
        f32x4 v[4], xv[4]; float s = 0.f;
#pragma unroll
        for (int j = 0; j < 4; ++j) { v[j] = mr[64 * j]; xv[j] = xr[64 * j]; s += (v[j].x * v[j].x + v[j].y * v[j].y) + (v[j].z * v[j].z + v[j].w * v[j].w); }
        const float r1 = 1.f / sqrtf(wave_sum(s) * (1.f / DM) + RMS_EPS);
        float s2 = 0.f;
        GAS f32x4* orow = (GAS f32x4*)(F.out + (size_t)m * DM) + lane;
#pragma unroll
        for (int j = 0; j < 4; ++j) { const int c = 4 * lane + 256 * j;
            const f32x4 g = *(const f32x4*)(F.g_post_mix + c), gm = *(const f32x4*)(mod + 2 * DM + c);
            xv[j] = xv[j] + gm * (v[j] * r1 * g); orow[64 * j] = xv[j];
            s2 += (xv[j].x * xv[j].x + xv[j].y * xv[j].y) + (xv[j].z * xv[j].z + xv[j].w * xv[j].w); }
        const float r2 = 1.f / sqrtf(wave_sum(s2) * (1.f / DM) + RMS_EPS);
        GAS v2u* h8 = (GAS v2u*)(F.XN + (size_t)m * DM) + lane;
        float lg[NE];
#pragma unroll
        for (int e = 0; e < NE; ++e) lg[e] = 0.f;
#pragma unroll
        for (int j = 0; j < 4; ++j) { const int c = 4 * lane + 256 * j;
            const f32x4 g = *(const f32x4*)(F.g_pre_ffn + c), sc = *(const f32x4*)(mod + 4 * DM + c), sh = *(const f32x4*)(mod + 3 * DM + c);
            const f32x4 h = xv[j] * r2 * g * (sc + 1.f) + sh;
            v2u w; w.x = pk2(h.x, h.y); w.y = pk2(h.z, h.w); h8[64 * j] = w;
#pragma unroll
            for (int e = 0; e < NE; ++e) { const f32x4 wv = *(const LAS f32x4*)(wr + e * WR_PITCH + c); lg[e] += (h.x * wv.x + h.y * wv.y) + (h.z * wv.z + h.w * wv.w); }
            asm volatile("" ::: "memory"); }
        float mxl = -3.0e38f;
#pragma unroll
        for (int e = 0; e < NE; ++e) { lg[e] = wave_sum(lg[e]); mxl = fmaxf(mxl, lg[e]); }
        float den = 0.f;
#pragma unroll
        for (int e = 0; e < NE; ++e) { lg[e] = __expf(lg[e] - mxl); den += lg[e]; }
        const float invd = 1.f / den; float mine = 0.f;
#pragma unroll
        for (int e = 0; e < NE; ++e) mine = (lane == e) ? lg[e] * invd : mine;
        if (lane < NE) F.AFF[((size_t)b * NE + lane) * SEQ + spos] = mine;
    }
}
__device__ __forceinline__ int block_excl_scan(int v, LAS int* wsum, int tid, int lane, int wave, int& total) {
    int inc = v;
#pragma unroll
    for (int o = 1; o < 64; o <<= 1) { const int t = __shfl_up(inc, o); if (lane >= o) inc += t; }
    __syncthreads();
    if (lane == 63) wsum[wave] = inc;
    __syncthreads();
    int base = 0, tot = 0;
#pragma unroll
    for (int w = 0; w < NWAVES; ++w) { const int t = wsum[w]; if (w < wave) base += t; tot += t; }
    total = tot; (void)tid;
    return base + inc - v;
}
__device__ __forceinline__ void phase_p7(Frame& F) {
    if (F.vcu >= BATCH * NE) return;
    const int be = F.vcu, b = be / NE, e = be % NE, tid = F.tid;
    LAS int* hist = (LAS int*)F.lds; LAS int* wsum = hist + 256; LAS int* bc = hist + 272;
    const float* a = F.AFF + (size_t)be * SEQ;
    unsigned v[16];
#pragma unroll
    for (int q = 0; q < 4; ++q) { const v4u t = *(const v4u*)(a + tid * 16 + q * 4); v[4 * q] = t.x; v[4 * q + 1] = t.y; v[4 * q + 2] = t.z; v[4 * q + 3] = t.w; }
    unsigned prefix = 0u; int kk = CAP;
#pragma unroll 1
    for (int pass = 0; pass < 4; ++pass) {
        const int shift = 24 - 8 * pass; const unsigned hmask = (pass == 0) ? 0u : (0xffffffffu << (shift + 8));
        if (tid < 256) hist[tid] = 0;
        __syncthreads();
#pragma unroll
        for (int q = 0; q < 16; ++q) { if (((v[q] ^ prefix) & hmask) == 0u) __hip_atomic_fetch_add(&hist[(v[q] >> shift) & 255u], 1, __ATOMIC_RELAXED, __HIP_MEMORY_SCOPE_WORKGROUP); }
        __syncthreads();
        if (tid == 0) { int cum = 0, sel = 0, rem = kk; for (int bin = 255; bin >= 0; --bin) { const int hc = hist[bin]; if (cum + hc >= kk) { sel = bin; rem = kk - cum; break; } cum += hc; } bc[0] = sel; bc[1] = rem; }
        __syncthreads();
        prefix |= (unsigned)bc[0] << shift; kk = bc[1];
        __syncthreads();
    }
    int ceq = 0;
#pragma unroll
    for (int q = 0; q < 16; ++q) ceq += (v[q] == prefix) ? 1 : 0;
    int tot; int eqbase = block_excl_scan(ceq, wsum, tid, F.lane, F.wave, tot);
    unsigned selmask = 0u; int csel = 0;
#pragma unroll
    for (int q = 0; q < 16; ++q) { bool s = v[q] > prefix; if (v[q] == prefix) { s = eqbase < kk; ++eqbase; } if (s) { selmask |= 1u << q; ++csel; } }
    __syncthreads();
    int slot = block_excl_scan(csel, wsum, tid, F.lane, F.wave, tot);
    const int rowbase = (e * BATCH + b) * CAP;
#pragma unroll
    for (int q = 0; q < 16; ++q) { const int tok = b * SEQ + tid * 16 + q; int so = -1;
        if (selmask & (1u << q)) { const int row = rowbase + (slot < CAP ? slot : CAP - 1); so = row; F.TOK[row] = tok; F.GATEV[row] = __uint_as_float(v[q]); ++slot; }
        F.SLOTOF[(size_t)tok * NE + e] = so; }
}
__device__ __forceinline__ void phase_p7b(Frame& F) {
    const int gw = F.vcu * NWAVES + F.wave, NGW = F.G * NWAVES;
    for (int r = gw; r < NSLOT; r += NGW) { const int t = F.TOK[r];
        const v4u* src = (const v4u*)(F.XN + (size_t)t * DM) + F.lane; v4u* dst = (v4u*)(F.XE + (size_t)r * DM) + F.lane;
        const v4u a = src[0], c = src[64]; dst[0] = a; dst[64] = c; }
}
__device__ __forceinline__ void phase_p10(Frame& F) {
    const int gw = F.vcu * NWAVES + F.wave, NGW = F.G * NWAVES, lane = F.lane;
    for (int m = gw; m < MTOK; m += NGW) {
        const int b = m / SEQ; const float* mod = F.MOD + b * 6 * DM;
        float acc[16];
#pragma unroll
        for (int k = 0; k < 16; ++k) acc[k] = 0.f;
        const int myslot = (lane < NE) ? F.SLOTOF[(size_t)m * NE + lane] : -1;
#pragma unroll 1
        for (int e = 0; e < NE; ++e) { const int r = __builtin_amdgcn_readlane(myslot, e);
            if (r >= 0) { const float g = F.GATEV[r]; const v4u* yr = (const v4u*)(F.YE + (size_t)r * DM) + lane;
#pragma unroll
                for (int j = 0; j < 2; ++j) { const v4u w = yr[64 * j];
                    acc[8 * j + 0] += g * bflo(w.x); acc[8 * j + 1] += g * bfhi(w.x); acc[8 * j + 2] += g * bflo(w.y); acc[8 * j + 3] += g * bfhi(w.y);
                    acc[8 * j + 4] += g * bflo(w.z); acc[8 * j + 5] += g * bfhi(w.z); acc[8 * j + 6] += g * bflo(w.w); acc[8 * j + 7] += g * bfhi(w.w); } } }
        float s = 0.f;
#pragma unroll
        for (int k = 0; k < 16; ++k) s += acc[k] * acc[k];
        const float rr = 1.f / sqrtf(wave_sum(s) * (1.f / DM) + RMS_EPS);
        float* orow = F.out + (size_t)m * DM;
#pragma unroll
        for (int j = 0; j < 2; ++j)
#pragma unroll
            for (int q = 0; q < 2; ++q) { const int c = 8 * lane + 512 * j + 4 * q;
                const f32x4 x1 = *(const f32x4*)(orow + c), g = *(const f32x4*)(F.g_post_ffn + c), gf = *(const f32x4*)(mod + 5 * DM + c);
                f32x4 a; a.x = acc[8 * j + 4 * q]; a.y = acc[8 * j + 4 * q + 1]; a.z = acc[8 * j + 4 * q + 2]; a.w = acc[8 * j + 4 * q + 3];
                *(f32x4*)(orow + c) = x1 + gf * (a * rr * g); }
    }
}
struct Args { const float* in[16]; float* out; unsigned char* ws; int ph_lo, ph_hi; };
__global__ void __launch_bounds__(NWAVES * 64, 2) mk_fwd(Args args) {
    extern __shared__ __attribute__((aligned(16))) unsigned char lds[];
    Frame F;
    F.lds = (LAS unsigned char*)lds;
    F.MISC = (volatile LAS unsigned*)(F.lds + MISC_OFF);
    F.tid = threadIdx.x; F.lane = F.tid & 63; F.wave = __builtin_amdgcn_readfirstlane(F.tid >> 6);
    F.G = gridDim.x; { const int bx = blockIdx.x; F.vcu = (F.G % 8 == 0) ? (bx % 8) * (F.G / 8) + bx / 8 : bx; }
    unsigned char* ws = args.ws;
    F.ctl = (gu32*)(ws + WS_CTL);
    F.x = args.in[0]; F.c = args.in[1]; F.w_ada = args.in[2]; F.b_ada = args.in[3]; F.g_pre_mix = args.in[4]; F.g_post_mix = args.in[5]; F.g_pre_ffn = args.in[6]; F.g_post_ffn = args.in[7];
    F.w_in = args.in[8]; F.dec_f = args.in[9]; F.dec_b = args.in[10]; F.w_out = args.in[11]; F.w_router = args.in[12]; F.w_gate = args.in[13]; F.w_up = args.in[14]; F.w_down = args.in[15];
    F.out = args.out;
    F.MOD = (float*)(ws + WS_MOD); F.AFF = (float*)(ws + WS_AFF); F.GATEV = (float*)(ws + WS_GATEV); F.LSE = (float*)(ws + WS_LSE); F.KV = (float*)(ws + WS_KV); F.MIXED = (float*)(ws + WS_MIXED);
    F.TOK = (int*)(ws + WS_TOK); F.SLOTOF = (int*)(ws + WS_SLOTOF);
    F.WIN = (bf16*)(ws + WS_WIN); F.WOUT = (bf16*)(ws + WS_WOUT); F.WGU = (bf16*)(ws + WS_WGU); F.WDN = (bf16*)(ws + WS_WDN); F.XN = (bf16*)(ws + WS_XN); F.PROJ = (bf16*)(ws + WS_PROJ);
    F.PREV = (bf16*)(ws + WS_PREV); F.ATTO = (bf16*)(ws + WS_ATTO); F.Y = (bf16*)(ws + WS_Y); F.XE = (bf16*)(ws + WS_XE); F.HH = (bf16*)(ws + WS_HH); F.YE = (bf16*)(ws + WS_YE);
    for (int u = F.tid; u < (LDS_BYTES - LDSCTL_OFF) / 4; u += NWAVES * 64) ((LAS unsigned*)(F.lds + LDSCTL_OFF))[u] = 0u;
    __syncthreads();
    const int lo = args.ph_lo, hi = args.ph_hi;
    XcdBarrier bar; bar.bar = (unsigned*)(F.ctl + CW_BAR); bar.x = 0; bar.st = nullptr;
    if (hi - lo > 1) bar = xcd_barrier_post((unsigned*)(F.ctl + CW_BAR), F.MISC + 8);
#ifndef PHASE_MASK
#define PHASE_MASK 0xffff
#endif
#define IN(k) (((PHASE_MASK >> (k)) & 1) && lo <= (k) && (k) < hi)
#define SEAM(k) do { if (IN(k) && IN((k) + 1)) xcd_barrier(bar); } while (0)
    if (IN(0)) { phase_p0a(F); } SEAM(0);
    if (IN(1)) { phase_p0b(F); } SEAM(1);
    if (IN(2)) {
        pg8::Gemm g{F.XN, F.WIN, MTOK, NPROJ, DM}; pg8::StaticOrder S; S.init(MTOK, NPROJ, F.G, (int)blockIdx.x);
        pg8::EpiBf16S E{F.PROJ, NPROJ, 0xffff, 0.125f, 0.125f * LOG2E, 1};
        pg8::gemm_phase<pg8::EpiBf16S, pg8::StaticOrder, true, true>(F.lds, g, S, E);
    } SEAM(2);
    if (IN(3)) { phase_p2(F); } SEAM(3);
    if (IN(4)) { phase_p3(F); } SEAM(4);
    if (IN(5)) { phase_p4(F); } SEAM(5);
    if (IN(6)) {
        pg8::Gemm g{F.Y, F.WOUT, MTOK, DM, DM}; pg8::StaticOrder S; S.init(MTOK, DM, F.G, (int)blockIdx.x);
        pg8::EpiF32 E{F.MIXED, DM};
        pg8::gemm_phase<pg8::EpiF32, pg8::StaticOrder, true, true>(F.lds, g, S, E);
    } SEAM(6);
    if (IN(7)) { phase_p6(F); } SEAM(7);
    if (IN(8)) { phase_p7(F); } SEAM(8);
    if (IN(9)) { phase_p7b(F); } SEAM(9);
    if (IN(10)) {
        pg8::Gemm g{F.XE, F.WGU, NSLOT, NE * 2 * FF, DM}; pg8::MoeOrder S{16, F.G, F.vcu};
        pg8::EpiSwiGLU E{F.HH, FF};
        pg8::gemm_phase<pg8::EpiSwiGLU, pg8::MoeOrder, true, true>(F.lds, g, S, E);
    } SEAM(10);
    if (IN(11)) {
        pg8::Gemm g{F.HH, F.WDN, NSLOT, NE * DM, FF}; pg8::MoeOrder S{4, F.G, F.vcu};
        pg8::EpiBf16S E{F.YE, DM, 3, 1.f, 1.f, 0};
        pg8::gemm_phase<pg8::EpiBf16S, pg8::MoeOrder, true, true>(F.lds, g, S, E);
    } SEAM(11);
    if (IN(12)) { phase_p10(F); }
#undef IN
#undef SEAM
}

extern "C" void kernel_launch(void* const* d_in, const int* in_sizes, int n_in, void* d_out, int out_size, void* d_ws, size_t ws_size, hipStream_t stream) {
    static int grid = 0;
    if (grid == 0) {
        if (n_in != 16 || in_sizes[0] != MTOK * DM || out_size != MTOK * DM || ws_size < WS_END) { fprintf(stderr, "kernel_launch: unexpected shapes: n_in %d in0 %d out %d ws %zu (need %zu)\n", n_in, n_in > 0 ? in_sizes[0] : -1, out_size, ws_size, (size_t)WS_END); grid = -1; return; }
        int dev = 0, cus = 0;
        if (hipGetDevice(&dev) != hipSuccess || hipDeviceGetAttribute(&cus, hipDeviceAttributeMultiprocessorCount, dev) != hipSuccess) { grid = -1; return; }
        if (hipFuncSetAttribute((const void*)mk_fwd, hipFuncAttributeMaxDynamicSharedMemorySize, LDS_BYTES) != hipSuccess) { fprintf(stderr, "kernel_launch: hipFuncSetAttribute failed\n"); grid = -1; return; }
        int per_cu = 0;
        if (hipOccupancyMaxActiveBlocksPerMultiprocessor(&per_cu, (const void*)mk_fwd, NWAVES * 64, LDS_BYTES) != hipSuccess || per_cu < 1) fprintf(stderr, "kernel_launch: occupancy query says %d blocks per CU\n", per_cu);
        (void)hipGetLastError();
        grid = cus;
    }
    if (grid < 0) return;
    (void)hipMemsetAsync((char*)d_ws + WS_CTL, 0, CTL_ZERO_BYTES, stream);
    Args a{};
    for (int i = 0; i < 16; ++i) a.in[i] = (const float*)d_in[i];
    a.out = (float*)d_out; a.ws = (unsigned char*)d_ws;
#if MK_ONE_LAUNCH
    a.ph_lo = 0; a.ph_hi = NPHASE;
    hipLaunchKernelGGL(mk_fwd, dim3(grid), dim3(NWAVES * 64), LDS_BYTES, stream, a);
#else
    for (int p = 0; p < NPHASE; ++p) { a.ph_lo = p; a.ph_hi = p + 1; hipLaunchKernelGGL(mk_fwd, dim3(grid), dim3(NWAVES * 64), LDS_BYTES, stream, a); }
#endif
}
```

```cpp
#include <hip/hip_runtime.h>
#include <cstdio>
#include <cstdint>
namespace pg8 {
#define PG8_LAS __attribute__((address_space(3)))
typedef unsigned short bf16_t;
typedef short bf16x8 __attribute__((ext_vector_type(8)));
typedef float f32x4 __attribute__((ext_vector_type(4)));
typedef unsigned u32x4 __attribute__((ext_vector_type(4)));
constexpr int BM = 256, BK = 64, HALF = 128, HTB = HALF * BK * 2  , STAGE_BYTES = 8 * HTB, NXCD = 8, WGM = 8;

__host__ __device__ __forceinline__ int lds_byte(int r, int c) { const int st = (r >> 4) * 2 + (c >> 5), rr = r & 15, cc = c & 31, ob = rr * 64 + cc * 2; return st * 1024 + (ob ^ (((ob >> 9) & 1) << 5)); }
__host__ __device__ __forceinline__ void stage_rc(int b, int& R, int& C) { const int st = b / 1024, sb = b % 1024, swz = sb ^ (((sb >> 9) & 1) << 5); R = (st >> 1) * 16 + swz / 64; C = (st & 1) * 32 + (swz % 64) / 2; }
__host__ __device__ __forceinline__ int perm32(int rho) { const int n = rho >> 4, i = rho & 15; return 8 * (i >> 2) + 4 * n + (i & 3); }

struct Unit { int pm, pn; };
struct Gemm { const bf16_t* A; const bf16_t* Bt; int M, N, K; };

struct StaticOrder {
    int nM, nN, nwg, G, c;
    __host__ __device__ void init(int M, int N, int G_, int c_) { nM = M / BM; nN = N / BM; nwg = nM * nN; G = G_; c = c_; }
    __host__ __device__ bool next(int i, Unit& u) const {
        const long L = (long)i * G + c; if (L >= nwg) return false;
        int wgid = (int)L; { const int q = nwg / NXCD, r = nwg % NXCD, xcd = wgid % NXCD, off = wgid / NXCD; wgid = (xcd < r ? xcd * (q + 1) : r * (q + 1) + (xcd - r) * q) + off; }
        const int nig = WGM * nN, gid = wgid / nig, fm = gid * WGM, gsz = (nM - fm) < WGM ? (nM - fm) : WGM;
        u.pm = fm + ((wgid % nig) % gsz); u.pn = (wgid % nig) / gsz; return true;
    }
    __device__ __forceinline__ void a_ready(const Unit&) const {}
    __device__ __forceinline__ void done(const Unit&) const {}
};

__device__ __forceinline__ unsigned cvt_pk_bf16(float lo, float hi) { unsigned r; asm volatile("v_cvt_pk_bf16_f32 %0, %1, %2" : "=v"(r) : "v"(lo), "v"(hi)); return r; }
typedef float f32x2 __attribute__((ext_vector_type(2)));
typedef unsigned u32x2 __attribute__((ext_vector_type(2)));
constexpr float LOG2E_F = 1.4426950408889634f;
struct EpiF32 {
    static constexpr bool PERM = false, AFTER_DRAIN = false;
    float* C; int ldc;
    __device__ __forceinline__ void operator()(const f32x4 (&acc)[2][2][4][2], const Unit& u, int wr, int wc, int fr, int fq) const {
        const int row0 = u.pm * BM + wr * 64 + fr, col0 = u.pn * BM + wc * 32 + 4 * fq;
#pragma unroll
        for (int ai = 0; ai < 2; ++ai)
#pragma unroll
            for (int m = 0; m < 4; ++m) { float* rowp = C + (size_t)(row0 + ai * HALF + m * 16) * ldc + col0;
#pragma unroll
                for (int bj = 0; bj < 2; ++bj)
#pragma unroll
                    for (int n = 0; n < 2; ++n) *(f32x4*)(rowp + bj * HALF + n * 16) = acc[ai][bj][m][n]; }
    }
};
struct EpiBf16S {
    static constexpr bool PERM = true, AFTER_DRAIN = false;
    bf16_t* O; int ldc; int pn_mask; float s_rk, s_aq; int proj;
    __device__ __forceinline__ void operator()(const f32x4 (&acc)[2][2][4][2], const Unit& u, int wr, int wc, int fr, int fq) const {
        const int pn = u.pn & pn_mask;
        const int row0 = u.pm * BM + wr * 64 + fr, col0 = pn * BM + wc * 32 + 8 * fq;
        float sc = 1.f; if (proj) sc = (pn == 1) ? s_rk : ((pn == 6 || pn == 7) ? s_aq : 1.f);
#pragma unroll
        for (int ai = 0; ai < 2; ++ai)
#pragma unroll
            for (int m = 0; m < 4; ++m) { bf16_t* rowp = O + (size_t)(row0 + ai * HALF + m * 16) * ldc + col0;
#pragma unroll
                for (int bj = 0; bj < 2; ++bj) { const f32x4 v0 = acc[ai][bj][m][0] * sc, v1 = acc[ai][bj][m][1] * sc;
                    u32x4 w; w.x = cvt_pk_bf16(v0[0], v0[1]); w.y = cvt_pk_bf16(v0[2], v0[3]); w.z = cvt_pk_bf16(v1[0], v1[1]); w.w = cvt_pk_bf16(v1[2], v1[3]);
                    *(u32x4*)(rowp + bj * HALF) = w; } }
    }
};
struct EpiSwiGLU {
    static constexpr bool PERM = true, AFTER_DRAIN = false;
    bf16_t* O; int ldc;
    __device__ __forceinline__ float act(float g, float up) const { return g * up * __builtin_amdgcn_rcpf(1.f + __builtin_amdgcn_exp2f(-g * LOG2E_F)); }
    __device__ __forceinline__ void operator()(const f32x4 (&acc)[2][2][4][2], const Unit& u, int wr, int wc, int fr, int fq) const {
        const int row0 = u.pm * BM + wr * 64 + fr, col0 = (u.pn & 15) * HALF + wc * 32 + 8 * fq;
#pragma unroll
        for (int ai = 0; ai < 2; ++ai)
#pragma unroll
            for (int m = 0; m < 4; ++m) { bf16_t* rowp = O + (size_t)(row0 + ai * HALF + m * 16) * ldc + col0;
                const f32x4 g0 = acc[ai][0][m][0], g1 = acc[ai][0][m][1], u0 = acc[ai][1][m][0], u1 = acc[ai][1][m][1];
                u32x4 w; w.x = cvt_pk_bf16(act(g0[0], u0[0]), act(g0[1], u0[1])); w.y = cvt_pk_bf16(act(g0[2], u0[2]), act(g0[3], u0[3]));
                w.z = cvt_pk_bf16(act(g1[0], u1[0]), act(g1[1], u1[1])); w.w = cvt_pk_bf16(act(g1[2], u1[2]), act(g1[3], u1[3]));
                *(u32x4*)rowp = w; }
    }
};
struct MoeOrder {
    int ntile, G, vcu;
    __device__ __forceinline__ bool next(int i, Unit& u) const {
        const int total = 16 * 8 * ntile; int L;
        if ((G & 7) == 0) { const int g8 = G >> 3, x = vcu / g8, c = vcu % g8, share = total >> 3, l = i * g8 + c; if (l >= share) return false; L = x * share + l; }
        else { L = i * G + vcu; if (L >= total) return false; }
        const int e = L / (8 * ntile), rem = L % (8 * ntile);
        u.pm = e * 8 + (rem & 7); u.pn = e * ntile + (rem >> 3); return true;
    }
    __device__ __forceinline__ void a_ready(const Unit&) const {}
    __device__ __forceinline__ void done(const Unit&) const {}
};
template <class Epi, class Sched, bool ALIGN_EPI = false, bool SP2 = false>
__device__ __forceinline__ void gemm_phase(PG8_LAS unsigned char* lds, const Gemm g, const Sched& S, const Epi& E) {
    const int tid = threadIdx.x, wid = __builtin_amdgcn_readfirstlane(tid >> 6), lane = tid & 63, wr = wid >> 2, wc = wid & 3, fr = lane & 15, fq = lane >> 4;
    const int K = g.K, nt = K / BK;
    unsigned voffA[2], voffB[2];
#pragma unroll
    for (int i = 0; i < 2; ++i) { int R, C; stage_rc(tid * 16 + i * 8192, R, C); const int Rb = Epi::PERM ? ((R & ~31) + perm32(R & 31)) : R;
        voffA[i] = (unsigned)(R * K + C) * 2u; voffB[i] = (unsigned)(Rb * K + C) * 2u; }
    const size_t kstep = (size_t)(BK * 2);
    const size_t hstep = (size_t)HALF * K * 2;
    const size_t tstep = 2 * hstep;
    const unsigned ldsw = (unsigned)wid * 1024u;
    const int aoff = lds_byte(wr * 64 + fr, fq * 8), boff = lds_byte(wc * 32 + fr, fq * 8);
#define PG8_SA(b, h) (((b) * 2 + (h)) * HTB)
#define PG8_SB(b, h) ((4 + (b) * 2 + (h)) * HTB)
#define PG8_STAGE(bufoff, gbase, voff) do { _Pragma("unroll") for (int _i = 0; _i < 2; ++_i) \
        __builtin_amdgcn_global_load_lds((const unsigned*)((const char*)(gbase) + (voff)[_i]), (PG8_LAS unsigned*)(lds + (bufoff) + ldsw + _i * 8192), 16, 0, 0); } while (0)
#define PG8_LDA(dst, b, h) do { _Pragma("unroll") for (int m = 0; m < 4; ++m) _Pragma("unroll") for (int k = 0; k < 2; ++k) dst[m][k] = *(const PG8_LAS bf16x8*)(lds + PG8_SA(b, h) + aoff + m * 2048 + k * 1024); } while (0)
#define PG8_LDB(dst, b, h) do { _Pragma("unroll") for (int n = 0; n < 2; ++n) _Pragma("unroll") for (int k = 0; k < 2; ++k) dst[n][k] = *(const PG8_LAS bf16x8*)(lds + PG8_SB(b, h) + boff + n * 2048 + k * 1024); } while (0)
#define PG8_MMA(ai, bj, At, Bt) do { __builtin_amdgcn_s_setprio(1); _Pragma("unroll") for (int m = 0; m < 4; ++m) _Pragma("unroll") for (int n = 0; n < 2; ++n) _Pragma("unroll") for (int k = 0; k < 2; ++k) \
        acc[ai][bj][m][n] = __builtin_amdgcn_mfma_f32_16x16x32_bf16(Bt[n][k], At[m][k], acc[ai][bj][m][n], 0, 0, 0); __builtin_amdgcn_s_setprio(0); } while (0)
#define PG8_WAIT_V(n) asm volatile("s_waitcnt vmcnt(" #n ")" ::: "memory")
#define PG8_WAIT_L(n) asm volatile("s_waitcnt lgkmcnt(" #n ")" ::: "memory")
#define PG8_BAR __builtin_amdgcn_s_barrier()
#define PG8_SCHED __builtin_amdgcn_sched_barrier(0)
    Unit cur, nxt; int ui = 0;
    if (!S.next(0, cur)) return;
    f32x4 acc[2][2][4][2];
#pragma unroll
    for (int a = 0; a < 2; ++a)
#pragma unroll
        for (int b = 0; b < 2; ++b)
#pragma unroll
            for (int m = 0; m < 4; ++m)
#pragma unroll
                for (int n = 0; n < 2; ++n) acc[a][b][m][n] = (f32x4){0.f, 0.f, 0.f, 0.f};
    bf16x8 At[4][2], B0[2][2], B1[2][2];
    const char* cA = (const char*)g.A + (size_t)cur.pm * tstep; const char* cB = (const char*)g.Bt + (size_t)cur.pn * tstep;
    S.a_ready(cur);
    if constexpr (SP2) {
        PG8_STAGE(PG8_SB(0, 0), cB, voffB); PG8_STAGE(PG8_SB(0, 1), cB + hstep, voffB); PG8_STAGE(PG8_SA(0, 0), cA, voffA); PG8_STAGE(PG8_SA(0, 1), cA + hstep, voffA);
        if (wr == 1) PG8_BAR;
        PG8_WAIT_V(2); PG8_BAR;
        PG8_STAGE(PG8_SB(1, 0), cB + kstep, voffB); PG8_STAGE(PG8_SA(1, 0), cA + kstep, voffA); PG8_STAGE(PG8_SB(1, 1), cB + hstep + kstep, voffB);
        PG8_WAIT_V(6); PG8_BAR;
    } else {
        PG8_STAGE(PG8_SB(0, 0), cB, voffB); PG8_STAGE(PG8_SA(0, 0), cA, voffA); PG8_STAGE(PG8_SB(0, 1), cB + hstep, voffB); PG8_STAGE(PG8_SA(0, 1), cA + hstep, voffA);
        if (wr == 1) PG8_BAR;
        PG8_WAIT_V(4); PG8_BAR;
        PG8_STAGE(PG8_SB(1, 0), cB + kstep, voffB); PG8_STAGE(PG8_SA(1, 0), cA + kstep, voffA); PG8_STAGE(PG8_SB(1, 1), cB + hstep + kstep, voffB);
        PG8_WAIT_V(6); PG8_BAR;
    }
    for (;;) {
        const bool has_next = S.next(ui + 1, nxt);
        const char* nA = has_next ? (const char*)g.A + (size_t)nxt.pm * tstep : cA; const char* nB = has_next ? (const char*)g.Bt + (size_t)nxt.pn * tstep : cB;
        for (int t = 0; t < nt; t += 2) {
            const bool last = (t == nt - 2);
            const char* a1 = cA + (size_t)(t + 1) * kstep;
            const char* a2 = last ? nA : cA + (size_t)(t + 2) * kstep; const char* b2 = last ? nB : cB + (size_t)(t + 2) * kstep;
            const char* a3 = a2 + kstep; const char* b3 = b2 + kstep;
            if (last && has_next) S.a_ready(nxt);
            if constexpr (SP2) {
            PG8_LDB(B0, 0, 0); PG8_LDB(B1, 0, 1); PG8_SCHED; PG8_LDA(At, 0, 0); PG8_STAGE(PG8_SA(1, 1), a1 + hstep, voffA);
            PG8_WAIT_V(8); PG8_WAIT_L(0); PG8_BAR; PG8_MMA(0, 0, At, B0); PG8_MMA(0, 1, At, B1); PG8_BAR; PG8_SCHED;
            PG8_LDA(At, 0, 1); PG8_STAGE(PG8_SB(0, 0), b2, voffB); PG8_STAGE(PG8_SB(0, 1), b2 + hstep, voffB); PG8_STAGE(PG8_SA(0, 0), a2, voffA);
            PG8_WAIT_V(8); PG8_WAIT_L(0); PG8_BAR; PG8_MMA(1, 0, At, B0); PG8_MMA(1, 1, At, B1); PG8_BAR; PG8_SCHED;
            PG8_LDB(B0, 1, 0); PG8_LDB(B1, 1, 1); PG8_SCHED; PG8_LDA(At, 1, 0); PG8_STAGE(PG8_SA(0, 1), a2 + hstep, voffA);
            PG8_WAIT_V(8); PG8_WAIT_L(0); PG8_BAR; PG8_MMA(0, 0, At, B0); PG8_MMA(0, 1, At, B1); PG8_BAR; PG8_SCHED;
            PG8_LDA(At, 1, 1); PG8_STAGE(PG8_SB(1, 0), b3, voffB); PG8_STAGE(PG8_SB(1, 1), b3 + hstep, voffB); PG8_STAGE(PG8_SA(1, 0), a3, voffA);
            PG8_WAIT_V(8); PG8_WAIT_L(0); PG8_BAR; PG8_MMA(1, 0, At, B0); PG8_MMA(1, 1, At, B1); PG8_BAR; PG8_SCHED;
            } else {
            PG8_LDB(B0, 0, 0); PG8_SCHED; PG8_LDA(At, 0, 0); PG8_STAGE(PG8_SA(1, 1), a1 + hstep, voffA);
            PG8_WAIT_L(8); PG8_BAR; PG8_WAIT_L(0); PG8_MMA(0, 0, At, B0); PG8_BAR; PG8_SCHED;
            PG8_LDB(B1, 0, 1); PG8_STAGE(PG8_SB(0, 0), b2, voffB);
            PG8_BAR; PG8_WAIT_L(0); PG8_MMA(0, 1, At, B1); PG8_BAR;
            PG8_LDA(At, 0, 1); PG8_STAGE(PG8_SA(0, 0), a2, voffA);
            PG8_BAR; PG8_WAIT_L(0); PG8_MMA(1, 0, At, B0); PG8_BAR; PG8_SCHED;
            PG8_STAGE(PG8_SB(0, 1), b2 + hstep, voffB);
            PG8_WAIT_V(6); PG8_BAR; PG8_MMA(1, 1, At, B1); PG8_BAR;
            PG8_LDB(B0, 1, 0); PG8_SCHED; PG8_LDA(At, 1, 0); PG8_STAGE(PG8_SA(0, 1), a2 + hstep, voffA);
            PG8_WAIT_L(8); PG8_BAR; PG8_WAIT_L(0); PG8_MMA(0, 0, At, B0); PG8_BAR; PG8_SCHED;
            PG8_LDB(B1, 1, 1); PG8_STAGE(PG8_SB(1, 0), b3, voffB);
            PG8_BAR; PG8_WAIT_L(0); PG8_MMA(0, 1, At, B1); PG8_BAR;
            PG8_LDA(At, 1, 1); PG8_STAGE(PG8_SA(1, 0), a3, voffA);
            PG8_BAR; PG8_WAIT_L(0); PG8_MMA(1, 0, At, B0); PG8_BAR; PG8_SCHED;
            PG8_STAGE(PG8_SB(1, 1), b3 + hstep, voffB);
            PG8_WAIT_V(6); PG8_BAR; PG8_MMA(1, 1, At, B1); PG8_BAR;
            }
        }
        if constexpr (ALIGN_EPI) { if (wr == 0) PG8_BAR; }
        if constexpr (!Epi::AFTER_DRAIN) { E(acc, cur, wr, wc, fr, fq); S.done(cur); }
        if (!has_next) break;
#pragma unroll
        for (int a = 0; a < 2; ++a)
#pragma unroll
            for (int b = 0; b < 2; ++b)
#pragma unroll
                for (int m = 0; m < 4; ++m)
#pragma unroll
                    for (int n = 0; n < 2; ++n) acc[a][b][m][n] = (f32x4){0.f, 0.f, 0.f, 0.f};
        cur = nxt; cA = nA; cB = nB; ++ui;
        if constexpr (ALIGN_EPI) { if (wr == 1) PG8_BAR; }
    }
    PG8_WAIT_V(0);
    if constexpr (!ALIGN_EPI) { if (wr == 0) PG8_BAR; }
    PG8_BAR;
    if constexpr (Epi::AFTER_DRAIN) { E.fused(acc, cur, wr, wc, fr, fq, lds, wid, lane); S.done(cur); }
#undef PG8_SA
#undef PG8_SB
#undef PG8_STAGE
#undef PG8_LDA
#undef PG8_LDB
#undef PG8_MMA
#undef PG8_WAIT_V
#undef PG8_WAIT_L
#undef PG8_BAR
#undef PG8_SCHED
}
}
constexpr int BATCH = 2, SEQ = 8192, DM = 1024, MTOK = BATCH * SEQ;
constexpr int RH = 4, RQK = 64, RV = 128, CHK = 128, NCH = SEQ / CHK;
constexpr int AH = 8, AD = 64;
constexpr int NE = 16, CAP = 1024, FF = 2048, NSLOT = NE * BATCH * CAP;
constexpr int NPROJ = 3072;
constexpr int C_RQ = 0, C_RK = 256, C_RV = 512, C_RG = 1024, C_AQ = 1536, C_AK = 2048, C_AV = 2560;
constexpr float RMS_EPS = 1e-6f, GN_EPS = 1e-5f;
constexpr float LOG2E = 1.4426950408889634f;
constexpr int NWAVES = 8;
#ifndef MK_ONE_LAUNCH
#define MK_ONE_LAUNCH 1
#endif
constexpr int NPHASE = 13;
constexpr size_t MiB = 1u << 20;
constexpr size_t WS_CTL = 0, CTL_ZERO_BYTES = 1 * MiB;
constexpr size_t WS_MOD = 1 * MiB;
constexpr size_t WS_AFF = 2 * MiB;
constexpr size_t WS_TOK = 3 * MiB;
constexpr size_t WS_GATEV = 3 * MiB + 128 * 1024;
constexpr size_t WS_SLOTOF = 3 * MiB + 256 * 1024;
constexpr size_t WS_LSE = 5 * MiB;
constexpr size_t WS_WIN = 8 * MiB;
constexpr size_t WS_WOUT = 14 * MiB;
constexpr size_t WS_WGU = 16 * MiB;
constexpr size_t WS_WDN = 144 * MiB;
constexpr size_t WS_XN = 208 * MiB;
constexpr size_t WS_R = 240 * MiB;
constexpr size_t WS_PROJ = WS_R;
constexpr size_t WS_KV = WS_R + 96 * MiB;
constexpr size_t WS_PREV = WS_R + 128 * MiB;
constexpr size_t WS_ATTO = WS_R + 144 * MiB;
constexpr size_t WS_Y = WS_R + 192 * MiB;
constexpr size_t WS_MIXED = WS_R;
constexpr size_t WS_XE = WS_R + 64 * MiB;
constexpr size_t WS_HH = WS_R + 128 * MiB;
constexpr size_t WS_YE = WS_R;
constexpr size_t WS_END = WS_R + 256 * MiB;
constexpr int CW_BAR = 4096;
constexpr int RING_BYTES = 131072;
constexpr int LDSCTL_OFF = RING_BYTES, MISC_OFF = LDSCTL_OFF + 320;
constexpr int LDS_BYTES = 147456;

#define GAS __attribute__((address_space(1)))
#define LAS __attribute__((address_space(3)))
typedef unsigned short bf16;
typedef unsigned v4u __attribute__((ext_vector_type(4)));
typedef unsigned v2u __attribute__((ext_vector_type(2)));
typedef float f32x4 __attribute__((ext_vector_type(4)));
typedef float f32x16 __attribute__((ext_vector_type(16)));
typedef short bf16x8 __attribute__((ext_vector_type(8)));
typedef short s16x4 __attribute__((ext_vector_type(4)));
typedef GAS unsigned gu32;
#define RLX_AGENT __ATOMIC_RELAXED, __HIP_MEMORY_SCOPE_AGENT
#define LDS_WAIT() asm volatile("s_waitcnt lgkmcnt(0)" ::: "memory")
typedef float f32x2_t __attribute__((ext_vector_type(2))); typedef __bf16 bf16x2_t __attribute__((ext_vector_type(2)));
__device__ __forceinline__ unsigned pk2(float lo, float hi) { f32x2_t v = {lo, hi}; bf16x2_t b = __builtin_convertvector(v, bf16x2_t); return __builtin_bit_cast(unsigned, b); }
__device__ __forceinline__ float bflo(unsigned w) { return __uint_as_float(w << 16); }
__device__ __forceinline__ float bfhi(unsigned w) { return __uint_as_float(w & 0xffff0000u); }
__device__ __forceinline__ float ex2(float x) { return __builtin_amdgcn_exp2f(x); }
__device__ __forceinline__ int crow(int r, int hi) { return (r & 3) + 8 * (r >> 2) + 4 * hi; }
__device__ __forceinline__ s16x4 vtr(const LAS unsigned char* p) { typedef short v4i16_t __attribute__((ext_vector_type(4))); return __builtin_bit_cast(s16x4, __builtin_amdgcn_ds_read_tr16_b64_v4i16((LAS v4i16_t*)p)); }
__device__ __forceinline__ bf16x8 cat8(s16x4 a, s16x4 b) { return (bf16x8){a[0], a[1], a[2], a[3], b[0], b[1], b[2], b[3]}; }
__device__ __forceinline__ float wave_sum(float v) {
#pragma unroll
    for (int o = 1; o < 64; o <<= 1) v += __shfl_xor(v, o);
    return v;
}
#define XB_TMO      128
#define XB_XCNT(j)  (256  + 64 * (j))
#define XB_XSUB(j)  (1280 + 64 * (j))
#define XB_XGEN(j)  (2304 + 64 * (j))
#define XB_TOP      3328
#define XB_TOPGEN   3392
#define XCD_BAR_WORDS 3456
#define XB_SPIN_CAP (1u << 18)

__device__ __forceinline__ unsigned xb_ld(unsigned* p)              { return __hip_atomic_load(p, __ATOMIC_RELAXED, __HIP_MEMORY_SCOPE_AGENT); }
__device__ __forceinline__ unsigned xb_add(unsigned* p, unsigned v) { return __hip_atomic_fetch_add(p, v, __ATOMIC_RELAXED, __HIP_MEMORY_SCOPE_AGENT); }
__device__ __forceinline__ unsigned xb_xcc_id() { return (unsigned)__builtin_amdgcn_s_getreg((3 << 11) | 20) & 0xFu; }
#define XB_SPIN(cond, bar) do { unsigned _sp = 0; while (cond) { __builtin_amdgcn_s_sleep(1); \
    if ((++_sp & 255u) == 0u) { if (xb_ld(&(bar)[XB_TMO])) break; if (_sp > XB_SPIN_CAP) { atomicAdd(&(bar)[XB_TMO], 1u); break; } } } } while (0)

struct XcdBarrier {
    unsigned* bar; unsigned x;
    volatile LAS unsigned* st;
};

__device__ __forceinline__ XcdBarrier xcd_barrier_post(unsigned* bar, volatile LAS unsigned* st) {
    XcdBarrier b; b.bar = bar; b.x = xb_xcc_id(); b.st = st;
    if (threadIdx.x == 0) (void)xb_add(&bar[XB_XCNT(b.x)], 1u);
    return b;
}
__device__ __forceinline__ void xcd_barrier_complete(unsigned* bar, unsigned x, unsigned& nloc, unsigned& nx) {
    const unsigned G = gridDim.x * gridDim.y * gridDim.z;
    unsigned sum, cnt, mine, sp = 0u;
    for (;;) {
        sum = 0u; cnt = 0u; mine = 0u;
#pragma unroll
        for (unsigned j = 0; j < 16; ++j) { const unsigned c = xb_ld(&bar[XB_XCNT(j)]); sum += c; cnt += (c > 0u) ? 1u : 0u; mine = (j == x) ? c : mine; }
        if (sum == G) break;
        __builtin_amdgcn_s_sleep(1);
        if ((++sp & 255u) == 0u) { if (xb_ld(&bar[XB_TMO])) break; if (sp > XB_SPIN_CAP) { atomicAdd(&bar[XB_TMO], 1u); break; } }
    }
    nloc = mine > 0u ? mine : 1u; nx = cnt > 0u ? cnt : 1u;
}

__device__ __forceinline__ void xcd_barrier(const XcdBarrier& b) {
    asm volatile("s_waitcnt vmcnt(0)" ::: "memory");
    __syncthreads();
    if (threadIdx.x == 0) {
        unsigned* bar = b.bar;
        __builtin_amdgcn_s_waitcnt(0);
        unsigned nloc = b.st[0], nx = b.st[1];
        if (nloc == 0u) { xcd_barrier_complete(bar, b.x, nloc, nx); b.st[0] = nloc; b.st[1] = nx; }
        const unsigned old = xb_add(&bar[XB_XSUB(b.x)], 1u);
        const unsigned gen = old / nloc;
        if (old + 1u == (gen + 1u) * nloc) {
            __builtin_amdgcn_fence(__ATOMIC_RELEASE, "agent");
            asm volatile("s_waitcnt vmcnt(0)" ::: "memory");
            const unsigned og = xb_add(&bar[XB_TOP], 1u);
            const unsigned tg = og / nx;
            if (og + 1u == (tg + 1u) * nx) xb_add(&bar[XB_TOPGEN], 1u);
            else XB_SPIN(xb_ld(&bar[XB_TOPGEN]) == tg, bar);
            __builtin_amdgcn_fence(__ATOMIC_ACQUIRE, "agent");
            xb_add(&bar[XB_XGEN(b.x)], 1u);
            asm volatile("s_waitcnt vmcnt(0)" ::: "memory");
        } else {
            XB_SPIN(xb_ld(&bar[XB_XGEN(b.x)]) == gen, bar);
            __builtin_amdgcn_fence(__ATOMIC_ACQUIRE, "agent");
            asm volatile("s_waitcnt vmcnt(0)" ::: "memory");
        }
    }
    __syncthreads();
}
struct Frame {
    LAS unsigned char* lds;
    volatile LAS unsigned* MISC;
    gu32* ctl;
    int tid, lane, wave;
    int vcu, G;
    const float *x, *c, *w_ada, *b_ada, *g_pre_mix, *g_post_mix, *g_pre_ffn, *g_post_ffn, *w_in, *dec_f, *dec_b, *w_out, *w_router, *w_gate, *w_up, *w_down;
    float* out;
    float *MOD, *AFF, *GATEV, *LSE, *KV, *MIXED;
    int *TOK, *SLOTOF;
    bf16 *WIN, *WOUT, *WGU, *WDN, *XN, *PROJ, *PREV, *ATTO, *Y, *XE, *HH, *YE;
};

__device__ __forceinline__ void p0_transpose_item(const float* W, int K, int N, bf16* WT, int k0, int n0, int drow0, LAS float* scr, int lane) {
#pragma unroll 8
    for (int i = 0; i < 32; ++i) { const int kk = 2 * i + (lane >> 5); scr[kk * 33 + (lane & 31)] = W[(size_t)(k0 + kk) * N + n0 + (lane & 31)]; }
    LDS_WAIT(); asm volatile("" ::: "memory");
    const int c = lane & 7;
#pragma unroll
    for (int j = 0; j < 4; ++j) { const int n = (lane >> 3) + 8 * j; const LAS float* s = scr + (8 * c) * 33 + n;
        v4u o; o.x = pk2(s[0 * 33], s[1 * 33]); o.y = pk2(s[2 * 33], s[3 * 33]); o.z = pk2(s[4 * 33], s[5 * 33]); o.w = pk2(s[6 * 33], s[7 * 33]);
        *(GAS v4u*)(WT + (size_t)(drow0 + n) * K + k0 + 8 * c) = o; }
    LDS_WAIT(); asm volatile("" ::: "memory");
}
__device__ __forceinline__ void phase_p0a(Frame& F) {
    LAS float* sc = (LAS float*)(F.lds + 98304);
    for (int i = F.tid; i < 2 * DM; i += NWAVES * 64) { const float v = F.c[i]; sc[i] = v / (1.f + __expf(-v)); }
    __syncthreads();
    { const int gwm = F.wave * F.G + F.vcu;
      for (int it = gwm; it < 6 * DM / 16; it += F.G * NWAVES) {
        const int col = it * 16 + (F.lane & 15), kq = F.lane >> 4; float a0 = 0.f, a1 = 0.f;
#pragma unroll 8
        for (int k = kq; k < DM; k += 4) { const float w = F.w_ada[(size_t)k * (6 * DM) + col]; a0 += sc[k] * w; a1 += sc[DM + k] * w; }
        a0 += __shfl_xor(a0, 16); a0 += __shfl_xor(a0, 32); a1 += __shfl_xor(a1, 16); a1 += __shfl_xor(a1, 32);
        if (kq == 0) { const float bb = F.b_ada[col]; F.MOD[col] = a0 + bb; F.MOD[6 * DM + col] = a1 + bb; }
      } }
    LAS float* scr = (LAS float*)(F.lds + F.wave * 12288);
    const int gw = F.vcu * NWAVES + F.wave, NGW = F.G * NWAVES;
    constexpr int I_IN = (DM / 64) * (NPROJ / 32), I_OUT = (DM / 64) * (DM / 32), I_G1 = (DM / 64) * (FF / 32), I_G = NE * I_G1, I_D1 = (FF / 64) * (DM / 32), I_D = NE * I_D1;
    constexpr int NITEMS = I_IN + I_OUT + 2 * I_G + I_D;
    for (int it = gw; it < NITEMS; it += NGW) {
        int r = it;
        if (r < I_IN) { const int nblk = NPROJ / 32, kb = r / nblk, nb = r % nblk; p0_transpose_item(F.w_in, DM, NPROJ, F.WIN, 64 * kb, 32 * nb, 32 * nb, scr, F.lane); continue; } r -= I_IN;
        if (r < I_OUT) { const int nblk = DM / 32, kb = r / nblk, nb = r % nblk; p0_transpose_item(F.w_out, DM, DM, F.WOUT, 64 * kb, 32 * nb, 32 * nb, scr, F.lane); continue; } r -= I_OUT;
        if (r < 2 * I_G) { const int half = r / I_G; r -= half * I_G; const int e = r / I_G1, q = r % I_G1, nblk = FF / 32, kb = q / nblk, nb = q % nblk, n0 = 32 * nb;
            const float* W = (half ? F.w_up : F.w_gate) + (size_t)e * DM * FF;
            p0_transpose_item(W, DM, FF, F.WGU + (size_t)e * (2 * FF) * DM, 64 * kb, n0, (n0 >> 7) * 256 + half * 128 + (n0 & 127), scr, F.lane); continue; } r -= 2 * I_G;
        { const int e = r / I_D1, q = r % I_D1, nblk = DM / 32, kb = q / nblk, nb = q % nblk;
          p0_transpose_item(F.w_down + (size_t)e * FF * DM, FF, DM, F.WDN + (size_t)e * DM * FF, 64 * kb, 32 * nb, 32 * nb, scr, F.lane); }
    }
}
__device__ __forceinline__ void phase_p0b(Frame& F) {
    const int gw = F.vcu * NWAVES + F.wave, NGW = F.G * NWAVES;
    for (int m = gw; m < MTOK; m += NGW) {
        const int b = m / SEQ; const float* mod = F.MOD + b * 6 * DM;
        const GAS f32x4* xr = (const GAS f32x4*)(F.x + (size_t)m * DM) + F.lane;
        f32x4 v[4]; float s = 0.f;
#pragma unroll
        for (int j = 0; j < 4; ++j) { v[j] = xr[64 * j]; s += (v[j].x * v[j].x + v[j].y * v[j].y) + (v[j].z * v[j].z + v[j].w * v[j].w); }
        const float r = 1.f / sqrtf(wave_sum(s) * (1.f / DM) + RMS_EPS);
        GAS v2u* o8 = (GAS v2u*)(F.XN + (size_t)m * DM) + F.lane;
#pragma unroll
        for (int j = 0; j < 4; ++j) { const int c = 4 * F.lane + 256 * j;
            const f32x4 g = *(const f32x4*)(F.g_pre_mix + c), sc = *(const f32x4*)(mod + DM + c), sh = *(const f32x4*)(mod + c);
            const f32x4 h = v[j] * r * g * (sc + 1.f) + sh;
            v2u w; w.x = pk2(h.x, h.y); w.y = pk2(h.z, h.w); o8[64 * j] = w; }
    }
}
__device__ __forceinline__ float lg2_sigmoid(float x) { return -log1pf(__expf(-x)) * LOG2E; }
__device__ __forceinline__ void attn_unit(Frame& F, int b, int h, int cfg, int r, int qblk) {
    const int d = (cfg == 0) ? 1 : ((cfg == 1) ? 4 : 16), L = SEQ / d;
    const int tid = F.tid, wave = F.wave; int lane = F.lane; asm volatile("" : "+v"(lane));
    const int i = lane & 31, hi = lane >> 5;
    const bf16* P = F.PROJ + (size_t)b * SEQ * NPROJ;
    const int wl0 = 256 * qblk - 64;
    LAS unsigned char* Vl = F.lds;
#pragma unroll
    for (int p = 0; p < 6; ++p) {
        const int kidx = p * 64 + (tid >> 3), ch = tid & 7;
        int l = wl0 + kidx; l = l < 0 ? 0 : (l > L - 1 ? L - 1 : l);
        const v4u val = *(const v4u*)(P + (size_t)(l * d + r) * NPROJ + C_AV + h * AD + ch * 8);
        *(LAS v4u*)(Vl + (ch >> 2) * (384 * 64) + (kidx >> 3) * 512 + (kidx & 7) * 64 + (ch & 3) * 16) = val;
    }
    __syncthreads();
    const int lw0 = 256 * qblk + 32 * wave - 64;
    const int ql = 256 * qblk + 32 * wave + i;
    bf16x8 qf[4];
    { const bf16* qp = P + (size_t)(ql * d + r) * NPROJ + C_AQ + h * AD + hi * 8;
#pragma unroll
      for (int s = 0; s < 4; ++s) qf[s] = *(const bf16x8*)(qp + 16 * s); }
    f32x16 acc[5];
    bf16x8 kf[2][4];
#define ATT_LOADK(T, buf) do { int kl_ = lw0 + 32 * (T) + i; kl_ = kl_ < 0 ? 0 : (kl_ > L - 1 ? L - 1 : kl_); const bf16* kp_ = P + (size_t)(kl_ * d + r) * NPROJ + C_AK + h * AD + hi * 8; \
        _Pragma("unroll") for (int s_ = 0; s_ < 4; ++s_) kf[buf][s_] = *(const bf16x8*)(kp_ + 16 * s_); } while (0)
    ATT_LOADK(0, 0);
#pragma unroll
    for (int T = 0; T < 5; ++T) {
        if (T + 1 < 5) ATT_LOADK(T + 1, (T + 1) & 1);
        asm volatile("" ::: "memory");
        f32x16 a = {};
#pragma unroll
        for (int s = 0; s < 4; ++s) a = __builtin_amdgcn_mfma_f32_32x32x16_bf16(kf[T & 1][s], qf[s], a, 0, 0, 0);
        acc[T] = a;
    }
#undef ATT_LOADK
    const float slope2 = ex2(-(float)(h + 1)) * (float)d * LOG2E;
    float mx = -3.0e38f;
#pragma unroll
    for (int T = 0; T < 5; ++T)
#pragma unroll
        for (int rr = 0; rr < 16; ++rr) {
            const int j = 32 * T + crow(rr, hi); int dist = i + 64 - j; dist = dist < 0 ? -dist : dist; const int kl = lw0 + j;
            const bool valid = (dist <= 64) && (kl >= 0) && (kl < L);
            const float sv = valid ? acc[T][rr] - slope2 * (float)dist : -1.0e30f;
            acc[T][rr] = sv; mx = fmaxf(mx, sv);
        }
    mx = fmaxf(mx, __shfl_xor(mx, 32));
    float lsum = 0.f;
#pragma unroll
    for (int T = 0; T < 5; ++T)
#pragma unroll
        for (int rr = 0; rr < 16; ++rr) { const float p = ex2(acc[T][rr] - mx); acc[T][rr] = p; lsum += p; }
    lsum += __shfl_xor(lsum, 32);
    f32x16 o[2]; o[0] = f32x16{}; o[1] = f32x16{};
    const LAS unsigned char* vb = Vl + ((lane >> 4) & 1) * 32 + (lane & 3) * 8 + (4 * hi + ((lane & 15) >> 2)) * 64;
#pragma unroll
    for (int T = 0; T < 5; ++T)
#pragma unroll
        for (int u = 0; u < 2; ++u) {
            v4u pw; pw.x = pk2(acc[T][8 * u + 0], acc[T][8 * u + 1]); pw.y = pk2(acc[T][8 * u + 2], acc[T][8 * u + 3]); pw.z = pk2(acc[T][8 * u + 4], acc[T][8 * u + 5]); pw.w = pk2(acc[T][8 * u + 6], acc[T][8 * u + 7]);
            const bf16x8 pb = __builtin_bit_cast(bf16x8, pw);
            const int kbase = 32 * wave + 32 * T + 16 * u;
#pragma unroll
            for (int dt = 0; dt < 2; ++dt) {
                const LAS unsigned char* a = vb + dt * (384 * 64) + (kbase >> 3) * 512;
                const bf16x8 va = cat8(vtr(a), vtr(a + 512));
                o[dt] = __builtin_amdgcn_mfma_f32_32x32x16_bf16(va, pb, o[dt], 0, 0, 0);
            }
            asm volatile("" ::: "memory");
        }
    const float inv = 1.f / lsum;
    const size_t row = (size_t)b * SEQ + (size_t)(ql * d + r);
    bf16* op = F.ATTO + ((size_t)cfg * MTOK + row) * (AH * AD) + h * AD;
#pragma unroll
    for (int dt = 0; dt < 2; ++dt)
#pragma unroll
        for (int g = 0; g < 4; ++g) { v2u w; w.x = pk2(o[dt][4 * g] * inv, o[dt][4 * g + 1] * inv); w.y = pk2(o[dt][4 * g + 2] * inv, o[dt][4 * g + 3] * inv);
            *(v2u*)(op + 32 * dt + 8 * g + 4 * hi) = w; }
    if (hi == 0) F.LSE[((size_t)cfg * MTOK + row) * AH + h] = mx + __builtin_amdgcn_logf(lsum);
    __syncthreads();
}
__device__ __forceinline__ void kv_unit(Frame& F, int b, int h, int n) {
    const int tid = F.tid, wave = F.wave; int lane = F.lane; asm volatile("" : "+v"(lane));
    const int hi = lane >> 5;
    const float lgf = lg2_sigmoid(F.dec_f[h]), lgb = lg2_sigmoid(F.dec_b[h]);
    const size_t row0 = (size_t)b * SEQ + (size_t)n * CHK;
    LAS unsigned char* Vl = F.lds;
    LAS unsigned char* Kl = F.lds + 32768;
#pragma unroll
    for (int p = 0; p < 4; ++p) { const int idx = p * 512 + tid, key = idx >> 4, ch = idx & 15;
        const v4u val = *(const v4u*)(F.PROJ + (row0 + key) * NPROJ + C_RV + h * RV + ch * 8);
        *(LAS v4u*)(Vl + (ch >> 2) * (128 * 64) + (key >> 3) * 512 + (key & 7) * 64 + (ch & 3) * 16) = val; }
#pragma unroll
    for (int p = 0; p < 2; ++p) { const int idx = p * 512 + tid, key = idx >> 3, ch = idx & 7;
        const v4u val = *(const v4u*)(F.PROJ + (row0 + key) * NPROJ + C_RK + h * RQK + ch * 8);
        const float sf = ex2(lgf * (float)(127 - key)), sb = ex2(lgb * (float)key);
        v4u wf, wb;
        wf.x = pk2(bflo(val.x) * sf, bfhi(val.x) * sf); wf.y = pk2(bflo(val.y) * sf, bfhi(val.y) * sf); wf.z = pk2(bflo(val.z) * sf, bfhi(val.z) * sf); wf.w = pk2(bflo(val.w) * sf, bfhi(val.w) * sf);
        wb.x = pk2(bflo(val.x) * sb, bfhi(val.x) * sb); wb.y = pk2(bflo(val.y) * sb, bfhi(val.y) * sb); wb.z = pk2(bflo(val.z) * sb, bfhi(val.z) * sb); wb.w = pk2(bflo(val.w) * sb, bfhi(val.w) * sb);
        const int off = (ch >> 2) * (128 * 64) + (key >> 3) * 512 + (key & 7) * 64 + (ch & 3) * 16;
        *(LAS v4u*)(Kl + off) = wf; *(LAS v4u*)(Kl + 16384 + off) = wb; }
    __syncthreads();
    const int dir = wave >> 2, dvt = wave & 3;
    const int lofs = ((lane >> 4) & 1) * 32 + (lane & 3) * 8 + (4 * hi + ((lane & 15) >> 2)) * 64;
    const LAS unsigned char* va = Vl + dvt * (128 * 64) + lofs;
    float* kvout = F.KV + ((size_t)(((b * RH + h) * 2 + dir) * NCH + n)) * (RV * RQK);
#pragma unroll
    for (int dkt = 0; dkt < 2; ++dkt) {
        const LAS unsigned char* ka = Kl + dir * 16384 + dkt * (128 * 64) + lofs;
        f32x16 a = {};
#pragma unroll
        for (int s = 0; s < 8; ++s) {
            const bf16x8 A = cat8(vtr(va + s * 1024), vtr(va + s * 1024 + 512));
            const bf16x8 B = cat8(vtr(ka + s * 1024), vtr(ka + s * 1024 + 512));
            a = __builtin_amdgcn_mfma_f32_32x32x16_bf16(A, B, a, 0, 0, 0);
        }
#pragma unroll
        for (int rr = 0; rr < 16; ++rr) kvout[(32 * dvt + crow(rr, hi)) * RQK + 32 * dkt + (lane & 31)] = a[rr];
    }
    __syncthreads();
}
__device__ __forceinline__ void phase_p2(Frame& F) {
    constexpr int NATT = BATCH * AH * 3 * (SEQ / 256);
    for (int u = F.vcu; u < NATT; u += F.G) {
        const int blk = u & 31, h = (u >> 5) & 7, b = (u >> 8) & 1, cfg = u >> 9;
        const int d = (cfg == 0) ? 1 : ((cfg == 1) ? 4 : 16), nq = (SEQ / d) / 256;
        attn_unit(F, b, h, cfg, blk / nq, blk % nq);
    }
    constexpr int NKV = BATCH * RH * NCH;
    for (int u = F.vcu; u < NKV; u += F.G) kv_unit(F, u >> 8, (u >> 6) & 3, u & 63);
}
__device__ __forceinline__ void phase_p3(Frame& F) {
    for (int g = F.vcu * (NWAVES * 64) + F.tid; g < BATCH * RH * 2 * (RV * RQK); g += F.G * NWAVES * 64) {
        const int bhd = g >> 13, e = g & 8191, dir = bhd & 1, h = (bhd >> 1) & 3;
        const float lam = ex2(128.f * lg2_sigmoid(dir ? F.dec_b[h] : F.dec_f[h]));
        const float* kv = F.KV + (size_t)bhd * NCH * 8192 + e; bf16* pv = F.PREV + (size_t)bhd * NCH * 8192 + e;
        float st = 0.f;
        for (int n0 = 0; n0 < NCH; n0 += 8) {
            float v[8];
#pragma unroll
            for (int k = 0; k < 8; ++k) { const int n = dir ? (NCH - 1 - (n0 + k)) : (n0 + k); v[k] = kv[(size_t)n * 8192]; }
#pragma unroll
            for (int k = 0; k < 8; ++k) { const int n = dir ? (NCH - 1 - (n0 + k)) : (n0 + k); pv[(size_t)n * 8192] = (bf16)(pk2(st, 0.f) & 0xffffu); st = lam * st + v[k]; }
        }
    }
    const int gw = F.vcu * NWAVES + F.wave, NGW = F.G * NWAVES;
    for (int m = gw; m < MTOK; m += NGW) {
        const int hd = F.lane >> 3, part = F.lane & 7;
        const float l0 = F.LSE[(size_t)m * AH + hd], l1 = F.LSE[((size_t)MTOK + m) * AH + hd], l2 = F.LSE[((size_t)2 * MTOK + m) * AH + hd];
        const float mx = fmaxf(l0, fmaxf(l1, l2)); float w0 = ex2(l0 - mx), w1 = ex2(l1 - mx), w2 = ex2(l2 - mx); const float inv = 1.f / (w0 + w1 + w2); w0 *= inv; w1 *= inv; w2 *= inv;
        const v4u a = *(const v4u*)(F.ATTO + (size_t)m * 512 + F.lane * 8), bq = *(const v4u*)(F.ATTO + ((size_t)MTOK + m) * 512 + F.lane * 8), cq = *(const v4u*)(F.ATTO + ((size_t)2 * MTOK + m) * 512 + F.lane * 8);
        (void)part;
        v4u o;
        o.x = pk2(w0 * bflo(a.x) + w1 * bflo(bq.x) + w2 * bflo(cq.x), w0 * bfhi(a.x) + w1 * bfhi(bq.x) + w2 * bfhi(cq.x));
        o.y = pk2(w0 * bflo(a.y) + w1 * bflo(bq.y) + w2 * bflo(cq.y), w0 * bfhi(a.y) + w1 * bfhi(bq.y) + w2 * bfhi(cq.y));
        o.z = pk2(w0 * bflo(a.z) + w1 * bflo(bq.z) + w2 * bflo(cq.z), w0 * bfhi(a.z) + w1 * bfhi(bq.z) + w2 * bfhi(cq.z));
        o.w = pk2(w0 * bflo(a.w) + w1 * bflo(bq.w) + w2 * bflo(cq.w), w0 * bfhi(a.w) + w1 * bfhi(bq.w) + w2 * bfhi(cq.w));
        *(v4u*)(F.Y + (size_t)m * DM + 512 + F.lane * 8) = o;
    }
}
__device__ __forceinline__ bf16x8 scale8(bf16x8 q, float s) {
    const v4u w = __builtin_bit_cast(v4u, q); v4u o;
    o.x = pk2(bflo(w.x) * s, bfhi(w.x) * s); o.y = pk2(bflo(w.y) * s, bfhi(w.y) * s); o.z = pk2(bflo(w.z) * s, bfhi(w.z) * s); o.w = pk2(bflo(w.w) * s, bfhi(w.w) * s);
    return __builtin_bit_cast(bf16x8, o);
}
__device__ __forceinline__ void ret_pair(Frame& F, int pair) {
    const int tid = F.tid, wave = F.wave; int lane = F.lane; asm volatile("" : "+v"(lane));
    const int i = lane & 31, hi = lane >> 5, grp = wave >> 2, w4 = wave & 3;
    const int cid = 2 * pair + grp, n = cid & 63, h = (cid >> 6) & 3, b = cid >> 8;
    const float lgf = lg2_sigmoid(F.dec_f[h]), lgb = lg2_sigmoid(F.dec_b[h]);
    const size_t row0 = (size_t)b * SEQ + (size_t)n * CHK;
    LAS unsigned char* Vl = F.lds + grp * 32768;
#pragma unroll
    for (int p = 0; p < 8; ++p) { const int idx = p * 256 + (tid & 255), key = idx >> 4, ch = idx & 15;
        const v4u val = *(const v4u*)(F.PROJ + (row0 + key) * NPROJ + C_RV + h * RV + ch * 8);
        *(LAS v4u*)(Vl + (ch >> 2) * (128 * 64) + (key >> 3) * 512 + (key & 7) * 64 + (ch & 3) * 16) = val; }
    __syncthreads();
    const int qi = 32 * w4 + i; const size_t qrow = row0 + qi;
    bf16x8 qf[4];
    { const bf16* qp = F.PROJ + qrow * NPROJ + C_RQ + h * RQK + hi * 8;
#pragma unroll
      for (int s = 0; s < 4; ++s) qf[s] = *(const bf16x8*)(qp + 16 * s); }
    f32x16 acc[4];
    bf16x8 kf[2][4];
#define RET_LOADK(T, buf) do { const bf16* kp_ = F.PROJ + (row0 + 32 * (T) + i) * NPROJ + C_RK + h * RQK + hi * 8; \
        _Pragma("unroll") for (int s_ = 0; s_ < 4; ++s_) kf[buf][s_] = *(const bf16x8*)(kp_ + 16 * s_); } while (0)
    RET_LOADK(0, 0);
#pragma unroll
    for (int T = 0; T < 4; ++T) {
        if (T + 1 < 4) RET_LOADK(T + 1, (T + 1) & 1);
        asm volatile("" ::: "memory");
        f32x16 a = {};
#pragma unroll
        for (int s = 0; s < 4; ++s) a = __builtin_amdgcn_mfma_f32_32x32x16_bf16(kf[T & 1][s], qf[s], a, 0, 0, 0);
        acc[T] = a;
    }
#undef RET_LOADK
#pragma unroll
    for (int T = 0; T < 4; ++T)
#pragma unroll
        for (int rr = 0; rr < 16; ++rr) { const int rel = qi - (32 * T + crow(rr, hi)); const float e = rel >= 0 ? lgf * (float)rel : -lgb * (float)rel; acc[T][rr] *= ex2(e); }
    f32x16 o[4]; o[0] = f32x16{}; o[1] = f32x16{}; o[2] = f32x16{}; o[3] = f32x16{};
    const LAS unsigned char* vb = Vl + ((lane >> 4) & 1) * 32 + (lane & 3) * 8 + (4 * hi + ((lane & 15) >> 2)) * 64;
#pragma unroll
    for (int T = 0; T < 4; ++T)
#pragma unroll
        for (int u = 0; u < 2; ++u) {
            v4u pw; pw.x = pk2(acc[T][8 * u + 0], acc[T][8 * u + 1]); pw.y = pk2(acc[T][8 * u + 2], acc[T][8 * u + 3]); pw.z = pk2(acc[T][8 * u + 4], acc[T][8 * u + 5]); pw.w = pk2(acc[T][8 * u + 6], acc[T][8 * u + 7]);
            const bf16x8 pb = __builtin_bit_cast(bf16x8, pw);
#pragma unroll
            for (int dvt = 0; dvt < 4; ++dvt) {
                const LAS unsigned char* a = vb + dvt * (128 * 64) + (4 * T + 2 * u) * 512;
                o[dvt] = __builtin_amdgcn_mfma_f32_32x32x16_bf16(cat8(vtr(a), vtr(a + 512)), pb, o[dvt], 0, 0, 0);
            }
            asm volatile("" ::: "memory");
        }
    {
        const float sf = ex2(lgf * (float)(qi + 1)), sb = ex2(lgb * (float)(CHK - qi));
        const bf16* pf = F.PREV + ((size_t)(((b * RH + h) * 2 + 0) * NCH + n)) * (RV * RQK) + (size_t)i * RQK + hi * 8;
        const bf16* pb_ = F.PREV + ((size_t)(((b * RH + h) * 2 + 1) * NCH + n)) * (RV * RQK) + (size_t)i * RQK + hi * 8;
#pragma unroll
        for (int s = 0; s < 4; ++s) {
            const bf16x8 qs_f = scale8(qf[s], sf), qs_b = scale8(qf[s], sb);
#pragma unroll
            for (int dvt = 0; dvt < 4; ++dvt) {
                const bf16x8 af = *(const bf16x8*)(pf + dvt * 32 * RQK + 16 * s), ab = *(const bf16x8*)(pb_ + dvt * 32 * RQK + 16 * s);
                o[dvt] = __builtin_amdgcn_mfma_f32_32x32x16_bf16(af, qs_f, o[dvt], 0, 0, 0);
                o[dvt] = __builtin_amdgcn_mfma_f32_32x32x16_bf16(ab, qs_b, o[dvt], 0, 0, 0);
            }
            asm volatile("" ::: "memory");
        }
    }
    float s1 = 0.f;
#pragma unroll
    for (int dvt = 0; dvt < 4; ++dvt)
#pragma unroll
        for (int rr = 0; rr < 16; ++rr) s1 += o[dvt][rr];
    s1 += __shfl_xor(s1, 32); const float mean = s1 * (1.f / RV);
    float s2 = 0.f;
#pragma unroll
    for (int dvt = 0; dvt < 4; ++dvt)
#pragma unroll
        for (int rr = 0; rr < 16; ++rr) { const float dlt = o[dvt][rr] - mean; s2 += dlt * dlt; }
    s2 += __shfl_xor(s2, 32); const float rstd = 1.f / sqrtf(s2 * (1.f / RV) + GN_EPS);
    const bf16* gp = F.PROJ + qrow * NPROJ + C_RG + h * RV; bf16* yp = F.Y + qrow * DM + h * RV;
#pragma unroll
    for (int dvt = 0; dvt < 4; ++dvt)
#pragma unroll
        for (int g = 0; g < 4; ++g) { const int dv = 32 * dvt + 8 * g + 4 * hi; const v2u gw = *(const v2u*)(gp + dv);
            float gv[4] = {bflo(gw.x), bfhi(gw.x), bflo(gw.y), bfhi(gw.y)}; float yv[4];
#pragma unroll
            for (int k = 0; k < 4; ++k) { const float sg = gv[k] * __builtin_amdgcn_rcpf(1.f + ex2(-gv[k] * LOG2E)); yv[k] = sg * (o[dvt][4 * g + k] - mean) * rstd; }
            v2u w; w.x = pk2(yv[0], yv[1]); w.y = pk2(yv[2], yv[3]); *(v2u*)(yp + dv) = w; }
    __syncthreads();
}
__device__ __forceinline__ void phase_p4(Frame& F) { for (int p = F.vcu; p < BATCH * RH * NCH / 2; p += F.G) ret_pair(F, p); }
constexpr int WR_PITCH = DM + 4;
__device__ __forceinline__ void phase_p6(Frame& F) {
    LAS float* wr = (LAS float*)F.lds;
    for (int idx = F.tid; idx < DM * NE; idx += NWAVES * 64) wr[(idx & 15) * WR_PITCH + (idx >> 4)] = F.w_router[idx];
    __syncthreads();
    const int gw = F.vcu * NWAVES + F.wave, NGW = F.G * NWAVES, lane = F.lane;
    for (int m = gw; m < MTOK; m += NGW) {
        const int b = m / SEQ, spos = m % SEQ; const float* mod = F.MOD + b * 6 * DM;
        const GAS f32x4* mr = (const GAS f32x4*)(F.MIXED + (size_t)m * DM) + lane;
        const GAS f32x4* xr = (const GAS f32x4*)(F.x + (size_t)m * DM) + lane;
        f32x4 v[4], xv[4]; float s = 0.f;
#pragma unroll
        for (int j = 0; j < 4; ++j) { v[j] = mr[64 * j]; xv[j] = xr[64 * j]; s += (v[j].x * v[j].x + v[j].y * v[j].y) + (v[j].z * v[j].z + v[j].w * v[j].w); }
        const float r1 = 1.f / sqrtf(wave_sum(s) * (1.f / DM) + RMS_EPS);
        float s2 = 0.f;
        GAS f32x4* orow = (GAS f32x4*)(F.out + (size_t)m * DM) + lane;
#pragma unroll
        for (int j = 0; j < 4; ++j) { const int c = 4 * lane + 256 * j;
            const f32x4 g = *(const f32x4*)(F.g_post_mix + c), gm = *(const f32x4*)(mod + 2 * DM + c);
            xv[j] = xv[j] + gm * (v[j] * r1 * g); orow[64 * j] = xv[j];
            s2 += (xv[j].x * xv[j].x + xv[j].y * xv[j].y) + (xv[j].z * xv[j].z + xv[j].w * xv[j].w); }
        const float r2 = 1.f / sqrtf(wave_sum(s2) * (1.f / DM) + RMS_EPS);
        GAS v2u* h8 = (GAS v2u*)(F.XN + (size_t)m * DM) + lane;
        float lg[NE];
#pragma unroll
        for (int e = 0; e < NE; ++e) lg[e] = 0.f;
#pragma unroll
        for (int j = 0; j < 4; ++j) { const int c = 4 * lane + 256 * j;
            const f32x4 g = *(const f32x4*)(F.g_pre_ffn + c), sc = *(const f32x4*)(mod + 4 * DM + c), sh = *(const f32x4*)(mod + 3 * DM + c);
            const f32x4 h = xv[j] * r2 * g * (sc + 1.f) + sh;
            v2u w; w.x = pk2(h.x, h.y); w.y = pk2(h.z, h.w); h8[64 * j] = w;
#pragma unroll
            for (int e = 0; e < NE; ++e) { const f32x4 wv = *(const LAS f32x4*)(wr + e * WR_PITCH + c); lg[e] += (h.x * wv.x + h.y * wv.y) + (h.z * wv.z + h.w * wv.w); }
            asm volatile("" ::: "memory"); }
        float mxl = -3.0e38f;
#pragma unroll
        for (int e = 0; e < NE; ++e) { lg[e] = wave_sum(lg[e]); mxl = fmaxf(mxl, lg[e]); }
        float den = 0.f;
#pragma unroll
        for (int e = 0; e < NE; ++e) { lg[e] = __expf(lg[e] - mxl); den += lg[e]; }
        const float invd = 1.f / den; float mine = 0.f;
#pragma unroll
        for (int e = 0; e < NE; ++e) mine = (lane == e) ? lg[e] * invd : mine;
        if (lane < NE) F.AFF[((size_t)b * NE + lane) * SEQ + spos] = mine;
    }
}
__device__ __forceinline__ int block_excl_scan(int v, LAS int* wsum, int tid, int lane, int wave, int& total) {
    int inc = v;
#pragma unroll
    for (int o = 1; o < 64; o <<= 1) { const int t = __shfl_up(inc, o); if (lane >= o) inc += t; }
    __syncthreads();
    if (lane == 63) wsum[wave] = inc;
    __syncthreads();
    int base = 0, tot = 0;
#pragma unroll
    for (int w = 0; w < NWAVES; ++w) { const int t = wsum[w]; if (w < wave) base += t; tot += t; }
    total = tot; (void)tid;
    return base + inc - v;
}
__device__ __forceinline__ void phase_p7(Frame& F) {
    if (F.vcu >= BATCH * NE) return;
    const int be = F.vcu, b = be / NE, e = be % NE, tid = F.tid;
    LAS int* hist = (LAS int*)F.lds; LAS int* wsum = hist + 256; LAS int* bc = hist + 272;
    const float* a = F.AFF + (size_t)be * SEQ;
    unsigned v[16];
#pragma unroll
    for (int q = 0; q < 4; ++q) { const v4u t = *(const v4u*)(a + tid * 16 + q * 4); v[4 * q] = t.x; v[4 * q + 1] = t.y; v[4 * q + 2] = t.z; v[4 * q + 3] = t.w; }
    unsigned prefix = 0u; int kk = CAP;
#pragma unroll 1
    for (int pass = 0; pass < 4; ++pass) {
        const int shift = 24 - 8 * pass; const unsigned hmask = (pass == 0) ? 0u : (0xffffffffu << (shift + 8));
        if (tid < 256) hist[tid] = 0;
        __syncthreads();
#pragma unroll
        for (int q = 0; q < 16; ++q) { if (((v[q] ^ prefix) & hmask) == 0u) __hip_atomic_fetch_add(&hist[(v[q] >> shift) & 255u], 1, __ATOMIC_RELAXED, __HIP_MEMORY_SCOPE_WORKGROUP); }
        __syncthreads();
        if (tid == 0) { int cum = 0, sel = 0, rem = kk; for (int bin = 255; bin >= 0; --bin) { const int hc = hist[bin]; if (cum + hc >= kk) { sel = bin; rem = kk - cum; break; } cum += hc; } bc[0] = sel; bc[1] = rem; }
        __syncthreads();
        prefix |= (unsigned)bc[0] << shift; kk = bc[1];
        __syncthreads();
    }
    int ceq = 0;
#pragma unroll
    for (int q = 0; q < 16; ++q) ceq += (v[q] == prefix) ? 1 : 0;
    int tot; int eqbase = block_excl_scan(ceq, wsum, tid, F.lane, F.wave, tot);
    unsigned selmask = 0u; int csel = 0;
#pragma unroll
    for (int q = 0; q < 16; ++q) { bool s = v[q] > prefix; if (v[q] == prefix) { s = eqbase < kk; ++eqbase; } if (s) { selmask |= 1u << q; ++csel; } }
    __syncthreads();
    int slot = block_excl_scan(csel, wsum, tid, F.lane, F.wave, tot);
    const int rowbase = (e * BATCH + b) * CAP;
#pragma unroll
    for (int q = 0; q < 16; ++q) { const int tok = b * SEQ + tid * 16 + q; int so = -1;
        if (selmask & (1u << q)) { const int row = rowbase + (slot < CAP ? slot : CAP - 1); so = row; F.TOK[row] = tok; F.GATEV[row] = __uint_as_float(v[q]); ++slot; }
        F.SLOTOF[(size_t)tok * NE + e] = so; }
}
__device__ __forceinline__ void phase_p7b(Frame& F) {
    const int gw = F.vcu * NWAVES + F.wave, NGW = F.G * NWAVES;
    for (int r = gw; r < NSLOT; r += NGW) { const int t = F.TOK[r];
        const v4u* src = (const v4u*)(F.XN + (size_t)t * DM) + F.lane; v4u* dst = (v4u*)(F.XE + (size_t)r * DM) + F.lane;
        const v4u a = src[0], c = src[64]; dst[0] = a; dst[64] = c; }
}
__device__ __forceinline__ void phase_p10(Frame& F) {
    const int gw = F.vcu * NWAVES + F.wave, NGW = F.G * NWAVES, lane = F.lane;
    for (int m = gw; m < MTOK; m += NGW) {
        const int b = m / SEQ; const float* mod = F.MOD + b * 6 * DM;
        float acc[16];
#pragma unroll
        for (int k = 0; k < 16; ++k) acc[k] = 0.f;
        const int myslot = (lane < NE) ? F.SLOTOF[(size_t)m * NE + lane] : -1;
#pragma unroll 1
        for (int e = 0; e < NE; ++e) { const int r = __builtin_amdgcn_readlane(myslot, e);
            if (r >= 0) { const float g = F.GATEV[r]; const v4u* yr = (const v4u*)(F.YE + (size_t)r * DM) + lane;
#pragma unroll
                for (int j = 0; j < 2; ++j) { const v4u w = yr[64 * j];
                    acc[8 * j + 0] += g * bflo(w.x); acc[8 * j + 1] += g * bfhi(w.x); acc[8 * j + 2] += g * bflo(w.y); acc[8 * j + 3] += g * bfhi(w.y);
                    acc[8 * j + 4] += g * bflo(w.z); acc[8 * j + 5] += g * bfhi(w.z); acc[8 * j + 6] += g * bflo(w.w); acc[8 * j + 7] += g * bfhi(w.w); } } }
        float s = 0.f;
#pragma unroll
        for (int k = 0; k < 16; ++k) s += acc[k] * acc[k];
        const float rr = 1.f / sqrtf(wave_sum(s) * (1.f / DM) + RMS_EPS);
        float* orow = F.out + (size_t)m * DM;
#pragma unroll
        for (int j = 0; j < 2; ++j)
#pragma unroll
            for (int q = 0; q < 2; ++q) { const int c = 8 * lane + 512 * j + 4 * q;
                const f32x4 x1 = *(const f32x4*)(orow + c), g = *(const f32x4*)(F.g_post_ffn + c), gf = *(const f32x4*)(mod + 5 * DM + c);
                f32x4 a; a.x = acc[8 * j + 4 * q]; a.y = acc[8 * j + 4 * q + 1]; a.z = acc[8 * j + 4 * q + 2]; a.w = acc[8 * j + 4 * q + 3];
                *(f32x4*)(orow + c) = x1 + gf * (a * rr * g); }
    }
}
struct Args { const float* in[16]; float* out; unsigned char* ws; int ph_lo, ph_hi; };
__global__ void __launch_bounds__(NWAVES * 64, 2) mk_fwd(Args args) {
    extern __shared__ __attribute__((aligned(16))) unsigned char lds[];
    Frame F;
    F.lds = (LAS unsigned char*)lds;
    F.MISC = (volatile LAS unsigned*)(F.lds + MISC_OFF);
    F.tid = threadIdx.x; F.lane = F.tid & 63; F.wave = __builtin_amdgcn_readfirstlane(F.tid >> 6);
    F.G = gridDim.x; { const int bx = blockIdx.x; F.vcu = (F.G % 8 == 0) ? (bx % 8) * (F.G / 8) + bx / 8 : bx; }
    unsigned char* ws = args.ws;
    F.ctl = (gu32*)(ws + WS_CTL);
    F.x = args.in[0]; F.c = args.in[1]; F.w_ada = args.in[2]; F.b_ada = args.in[3]; F.g_pre_mix = args.in[4]; F.g_post_mix = args.in[5]; F.g_pre_ffn = args.in[6]; F.g_post_ffn = args.in[7];
    F.w_in = args.in[8]; F.dec_f = args.in[9]; F.dec_b = args.in[10]; F.w_out = args.in[11]; F.w_router = args.in[12]; F.w_gate = args.in[13]; F.w_up = args.in[14]; F.w_down = args.in[15];
    F.out = args.out;
    F.MOD = (float*)(ws + WS_MOD); F.AFF = (float*)(ws + WS_AFF); F.GATEV = (float*)(ws + WS_GATEV); F.LSE = (float*)(ws + WS_LSE); F.KV = (float*)(ws + WS_KV); F.MIXED = (float*)(ws + WS_MIXED);
    F.TOK = (int*)(ws + WS_TOK); F.SLOTOF = (int*)(ws + WS_SLOTOF);
    F.WIN = (bf16*)(ws + WS_WIN); F.WOUT = (bf16*)(ws + WS_WOUT); F.WGU = (bf16*)(ws + WS_WGU); F.WDN = (bf16*)(ws + WS_WDN); F.XN = (bf16*)(ws + WS_XN); F.PROJ = (bf16*)(ws + WS_PROJ);
    F.PREV = (bf16*)(ws + WS_PREV); F.ATTO = (bf16*)(ws + WS_ATTO); F.Y = (bf16*)(ws + WS_Y); F.XE = (bf16*)(ws + WS_XE); F.HH = (bf16*)(ws + WS_HH); F.YE = (bf16*)(ws + WS_YE);
    for (int u = F.tid; u < (LDS_BYTES - LDSCTL_OFF) / 4; u += NWAVES * 64) ((LAS unsigned*)(F.lds + LDSCTL_OFF))[u] = 0u;
    __syncthreads();
    const int lo = args.ph_lo, hi = args.ph_hi;
    XcdBarrier bar; bar.bar = (unsigned*)(F.ctl + CW_BAR); bar.x = 0; bar.st = nullptr;
    if (hi - lo > 1) bar = xcd_barrier_post((unsigned*)(F.ctl + CW_BAR), F.MISC + 8);
#ifndef PHASE_MASK
#define PHASE_MASK 0xffff
#endif
#define IN(k) (((PHASE_MASK >> (k)) & 1) && lo <= (k) && (k) < hi)
#define SEAM(k) do { if (IN(k) && IN((k) + 1)) xcd_barrier(bar); } while (0)
    if (IN(0)) { phase_p0a(F); } SEAM(0);
    if (IN(1)) { phase_p0b(F); } SEAM(1);
    if (IN(2)) {
        pg8::Gemm g{F.XN, F.WIN, MTOK, NPROJ, DM}; pg8::StaticOrder S; S.init(MTOK, NPROJ, F.G, (int)blockIdx.x);
        pg8::EpiBf16S E{F.PROJ, NPROJ, 0xffff, 0.125f, 0.125f * LOG2E, 1};
        pg8::gemm_phase<pg8::EpiBf16S, pg8::StaticOrder, true, true>(F.lds, g, S, E);
    } SEAM(2);
    if (IN(3)) { phase_p2(F); } SEAM(3);
    if (IN(4)) { phase_p3(F); } SEAM(4);
    if (IN(5)) { phase_p4(F); } SEAM(5);
    if (IN(6)) {
        pg8::Gemm g{F.Y, F.WOUT, MTOK, DM, DM}; pg8::StaticOrder S; S.init(MTOK, DM, F.G, (int)blockIdx.x);
        pg8::EpiF32 E{F.MIXED, DM};
        pg8::gemm_phase<pg8::EpiF32, pg8::StaticOrder, true, true>(F.lds, g, S, E);
    } SEAM(6);
    if (IN(7)) { phase_p6(F); } SEAM(7);
    if (IN(8)) { phase_p7(F); } SEAM(8);
    if (IN(9)) { phase_p7b(F); } SEAM(9);
    if (IN(10)) {
        pg8::Gemm g{F.XE, F.WGU, NSLOT, NE * 2 * FF, DM}; pg8::MoeOrder S{16, F.G, F.vcu};
        pg8::EpiSwiGLU E{F.HH, FF};
        pg8::gemm_phase<pg8::EpiSwiGLU, pg8::MoeOrder, true, true>(F.lds, g, S, E);
    } SEAM(10);
    if (IN(11)) {
        pg8::Gemm g{F.HH, F.WDN, NSLOT, NE * DM, FF}; pg8::MoeOrder S{4, F.G, F.vcu};
        pg8::EpiBf16S E{F.YE, DM, 3, 1.f, 1.f, 0};
        pg8::gemm_phase<pg8::EpiBf16S, pg8::MoeOrder, true, true>(F.lds, g, S, E);
    } SEAM(11);
    if (IN(12)) { phase_p10(F); }
#undef IN
#undef SEAM
}

extern "C" void kernel_launch(void* const* d_in, const int* in_sizes, int n_in, void* d_out, int out_size, void* d_ws, size_t ws_size, hipStream_t stream) {
    static int grid = 0;
    if (grid == 0) {
        if (n_in != 16 || in_sizes[0] != MTOK * DM || out_size != MTOK * DM || ws_size < WS_END) { fprintf(stderr, "kernel_launch: unexpected shapes: n_in %d in0 %d out %d ws %zu (need %zu)\n", n_in, n_in > 0 ? in_sizes[0] : -1, out_size, ws_size, (size_t)WS_END); grid = -1; return; }
        int dev = 0, cus = 0;
        if (hipGetDevice(&dev) != hipSuccess || hipDeviceGetAttribute(&cus, hipDeviceAttributeMultiprocessorCount, dev) != hipSuccess) { grid = -1; return; }
        if (hipFuncSetAttribute((const void*)mk_fwd, hipFuncAttributeMaxDynamicSharedMemorySize, LDS_BYTES) != hipSuccess) { fprintf(stderr, "kernel_launch: hipFuncSetAttribute failed\n"); grid = -1; return; }
        int per_cu = 0;
        if (hipOccupancyMaxActiveBlocksPerMultiprocessor(&per_cu, (const void*)mk_fwd, NWAVES * 64, LDS_BYTES) != hipSuccess || per_cu < 1) fprintf(stderr, "kernel_launch: occupancy query says %d blocks per CU\n", per_cu);
        (void)hipGetLastError();
        grid = cus;
    }
    if (grid < 0) return;
    (void)hipMemsetAsync((char*)d_ws + WS_CTL, 0, CTL_ZERO_BYTES, stream);
    Args a{};
    for (int i = 0; i < 16; ++i) a.in[i] = (const float*)d_in[i];
    a.out = (float*)d_out; a.ws = (unsigned char*)d_ws;
#if MK_ONE_LAUNCH
    a.ph_lo = 0; a.ph_hi = NPHASE;
    hipLaunchKernelGGL(mk_fwd, dim3(grid), dim3(NWAVES * 64), LDS_BYTES, stream, a);
#else
    for (int p = 0; p < NPHASE; ++p) { a.ph_lo = p; a.ph_hi = p + 1; hipLaunchKernelGGL(mk_fwd, dim3(grid), dim3(NWAVES * 64), LDS_BYTES, stream, a); }
#endif
}
```

```cpp
#include <hip/hip_runtime.h>
#include <cstdio>
#include <cstdint>
namespace pg8 {
#define PG8_LAS __attribute__((address_space(3)))
typedef unsigned short bf16_t;
typedef short bf16x8 __attribute__((ext_vector_type(8)));
typedef float f32x4 __attribute__((ext_vector_type(4)));
typedef unsigned u32x4 __attribute__((ext_vector_type(4)));
constexpr int BM = 256, BK = 64, HALF = 128, HTB = HALF * BK * 2  , STAGE_BYTES = 8 * HTB, NXCD = 8, WGM = 8;

__host__ __device__ __forceinline__ int lds_byte(int r, int c) { const int st = (r >> 4) * 2 + (c >> 5), rr = r & 15, cc = c & 31, ob = rr * 64 + cc * 2; return st * 1024 + (ob ^ (((ob >> 9) & 1) << 5)); }
__host__ __device__ __forceinline__ void stage_rc(int b, int& R, int& C) { const int st = b / 1024, sb = b % 1024, swz = sb ^ (((sb >> 9) & 1) << 5); R = (st >> 1) * 16 + swz / 64; C = (st & 1) * 32 + (swz % 64) / 2; }
__host__ __device__ __forceinline__ int perm32(int rho) { const int n = rho >> 4, i = rho & 15; return 8 * (i >> 2) + 4 * n + (i & 3); }

struct Unit { int pm, pn; };
struct Gemm { const bf16_t* A; const bf16_t* Bt; int M, N, K; };

struct StaticOrder {
    int nM, nN, nwg, G, c;
    __host__ __device__ void init(int M, int N, int G_, int c_) { nM = M / BM; nN = N / BM; nwg = nM * nN; G = G_; c = c_; }
    __host__ __device__ bool next(int i, Unit& u) const {
        const long L = (long)i * G + c; if (L >= nwg) return false;
        int wgid = (int)L; { const int q = nwg / NXCD, r = nwg % NXCD, xcd = wgid % NXCD, off = wgid / NXCD; wgid = (xcd < r ? xcd * (q + 1) : r * (q + 1) + (xcd - r) * q) + off; }
        const int nig = WGM * nN, gid = wgid / nig, fm = gid * WGM, gsz = (nM - fm) < WGM ? (nM - fm) : WGM;
        u.pm = fm + ((wgid % nig) % gsz); u.pn = (wgid % nig) / gsz; return true;
    }
    __device__ __forceinline__ void a_ready(const Unit&) const {}
    __device__ __forceinline__ void done(const Unit&) const {}
};

__device__ __forceinline__ unsigned cvt_pk_bf16(float lo, float hi) { unsigned r; asm volatile("v_cvt_pk_bf16_f32 %0, %1, %2" : "=v"(r) : "v"(lo), "v"(hi)); return r; }
typedef float f32x2 __attribute__((ext_vector_type(2)));
typedef unsigned u32x2 __attribute__((ext_vector_type(2)));
constexpr float LOG2E_F = 1.4426950408889634f;
struct EpiF32 {
    static constexpr bool PERM = false, AFTER_DRAIN = false;
    float* C; int ldc;
    __device__ __forceinline__ void operator()(const f32x4 (&acc)[2][2][4][2], const Unit& u, int wr, int wc, int fr, int fq) const {
        const int row0 = u.pm * BM + wr * 64 + fr, col0 = u.pn * BM + wc * 32 + 4 * fq;
#pragma unroll
        for (int ai = 0; ai < 2; ++ai)
#pragma unroll
            for (int m = 0; m < 4; ++m) { float* rowp = C + (size_t)(row0 + ai * HALF + m * 16) * ldc + col0;
#pragma unroll
                for (int bj = 0; bj < 2; ++bj)
#pragma unroll
                    for (int n = 0; n < 2; ++n) *(f32x4*)(rowp + bj * HALF + n * 16) = acc[ai][bj][m][n]; }
    }
};
struct EpiBf16S {
    static constexpr bool PERM = true, AFTER_DRAIN = false;
    bf16_t* O; int ldc; int pn_mask; float s_rk, s_aq; int proj;
    __device__ __forceinline__ void operator()(const f32x4 (&acc)[2][2][4][2], const Unit& u, int wr, int wc, int fr, int fq) const {
        const int pn = u.pn & pn_mask;
        const int row0 = u.pm * BM + wr * 64 + fr, col0 = pn * BM + wc * 32 + 8 * fq;
        float sc = 1.f; if (proj) sc = (pn == 1) ? s_rk : ((pn == 6 || pn == 7) ? s_aq : 1.f);
#pragma unroll
        for (int ai = 0; ai < 2; ++ai)
#pragma unroll
            for (int m = 0; m < 4; ++m) { bf16_t* rowp = O + (size_t)(row0 + ai * HALF + m * 16) * ldc + col0;
#pragma unroll
                for (int bj = 0; bj < 2; ++bj) { const f32x4 v0 = acc[ai][bj][m][0] * sc, v1 = acc[ai][bj][m][1] * sc;
                    u32x4 w; w.x = cvt_pk_bf16(v0[0], v0[1]); w.y = cvt_pk_bf16(v0[2], v0[3]); w.z = cvt_pk_bf16(v1[0], v1[1]); w.w = cvt_pk_bf16(v1[2], v1[3]);
                    *(u32x4*)(rowp + bj * HALF) = w; } }
    }
};
struct EpiSwiGLU {
    static constexpr bool PERM = true, AFTER_DRAIN = false;
    bf16_t* O; int ldc;
    __device__ __forceinline__ float act(float g, float up) const { return g * up * __builtin_amdgcn_rcpf(1.f + __builtin_amdgcn_exp2f(-g * LOG2E_F)); }
    __device__ __forceinline__ void operator()(const f32x4 (&acc)[2][2][4][2], const Unit& u, int wr, int wc, int fr, int fq) const {
        const int row0 = u.pm * BM + wr * 64 + fr, col0 = (u.pn & 15) * HALF + wc * 32 + 8 * fq;
#pragma unroll
        for (int ai = 0; ai < 2; ++ai)
#pragma unroll
            for (int m = 0; m < 4; ++m) { bf16_t* rowp = O + (size_t)(row0 + ai * HALF + m * 16) * ldc + col0;
                const f32x4 g0 = acc[ai][0][m][0], g1 = acc[ai][0][m][1], u0 = acc[ai][1][m][0], u1 = acc[ai][1][m][1];
                u32x4 w; w.x = cvt_pk_bf16(act(g0[0], u0[0]), act(g0[1], u0[1])); w.y = cvt_pk_bf16(act(g0[2], u0[2]), act(g0[3], u0[3]));
                w.z = cvt_pk_bf16(act(g1[0], u1[0]), act(g1[1], u1[1])); w.w = cvt_pk_bf16(act(g1[2], u1[2]), act(g1[3], u1[3]));
                *(u32x4*)rowp = w; }
    }
};
struct MoeOrder {
    int ntile, G, vcu;
    __device__ __forceinline__ bool next(int i, Unit& u) const {
        const int total = 16 * 8 * ntile; int L;
        if ((G & 7) == 0) { const int g8 = G >> 3, x = vcu / g8, c = vcu % g8, share = total >> 3, l = i * g8 + c; if (l >= share) return false; L = x * share + l; }
        else { L = i * G + vcu; if (L >= total) return false; }
        const int e = L / (8 * ntile), rem = L % (8 * ntile);
        u.pm = e * 8 + (rem & 7); u.pn = e * ntile + (rem >> 3); return true;
    }
    __device__ __forceinline__ void a_ready(const Unit&) const {}
    __device__ __forceinline__ void done(const Unit&) const {}
};
template <class Epi, class Sched, bool ALIGN_EPI = false, bool SP2 = false, bool GATHER = false>
__device__ __forceinline__ void gemm_phase(PG8_LAS unsigned char* lds, const Gemm g, const Sched& S, const Epi& E, const int* rowmap = nullptr, PG8_LAS int* ldsrow = nullptr) {
    const int tid = threadIdx.x, wid = __builtin_amdgcn_readfirstlane(tid >> 6), lane = tid & 63, wr = wid >> 2, wc = wid & 3, fr = lane & 15, fq = lane >> 4;
    const int K = g.K, nt = K / BK;
    unsigned voffA[2], voffB[2];
#pragma unroll
    for (int i = 0; i < 2; ++i) { int R, C; stage_rc(tid * 16 + i * 8192, R, C); const int Rb = Epi::PERM ? ((R & ~31) + perm32(R & 31)) : R;
        voffA[i] = (unsigned)(R * K + C) * 2u; voffB[i] = (unsigned)(Rb * K + C) * 2u; }
    unsigned gC[2][2] = {{0u, 0u}, {0u, 0u}}, gN[2][2] = {{0u, 0u}, {0u, 0u}}; int gR[2] = {0, 0}; unsigned gCb[2] = {0u, 0u};
    if constexpr (GATHER) {
#pragma unroll
        for (int i = 0; i < 2; ++i) { int R, C; stage_rc(tid * 16 + i * 8192, R, C); gR[i] = R; gCb[i] = (unsigned)C * 2u; }
        Unit uu;
        for (int ui_ = 0; ui_ < 8; ++ui_) { if (!S.next(ui_, uu)) break; if (tid < 256) ldsrow[ui_ * 256 + tid] = rowmap[uu.pm * BM + tid]; }
        __syncthreads();
#pragma unroll
        for (int h = 0; h < 2; ++h)
#pragma unroll
            for (int i = 0; i < 2; ++i) gC[h][i] = (unsigned)ldsrow[h * HALF + gR[i]] * (unsigned)(K * 2) + gCb[i];
    }
    const size_t kstep = (size_t)(BK * 2);
    const size_t hstep = (size_t)HALF * K * 2;
    const size_t tstep = 2 * hstep;
    const unsigned ldsw = (unsigned)wid * 1024u;
    const int aoff = lds_byte(wr * 64 + fr, fq * 8), boff = lds_byte(wc * 32 + fr, fq * 8);
#define PG8_SA(b, h) (((b) * 2 + (h)) * HTB)
#define PG8_SB(b, h) ((4 + (b) * 2 + (h)) * HTB)
#define PG8_STAGE(bufoff, gbase, voff) do { _Pragma("unroll") for (int _i = 0; _i < 2; ++_i) \
        __builtin_amdgcn_global_load_lds((const unsigned*)((const char*)(gbase) + (voff)[_i]), (PG8_LAS unsigned*)(lds + (bufoff) + ldsw + _i * 8192), 16, 0, 0); } while (0)
#define PG8_STAGE_A(bufoff, isnext, half, koff) do { \
        if constexpr (GATHER) { _Pragma("unroll") for (int _i = 0; _i < 2; ++_i) { const unsigned vo_ = (isnext) ? gN[half][_i] : gC[half][_i]; \
            __builtin_amdgcn_global_load_lds((const unsigned*)((const char*)g.A + (koff) + vo_), (PG8_LAS unsigned*)(lds + (bufoff) + ldsw + _i * 8192), 16, 0, 0); } } \
        else { const char* b_ = ((isnext) ? nA : cA) + (half) * hstep + (koff); PG8_STAGE(bufoff, b_, voffA); } } while (0)
#define PG8_LDA(dst, b, h) do { _Pragma("unroll") for (int m = 0; m < 4; ++m) _Pragma("unroll") for (int k = 0; k < 2; ++k) dst[m][k] = *(const PG8_LAS bf16x8*)(lds + PG8_SA(b, h) + aoff + m * 2048 + k * 1024); } while (0)
#define PG8_LDB(dst, b, h) do { _Pragma("unroll") for (int n = 0; n < 2; ++n) _Pragma("unroll") for (int k = 0; k < 2; ++k) dst[n][k] = *(const PG8_LAS bf16x8*)(lds + PG8_SB(b, h) + boff + n * 2048 + k * 1024); } while (0)
#define PG8_MMA(ai, bj, At, Bt) do { __builtin_amdgcn_s_setprio(1); _Pragma("unroll") for (int m = 0; m < 4; ++m) _Pragma("unroll") for (int n = 0; n < 2; ++n) _Pragma("unroll") for (int k = 0; k < 2; ++k) \
        acc[ai][bj][m][n] = __builtin_amdgcn_mfma_f32_16x16x32_bf16(Bt[n][k], At[m][k], acc[ai][bj][m][n], 0, 0, 0); __builtin_amdgcn_s_setprio(0); } while (0)
#define PG8_WAIT_V(n) asm volatile("s_waitcnt vmcnt(" #n ")" ::: "memory")
#define PG8_WAIT_L(n) asm volatile("s_waitcnt lgkmcnt(" #n ")" ::: "memory")
#define PG8_BAR __builtin_amdgcn_s_barrier()
#define PG8_SCHED __builtin_amdgcn_sched_barrier(0)
    Unit cur, nxt; int ui = 0;
    if (!S.next(0, cur)) return;
    f32x4 acc[2][2][4][2];
#pragma unroll
    for (int a = 0; a < 2; ++a)
#pragma unroll
        for (int b = 0; b < 2; ++b)
#pragma unroll
            for (int m = 0; m < 4; ++m)
#pragma unroll
                for (int n = 0; n < 2; ++n) acc[a][b][m][n] = (f32x4){0.f, 0.f, 0.f, 0.f};
    bf16x8 At[4][2], B0[2][2], B1[2][2];
    const char* cA = (const char*)g.A + (size_t)cur.pm * tstep; const char* cB = (const char*)g.Bt + (size_t)cur.pn * tstep;
    S.a_ready(cur);
    const char* nA = cA; (void)nA;
    if constexpr (SP2) {
        PG8_STAGE(PG8_SB(0, 0), cB, voffB); PG8_STAGE(PG8_SB(0, 1), cB + hstep, voffB); PG8_STAGE_A(PG8_SA(0, 0), false, 0, (size_t)0); PG8_STAGE_A(PG8_SA(0, 1), false, 1, (size_t)0);
        if (wr == 1) PG8_BAR;
        PG8_WAIT_V(2); PG8_BAR;
        PG8_STAGE(PG8_SB(1, 0), cB + kstep, voffB); PG8_STAGE_A(PG8_SA(1, 0), false, 0, kstep); PG8_STAGE(PG8_SB(1, 1), cB + hstep + kstep, voffB);
        PG8_WAIT_V(6); PG8_BAR;
    } else {
        PG8_STAGE(PG8_SB(0, 0), cB, voffB); PG8_STAGE_A(PG8_SA(0, 0), false, 0, (size_t)0); PG8_STAGE(PG8_SB(0, 1), cB + hstep, voffB); PG8_STAGE_A(PG8_SA(0, 1), false, 1, (size_t)0);
        if (wr == 1) PG8_BAR;
        PG8_WAIT_V(4); PG8_BAR;
        PG8_STAGE(PG8_SB(1, 0), cB + kstep, voffB); PG8_STAGE_A(PG8_SA(1, 0), false, 0, kstep); PG8_STAGE(PG8_SB(1, 1), cB + hstep + kstep, voffB);
        PG8_WAIT_V(6); PG8_BAR;
    }
    for (;;) {
        const bool has_next = S.next(ui + 1, nxt);
        if constexpr (GATHER) {
#pragma unroll
            for (int h = 0; h < 2; ++h)
#pragma unroll
                for (int i = 0; i < 2; ++i) gN[h][i] = has_next ? (unsigned)ldsrow[(ui + 1) * 256 + h * HALF + gR[i]] * (unsigned)(K * 2) + gCb[i] : gC[h][i];
        }
        const char* nA = has_next ? (const char*)g.A + (size_t)nxt.pm * tstep : cA; const char* nB = has_next ? (const char*)g.Bt + (size_t)nxt.pn * tstep : cB;
        for (int t = 0; t < nt; t += 2) {
            const bool last = (t == nt - 2);
            const size_t k1 = (size_t)(t + 1) * kstep, k2 = last ? (size_t)0 : (size_t)(t + 2) * kstep, k3 = k2 + kstep;
            const char* a1 = cA + (size_t)(t + 1) * kstep;
            const char* a2 = last ? nA : cA + (size_t)(t + 2) * kstep; const char* b2 = last ? nB : cB + (size_t)(t + 2) * kstep;
            const char* a3 = a2 + kstep; const char* b3 = b2 + kstep;
            if (last && has_next) S.a_ready(nxt);
            if constexpr (SP2) {
            PG8_LDB(B0, 0, 0); PG8_LDB(B1, 0, 1); PG8_SCHED; PG8_LDA(At, 0, 0); PG8_STAGE_A(PG8_SA(1, 1), false, 1, k1);
            PG8_WAIT_V(8); PG8_WAIT_L(0); PG8_BAR; PG8_MMA(0, 0, At, B0); PG8_MMA(0, 1, At, B1); PG8_BAR; PG8_SCHED;
            PG8_LDA(At, 0, 1); PG8_STAGE(PG8_SB(0, 0), b2, voffB); PG8_STAGE(PG8_SB(0, 1), b2 + hstep, voffB); PG8_STAGE_A(PG8_SA(0, 0), last, 0, k2);
            PG8_WAIT_V(8); PG8_WAIT_L(0); PG8_BAR; PG8_MMA(1, 0, At, B0); PG8_MMA(1, 1, At, B1); PG8_BAR; PG8_SCHED;
            PG8_LDB(B0, 1, 0); PG8_LDB(B1, 1, 1); PG8_SCHED; PG8_LDA(At, 1, 0); PG8_STAGE_A(PG8_SA(0, 1), last, 1, k2);
            PG8_WAIT_V(8); PG8_WAIT_L(0); PG8_BAR; PG8_MMA(0, 0, At, B0); PG8_MMA(0, 1, At, B1); PG8_BAR; PG8_SCHED;
            PG8_LDA(At, 1, 1); PG8_STAGE(PG8_SB(1, 0), b3, voffB); PG8_STAGE(PG8_SB(1, 1), b3 + hstep, voffB); PG8_STAGE_A(PG8_SA(1, 0), last, 0, k3);
            PG8_WAIT_V(8); PG8_WAIT_L(0); PG8_BAR; PG8_MMA(1, 0, At, B0); PG8_MMA(1, 1, At, B1); PG8_BAR; PG8_SCHED;
            } else {
            PG8_LDB(B0, 0, 0); PG8_SCHED; PG8_LDA(At, 0, 0); PG8_STAGE_A(PG8_SA(1, 1), false, 1, k1);
            PG8_WAIT_L(8); PG8_BAR; PG8_WAIT_L(0); PG8_MMA(0, 0, At, B0); PG8_BAR; PG8_SCHED;
            PG8_LDB(B1, 0, 1); PG8_STAGE(PG8_SB(0, 0), b2, voffB);
            PG8_BAR; PG8_WAIT_L(0); PG8_MMA(0, 1, At, B1); PG8_BAR;
            PG8_LDA(At, 0, 1); PG8_STAGE_A(PG8_SA(0, 0), last, 0, k2);
            PG8_BAR; PG8_WAIT_L(0); PG8_MMA(1, 0, At, B0); PG8_BAR; PG8_SCHED;
            PG8_STAGE(PG8_SB(0, 1), b2 + hstep, voffB);
            PG8_WAIT_V(6); PG8_BAR; PG8_MMA(1, 1, At, B1); PG8_BAR;
            PG8_LDB(B0, 1, 0); PG8_SCHED; PG8_LDA(At, 1, 0); PG8_STAGE_A(PG8_SA(0, 1), last, 1, k2);
            PG8_WAIT_L(8); PG8_BAR; PG8_WAIT_L(0); PG8_MMA(0, 0, At, B0); PG8_BAR; PG8_SCHED;
            PG8_LDB(B1, 1, 1); PG8_STAGE(PG8_SB(1, 0), b3, voffB);
            PG8_BAR; PG8_WAIT_L(0); PG8_MMA(0, 1, At, B1); PG8_BAR;
            PG8_LDA(At, 1, 1); PG8_STAGE_A(PG8_SA(1, 0), last, 0, k3);
            PG8_BAR; PG8_WAIT_L(0); PG8_MMA(1, 0, At, B0); PG8_BAR; PG8_SCHED;
            PG8_STAGE(PG8_SB(1, 1), b3 + hstep, voffB);
            PG8_WAIT_V(6); PG8_BAR; PG8_MMA(1, 1, At, B1); PG8_BAR;
            }
        }
        if constexpr (ALIGN_EPI) { if (wr == 0) PG8_BAR; }
        if constexpr (!Epi::AFTER_DRAIN) { E(acc, cur, wr, wc, fr, fq); S.done(cur); }
        if (!has_next) break;
#pragma unroll
        for (int a = 0; a < 2; ++a)
#pragma unroll
            for (int b = 0; b < 2; ++b)
#pragma unroll
                for (int m = 0; m < 4; ++m)
#pragma unroll
                    for (int n = 0; n < 2; ++n) acc[a][b][m][n] = (f32x4){0.f, 0.f, 0.f, 0.f};
        cur = nxt; cA = nA; cB = nB; ++ui;
        if constexpr (GATHER) { gC[0][0] = gN[0][0]; gC[0][1] = gN[0][1]; gC[1][0] = gN[1][0]; gC[1][1] = gN[1][1]; }
        if constexpr (ALIGN_EPI) { if (wr == 1) PG8_BAR; }
    }
    PG8_WAIT_V(0);
    if constexpr (!ALIGN_EPI) { if (wr == 0) PG8_BAR; }
    PG8_BAR;
    if constexpr (Epi::AFTER_DRAIN) { E.fused(acc, cur, wr, wc, fr, fq, lds, wid, lane); S.done(cur); }
#undef PG8_SA
#undef PG8_SB
#undef PG8_STAGE
#undef PG8_STAGE_A
#undef PG8_LDA
#undef PG8_LDB
#undef PG8_MMA
#undef PG8_WAIT_V
#undef PG8_WAIT_L
#undef PG8_BAR
#undef PG8_SCHED
}
}
constexpr int BATCH = 2, SEQ = 8192, DM = 1024, MTOK = BATCH * SEQ;
constexpr int RH = 4, RQK = 64, RV = 128, CHK = 128, NCH = SEQ / CHK;
constexpr int AH = 8, AD = 64;
constexpr int NE = 16, CAP = 1024, FF = 2048, NSLOT = NE * BATCH * CAP;
constexpr int NPROJ = 3072;
constexpr int C_RQ = 0, C_RK = 256, C_RV = 512, C_RG = 1024, C_AQ = 1536, C_AK = 2048, C_AV = 2560;
constexpr float RMS_EPS = 1e-6f, GN_EPS = 1e-5f;
constexpr float LOG2E = 1.4426950408889634f;
constexpr int NWAVES = 8;
#ifndef MK_ONE_LAUNCH
#define MK_ONE_LAUNCH 1
#endif
constexpr int NPHASE = 13;
constexpr size_t MiB = 1u << 20;
constexpr size_t WS_CTL = 0, CTL_ZERO_BYTES = 1 * MiB;
constexpr size_t WS_MOD = 1 * MiB;
constexpr size_t WS_AFF = 2 * MiB;
constexpr size_t WS_TOK = 3 * MiB;
constexpr size_t WS_GATEV = 3 * MiB + 128 * 1024;
constexpr size_t WS_SLOTOF = 3 * MiB + 256 * 1024;
constexpr size_t WS_LSE = 5 * MiB;
constexpr size_t WS_WIN = 8 * MiB;
constexpr size_t WS_WOUT = 14 * MiB;
constexpr size_t WS_WGU = 16 * MiB;
constexpr size_t WS_WDN = 144 * MiB;
constexpr size_t WS_XN = 208 * MiB;
constexpr size_t WS_R = 240 * MiB;
constexpr size_t WS_PROJ = WS_R;
constexpr size_t WS_KV = WS_R + 96 * MiB;
constexpr size_t WS_PREV = WS_R + 128 * MiB;
constexpr size_t WS_ATTO = WS_R + 144 * MiB;
constexpr size_t WS_Y = WS_R + 192 * MiB;
constexpr size_t WS_MIXED = WS_R;
constexpr size_t WS_XE = WS_R + 64 * MiB;
constexpr size_t WS_HH = WS_R + 128 * MiB;
constexpr size_t WS_YE = WS_R;
constexpr size_t WS_END = WS_R + 256 * MiB;
constexpr int CW_BAR = 4096;
constexpr int RING_BYTES = 131072;
constexpr int LDSCTL_OFF = RING_BYTES, MISC_OFF = LDSCTL_OFF + 320;
constexpr int LDS_BYTES = 147456;

#define GAS __attribute__((address_space(1)))
#define LAS __attribute__((address_space(3)))
typedef unsigned short bf16;
typedef unsigned v4u __attribute__((ext_vector_type(4)));
typedef unsigned v2u __attribute__((ext_vector_type(2)));
typedef float f32x4 __attribute__((ext_vector_type(4)));
typedef float f32x16 __attribute__((ext_vector_type(16)));
typedef short bf16x8 __attribute__((ext_vector_type(8)));
typedef short s16x4 __attribute__((ext_vector_type(4)));
typedef GAS unsigned gu32;
#define RLX_AGENT __ATOMIC_RELAXED, __HIP_MEMORY_SCOPE_AGENT
#define LDS_WAIT() asm volatile("s_waitcnt lgkmcnt(0)" ::: "memory")
typedef float f32x2_t __attribute__((ext_vector_type(2))); typedef __bf16 bf16x2_t __attribute__((ext_vector_type(2)));
__device__ __forceinline__ unsigned pk2(float lo, float hi) { f32x2_t v = {lo, hi}; bf16x2_t b = __builtin_convertvector(v, bf16x2_t); return __builtin_bit_cast(unsigned, b); }
__device__ __forceinline__ float bflo(unsigned w) { return __uint_as_float(w << 16); }
__device__ __forceinline__ float bfhi(unsigned w) { return __uint_as_float(w & 0xffff0000u); }
__device__ __forceinline__ float ex2(float x) { return __builtin_amdgcn_exp2f(x); }
__device__ __forceinline__ int crow(int r, int hi) { return (r & 3) + 8 * (r >> 2) + 4 * hi; }
__device__ __forceinline__ s16x4 vtr(const LAS unsigned char* p) { typedef short v4i16_t __attribute__((ext_vector_type(4))); return __builtin_bit_cast(s16x4, __builtin_amdgcn_ds_read_tr16_b64_v4i16((LAS v4i16_t*)p)); }
__device__ __forceinline__ bf16x8 cat8(s16x4 a, s16x4 b) { return (bf16x8){a[0], a[1], a[2], a[3], b[0], b[1], b[2], b[3]}; }
__device__ __forceinline__ float wave_sum(float v) {
#pragma unroll
    for (int o = 1; o < 64; o <<= 1) v += __shfl_xor(v, o);
    return v;
}
#define XB_TMO      128
#define XB_XCNT(j)  (256  + 64 * (j))
#define XB_XSUB(j)  (1280 + 64 * (j))
#define XB_XGEN(j)  (2304 + 64 * (j))
#define XB_TOP      3328
#define XB_TOPGEN   3392
#define XCD_BAR_WORDS 3456
#define XB_SPIN_CAP (1u << 18)

__device__ __forceinline__ unsigned xb_ld(unsigned* p)              { return __hip_atomic_load(p, __ATOMIC_RELAXED, __HIP_MEMORY_SCOPE_AGENT); }
__device__ __forceinline__ unsigned xb_add(unsigned* p, unsigned v) { return __hip_atomic_fetch_add(p, v, __ATOMIC_RELAXED, __HIP_MEMORY_SCOPE_AGENT); }
__device__ __forceinline__ unsigned xb_xcc_id() { return (unsigned)__builtin_amdgcn_s_getreg((3 << 11) | 20) & 0xFu; }
#define XB_SPIN(cond, bar) do { unsigned _sp = 0; while (cond) { __builtin_amdgcn_s_sleep(1); \
    if ((++_sp & 255u) == 0u) { if (xb_ld(&(bar)[XB_TMO])) break; if (_sp > XB_SPIN_CAP) { atomicAdd(&(bar)[XB_TMO], 1u); break; } } } } while (0)

struct XcdBarrier {
    unsigned* bar; unsigned x;
    volatile LAS unsigned* st;
};

__device__ __forceinline__ XcdBarrier xcd_barrier_post(unsigned* bar, volatile LAS unsigned* st) {
    XcdBarrier b; b.bar = bar; b.x = xb_xcc_id(); b.st = st;
    if (threadIdx.x == 0) (void)xb_add(&bar[XB_XCNT(b.x)], 1u);
    return b;
}
__device__ __forceinline__ void xcd_barrier_complete(unsigned* bar, unsigned x, unsigned& nloc, unsigned& nx) {
    const unsigned G = gridDim.x * gridDim.y * gridDim.z;
    unsigned sum, cnt, mine, sp = 0u;
    for (;;) {
        sum = 0u; cnt = 0u; mine = 0u;
#pragma unroll
        for (unsigned j = 0; j < 16; ++j) { const unsigned c = xb_ld(&bar[XB_XCNT(j)]); sum += c; cnt += (c > 0u) ? 1u : 0u; mine = (j == x) ? c : mine; }
        if (sum == G) break;
        __builtin_amdgcn_s_sleep(1);
        if ((++sp & 255u) == 0u) { if (xb_ld(&bar[XB_TMO])) break; if (sp > XB_SPIN_CAP) { atomicAdd(&bar[XB_TMO], 1u); break; } }
    }
    nloc = mine > 0u ? mine : 1u; nx = cnt > 0u ? cnt : 1u;
}

__device__ __forceinline__ void xcd_barrier(const XcdBarrier& b) {
    asm volatile("s_waitcnt vmcnt(0)" ::: "memory");
    __syncthreads();
    if (threadIdx.x == 0) {
        unsigned* bar = b.bar;
        __builtin_amdgcn_s_waitcnt(0);
        unsigned nloc = b.st[0], nx = b.st[1];
        if (nloc == 0u) { xcd_barrier_complete(bar, b.x, nloc, nx); b.st[0] = nloc; b.st[1] = nx; }
        const unsigned old = xb_add(&bar[XB_XSUB(b.x)], 1u);
        const unsigned gen = old / nloc;
        if (old + 1u == (gen + 1u) * nloc) {
            __builtin_amdgcn_fence(__ATOMIC_RELEASE, "agent");
            asm volatile("s_waitcnt vmcnt(0)" ::: "memory");
            const unsigned og = xb_add(&bar[XB_TOP], 1u);
            const unsigned tg = og / nx;
            if (og + 1u == (tg + 1u) * nx) xb_add(&bar[XB_TOPGEN], 1u);
            else XB_SPIN(xb_ld(&bar[XB_TOPGEN]) == tg, bar);
            __builtin_amdgcn_fence(__ATOMIC_ACQUIRE, "agent");
            xb_add(&bar[XB_XGEN(b.x)], 1u);
            asm volatile("s_waitcnt vmcnt(0)" ::: "memory");
        } else {
            XB_SPIN(xb_ld(&bar[XB_XGEN(b.x)]) == gen, bar);
            __builtin_amdgcn_fence(__ATOMIC_ACQUIRE, "agent");
            asm volatile("s_waitcnt vmcnt(0)" ::: "memory");
        }
    }
    __syncthreads();
}
struct Frame {
    LAS unsigned char* lds;
    volatile LAS unsigned* MISC;
    gu32* ctl;
    int tid, lane, wave;
    int vcu, G;
    const float *x, *c, *w_ada, *b_ada, *g_pre_mix, *g_post_mix, *g_pre_ffn, *g_post_ffn, *w_in, *dec_f, *dec_b, *w_out, *w_router, *w_gate, *w_up, *w_down;
    float* out;
    float *MOD, *AFF, *GATEV, *LSE, *KV, *MIXED;
    int *TOK, *SLOTOF;
    bf16 *WIN, *WOUT, *WGU, *WDN, *XN, *PROJ, *PREV, *ATTO, *Y, *XE, *HH, *YE;
};

__device__ __forceinline__ void p0_transpose_item(const float* W, int K, int N, bf16* WT, int k0, int n0, int drow0, LAS float* scr, int lane) {
#pragma unroll 8
    for (int i = 0; i < 32; ++i) { const int kk = 2 * i + (lane >> 5); scr[kk * 33 + (lane & 31)] = W[(size_t)(k0 + kk) * N + n0 + (lane & 31)]; }
    LDS_WAIT(); asm volatile("" ::: "memory");
    const int c = lane & 7;
#pragma unroll
    for (int j = 0; j < 4; ++j) { const int n = (lane >> 3) + 8 * j; const LAS float* s = scr + (8 * c) * 33 + n;
        v4u o; o.x = pk2(s[0 * 33], s[1 * 33]); o.y = pk2(s[2 * 33], s[3 * 33]); o.z = pk2(s[4 * 33], s[5 * 33]); o.w = pk2(s[6 * 33], s[7 * 33]);
        *(GAS v4u*)(WT + (size_t)(drow0 + n) * K + k0 + 8 * c) = o; }
    LDS_WAIT(); asm volatile("" ::: "memory");
}
__device__ __forceinline__ void phase_p0a(Frame& F) {
    LAS float* sc = (LAS float*)(F.lds + 98304);
    for (int i = F.tid; i < 2 * DM; i += NWAVES * 64) { const float v = F.c[i]; sc[i] = v / (1.f + __expf(-v)); }
    __syncthreads();
    { const int gwm = F.wave * F.G + F.vcu;
      for (int it = gwm; it < 6 * DM / 16; it += F.G * NWAVES) {
        const int col = it * 16 + (F.lane & 15), kq = F.lane >> 4; float a0 = 0.f, a1 = 0.f;
#pragma unroll 8
        for (int k = kq; k < DM; k += 4) { const float w = F.w_ada[(size_t)k * (6 * DM) + col]; a0 += sc[k] * w; a1 += sc[DM + k] * w; }
        a0 += __shfl_xor(a0, 16); a0 += __shfl_xor(a0, 32); a1 += __shfl_xor(a1, 16); a1 += __shfl_xor(a1, 32);
        if (kq == 0) { const float bb = F.b_ada[col]; F.MOD[col] = a0 + bb; F.MOD[6 * DM + col] = a1 + bb; }
      } }
    LAS float* scr = (LAS float*)(F.lds + F.wave * 12288);
    const int gw = F.vcu * NWAVES + F.wave, NGW = F.G * NWAVES;
    constexpr int I_IN = (DM / 64) * (NPROJ / 32), I_OUT = (DM / 64) * (DM / 32), I_G1 = (DM / 64) * (FF / 32), I_G = NE * I_G1, I_D1 = (FF / 64) * (DM / 32), I_D = NE * I_D1;
    constexpr int NITEMS = I_IN + I_OUT + 2 * I_G + I_D;
    for (int it = gw; it < NITEMS; it += NGW) {
        int r = it;
        if (r < I_IN) { const int nblk = NPROJ / 32, kb = r / nblk, nb = r % nblk; p0_transpose_item(F.w_in, DM, NPROJ, F.WIN, 64 * kb, 32 * nb, 32 * nb, scr, F.lane); continue; } r -= I_IN;
        if (r < I_OUT) { const int nblk = DM / 32, kb = r / nblk, nb = r % nblk; p0_transpose_item(F.w_out, DM, DM, F.WOUT, 64 * kb, 32 * nb, 32 * nb, scr, F.lane); continue; } r -= I_OUT;
        if (r < 2 * I_G) { const int half = r / I_G; r -= half * I_G; const int e = r / I_G1, q = r % I_G1, nblk = FF / 32, kb = q / nblk, nb = q % nblk, n0 = 32 * nb;
            const float* W = (half ? F.w_up : F.w_gate) + (size_t)e * DM * FF;
            p0_transpose_item(W, DM, FF, F.WGU + (size_t)e * (2 * FF) * DM, 64 * kb, n0, (n0 >> 7) * 256 + half * 128 + (n0 & 127), scr, F.lane); continue; } r -= 2 * I_G;
        { const int e = r / I_D1, q = r % I_D1, nblk = DM / 32, kb = q / nblk, nb = q % nblk;
          p0_transpose_item(F.w_down + (size_t)e * FF * DM, FF, DM, F.WDN + (size_t)e * DM * FF, 64 * kb, 32 * nb, 32 * nb, scr, F.lane); }
    }
}
__device__ __forceinline__ void phase_p0b(Frame& F) {
    const int gw = F.vcu * NWAVES + F.wave, NGW = F.G * NWAVES;
    for (int m = gw; m < MTOK; m += NGW) {
        const int b = m / SEQ; const float* mod = F.MOD + b * 6 * DM;
        const GAS f32x4* xr = (const GAS f32x4*)(F.x + (size_t)m * DM) + F.lane;
        f32x4 v[4]; float s = 0.f;
#pragma unroll
        for (int j = 0; j < 4; ++j) { v[j] = xr[64 * j]; s += (v[j].x * v[j].x + v[j].y * v[j].y) + (v[j].z * v[j].z + v[j].w * v[j].w); }
        const float r = 1.f / sqrtf(wave_sum(s) * (1.f / DM) + RMS_EPS);
        GAS v2u* o8 = (GAS v2u*)(F.XN + (size_t)m * DM) + F.lane;
#pragma unroll
        for (int j = 0; j < 4; ++j) { const int c = 4 * F.lane + 256 * j;
            const f32x4 g = *(const f32x4*)(F.g_pre_mix + c), sc = *(const f32x4*)(mod + DM + c), sh = *(const f32x4*)(mod + c);
            const f32x4 h = v[j] * r * g * (sc + 1.f) + sh;
            v2u w; w.x = pk2(h.x, h.y); w.y = pk2(h.z, h.w); o8[64 * j] = w; }
    }
}
__device__ __forceinline__ float lg2_sigmoid(float x) { return -log1pf(__expf(-x)) * LOG2E; }
__device__ __forceinline__ void attn_unit(Frame& F, int b, int h, int cfg, int r, int qblk) {
    const int d = (cfg == 0) ? 1 : ((cfg == 1) ? 4 : 16), L = SEQ / d;
    const int tid = F.tid, wave = F.wave; int lane = F.lane; asm volatile("" : "+v"(lane));
    const int i = lane & 31, hi = lane >> 5;
    const bf16* P = F.PROJ + (size_t)b * SEQ * NPROJ;
    const int wl0 = 256 * qblk - 64;
    LAS unsigned char* Vl = F.lds;
#pragma unroll
    for (int p = 0; p < 6; ++p) {
        const int kidx = p * 64 + (tid >> 3), ch = tid & 7;
        int l = wl0 + kidx; l = l < 0 ? 0 : (l > L - 1 ? L - 1 : l);
        const v4u val = *(const v4u*)(P + (size_t)(l * d + r) * NPROJ + C_AV + h * AD + ch * 8);
        *(LAS v4u*)(Vl + (ch >> 2) * (384 * 64) + (kidx >> 3) * 512 + (kidx & 7) * 64 + (ch & 3) * 16) = val;
    }
    __syncthreads();
    const int lw0 = 256 * qblk + 32 * wave - 64;
    const int ql = 256 * qblk + 32 * wave + i;
    bf16x8 qf[4];
    { const bf16* qp = P + (size_t)(ql * d + r) * NPROJ + C_AQ + h * AD + hi * 8;
#pragma unroll
      for (int s = 0; s < 4; ++s) qf[s] = *(const bf16x8*)(qp + 16 * s); }
    f32x16 acc[5];
    bf16x8 kf[2][4];
#define ATT_LOADK(T, buf) do { int kl_ = lw0 + 32 * (T) + i; kl_ = kl_ < 0 ? 0 : (kl_ > L - 1 ? L - 1 : kl_); const bf16* kp_ = P + (size_t)(kl_ * d + r) * NPROJ + C_AK + h * AD + hi * 8; \
        _Pragma("unroll") for (int s_ = 0; s_ < 4; ++s_) kf[buf][s_] = *(const bf16x8*)(kp_ + 16 * s_); } while (0)
    ATT_LOADK(0, 0);
#pragma unroll
    for (int T = 0; T < 5; ++T) {
        if (T + 1 < 5) ATT_LOADK(T + 1, (T + 1) & 1);
        asm volatile("" ::: "memory");
        f32x16 a = {};
#pragma unroll
        for (int s = 0; s < 4; ++s) a = __builtin_amdgcn_mfma_f32_32x32x16_bf16(kf[T & 1][s], qf[s], a, 0, 0, 0);
        acc[T] = a;
    }
#undef ATT_LOADK
    const float slope2 = ex2(-(float)(h + 1)) * (float)d * LOG2E;
    float mx = -3.0e38f;
#pragma unroll
    for (int T = 0; T < 5; ++T)
#pragma unroll
        for (int rr = 0; rr < 16; ++rr) {
            const int j = 32 * T + crow(rr, hi); int dist = i + 64 - j; dist = dist < 0 ? -dist : dist; const int kl = lw0 + j;
            const bool valid = (dist <= 64) && (kl >= 0) && (kl < L);
            const float sv = valid ? acc[T][rr] - slope2 * (float)dist : -1.0e30f;
            acc[T][rr] = sv; mx = fmaxf(mx, sv);
        }
    mx = fmaxf(mx, __shfl_xor(mx, 32));
    float lsum = 0.f;
#pragma unroll
    for (int T = 0; T < 5; ++T)
#pragma unroll
        for (int rr = 0; rr < 16; ++rr) { const float p = ex2(acc[T][rr] - mx); acc[T][rr] = p; lsum += p; }
    lsum += __shfl_xor(lsum, 32);
    f32x16 o[2]; o[0] = f32x16{}; o[1] = f32x16{};
    const LAS unsigned char* vb = Vl + ((lane >> 4) & 1) * 32 + (lane & 3) * 8 + (4 * hi + ((lane & 15) >> 2)) * 64;
#pragma unroll
    for (int T = 0; T < 5; ++T)
#pragma unroll
        for (int u = 0; u < 2; ++u) {
            v4u pw; pw.x = pk2(acc[T][8 * u + 0], acc[T][8 * u + 1]); pw.y = pk2(acc[T][8 * u + 2], acc[T][8 * u + 3]); pw.z = pk2(acc[T][8 * u + 4], acc[T][8 * u + 5]); pw.w = pk2(acc[T][8 * u + 6], acc[T][8 * u + 7]);
            const bf16x8 pb = __builtin_bit_cast(bf16x8, pw);
            const int kbase = 32 * wave + 32 * T + 16 * u;
#pragma unroll
            for (int dt = 0; dt < 2; ++dt) {
                const LAS unsigned char* a = vb + dt * (384 * 64) + (kbase >> 3) * 512;
                const bf16x8 va = cat8(vtr(a), vtr(a + 512));
                o[dt] = __builtin_amdgcn_mfma_f32_32x32x16_bf16(va, pb, o[dt], 0, 0, 0);
            }
            asm volatile("" ::: "memory");
        }
    const float inv = 1.f / lsum;
    const size_t row = (size_t)b * SEQ + (size_t)(ql * d + r);
    bf16* op = F.ATTO + ((size_t)cfg * MTOK + row) * (AH * AD) + h * AD;
#pragma unroll
    for (int dt = 0; dt < 2; ++dt)
#pragma unroll
        for (int g = 0; g < 4; ++g) { v2u w; w.x = pk2(o[dt][4 * g] * inv, o[dt][4 * g + 1] * inv); w.y = pk2(o[dt][4 * g + 2] * inv, o[dt][4 * g + 3] * inv);
            *(v2u*)(op + 32 * dt + 8 * g + 4 * hi) = w; }
    if (hi == 0) F.LSE[((size_t)cfg * MTOK + row) * AH + h] = mx + __builtin_amdgcn_logf(lsum);
    __syncthreads();
}
__device__ __forceinline__ void kv_unit(Frame& F, int b, int h, int n) {
    const int tid = F.tid, wave = F.wave; int lane = F.lane; asm volatile("" : "+v"(lane));
    const int hi = lane >> 5;
    const float lgf = lg2_sigmoid(F.dec_f[h]), lgb = lg2_sigmoid(F.dec_b[h]);
    const size_t row0 = (size_t)b * SEQ + (size_t)n * CHK;
    LAS unsigned char* Vl = F.lds;
    LAS unsigned char* Kl = F.lds + 32768;
#pragma unroll
    for (int p = 0; p < 4; ++p) { const int idx = p * 512 + tid, key = idx >> 4, ch = idx & 15;
        const v4u val = *(const v4u*)(F.PROJ + (row0 + key) * NPROJ + C_RV + h * RV + ch * 8);
        *(LAS v4u*)(Vl + (ch >> 2) * (128 * 64) + (key >> 3) * 512 + (key & 7) * 64 + (ch & 3) * 16) = val; }
#pragma unroll
    for (int p = 0; p < 2; ++p) { const int idx = p * 512 + tid, key = idx >> 3, ch = idx & 7;
        const v4u val = *(const v4u*)(F.PROJ + (row0 + key) * NPROJ + C_RK + h * RQK + ch * 8);
        const float sf = ex2(lgf * (float)(127 - key)), sb = ex2(lgb * (float)key);
        v4u wf, wb;
        wf.x = pk2(bflo(val.x) * sf, bfhi(val.x) * sf); wf.y = pk2(bflo(val.y) * sf, bfhi(val.y) * sf); wf.z = pk2(bflo(val.z) * sf, bfhi(val.z) * sf); wf.w = pk2(bflo(val.w) * sf, bfhi(val.w) * sf);
        wb.x = pk2(bflo(val.x) * sb, bfhi(val.x) * sb); wb.y = pk2(bflo(val.y) * sb, bfhi(val.y) * sb); wb.z = pk2(bflo(val.z) * sb, bfhi(val.z) * sb); wb.w = pk2(bflo(val.w) * sb, bfhi(val.w) * sb);
        const int off = (ch >> 2) * (128 * 64) + (key >> 3) * 512 + (key & 7) * 64 + (ch & 3) * 16;
        *(LAS v4u*)(Kl + off) = wf; *(LAS v4u*)(Kl + 16384 + off) = wb; }
    __syncthreads();
    const int dir = wave >> 2, dvt = wave & 3;
    const int lofs = ((lane >> 4) & 1) * 32 + (lane & 3) * 8 + (4 * hi + ((lane & 15) >> 2)) * 64;
    const LAS unsigned char* va = Vl + dvt * (128 * 64) + lofs;
    float* kvout = F.KV + ((size_t)(((b * RH + h) * 2 + dir) * NCH + n)) * (RV * RQK);
#pragma unroll
    for (int dkt = 0; dkt < 2; ++dkt) {
        const LAS unsigned char* ka = Kl + dir * 16384 + dkt * (128 * 64) + lofs;
        f32x16 a = {};
#pragma unroll
        for (int s = 0; s < 8; ++s) {
            const bf16x8 A = cat8(vtr(va + s * 1024), vtr(va + s * 1024 + 512));
            const bf16x8 B = cat8(vtr(ka + s * 1024), vtr(ka + s * 1024 + 512));
            a = __builtin_amdgcn_mfma_f32_32x32x16_bf16(A, B, a, 0, 0, 0);
        }
#pragma unroll
        for (int rr = 0; rr < 16; ++rr) kvout[(32 * dvt + crow(rr, hi)) * RQK + 32 * dkt + (lane & 31)] = a[rr];
    }
    __syncthreads();
}
__device__ __forceinline__ void phase_p2(Frame& F) {
    constexpr int NATT = BATCH * AH * 3 * (SEQ / 256);
    for (int u = F.vcu; u < NATT; u += F.G) {
        const int blk = u & 31, h = (u >> 5) & 7, b = (u >> 8) & 1, cfg = u >> 9;
        const int d = (cfg == 0) ? 1 : ((cfg == 1) ? 4 : 16), nq = (SEQ / d) / 256;
        attn_unit(F, b, h, cfg, blk / nq, blk % nq);
    }
    constexpr int NKV = BATCH * RH * NCH;
    for (int u = F.vcu; u < NKV; u += F.G) kv_unit(F, u >> 8, (u >> 6) & 3, u & 63);
}
__device__ __forceinline__ void phase_p3(Frame& F) {
    for (int g = F.vcu * (NWAVES * 64) + F.tid; g < BATCH * RH * 2 * (RV * RQK); g += F.G * NWAVES * 64) {
        const int bhd = g >> 13, e = g & 8191, dir = bhd & 1, h = (bhd >> 1) & 3;
        const float lam = ex2(128.f * lg2_sigmoid(dir ? F.dec_b[h] : F.dec_f[h]));
        const float* kv = F.KV + (size_t)bhd * NCH * 8192 + e; bf16* pv = F.PREV + (size_t)bhd * NCH * 8192 + e;
        float st = 0.f;
        for (int n0 = 0; n0 < NCH; n0 += 8) {
            float v[8];
#pragma unroll
            for (int k = 0; k < 8; ++k) { const int n = dir ? (NCH - 1 - (n0 + k)) : (n0 + k); v[k] = kv[(size_t)n * 8192]; }
#pragma unroll
            for (int k = 0; k < 8; ++k) { const int n = dir ? (NCH - 1 - (n0 + k)) : (n0 + k); pv[(size_t)n * 8192] = (bf16)(pk2(st, 0.f) & 0xffffu); st = lam * st + v[k]; }
        }
    }
    const int gw = F.vcu * NWAVES + F.wave, NGW = F.G * NWAVES;
    for (int m = gw; m < MTOK; m += NGW) {
        const int hd = F.lane >> 3, part = F.lane & 7;
        const float l0 = F.LSE[(size_t)m * AH + hd], l1 = F.LSE[((size_t)MTOK + m) * AH + hd], l2 = F.LSE[((size_t)2 * MTOK + m) * AH + hd];
        const float mx = fmaxf(l0, fmaxf(l1, l2)); float w0 = ex2(l0 - mx), w1 = ex2(l1 - mx), w2 = ex2(l2 - mx); const float inv = 1.f / (w0 + w1 + w2); w0 *= inv; w1 *= inv; w2 *= inv;
        const v4u a = *(const v4u*)(F.ATTO + (size_t)m * 512 + F.lane * 8), bq = *(const v4u*)(F.ATTO + ((size_t)MTOK + m) * 512 + F.lane * 8), cq = *(const v4u*)(F.ATTO + ((size_t)2 * MTOK + m) * 512 + F.lane * 8);
        (void)part;
        v4u o;
        o.x = pk2(w0 * bflo(a.x) + w1 * bflo(bq.x) + w2 * bflo(cq.x), w0 * bfhi(a.x) + w1 * bfhi(bq.x) + w2 * bfhi(cq.x));
        o.y = pk2(w0 * bflo(a.y) + w1 * bflo(bq.y) + w2 * bflo(cq.y), w0 * bfhi(a.y) + w1 * bfhi(bq.y) + w2 * bfhi(cq.y));
        o.z = pk2(w0 * bflo(a.z) + w1 * bflo(bq.z) + w2 * bflo(cq.z), w0 * bfhi(a.z) + w1 * bfhi(bq.z) + w2 * bfhi(cq.z));
        o.w = pk2(w0 * bflo(a.w) + w1 * bflo(bq.w) + w2 * bflo(cq.w), w0 * bfhi(a.w) + w1 * bfhi(bq.w) + w2 * bfhi(cq.w));
        *(v4u*)(F.Y + (size_t)m * DM + 512 + F.lane * 8) = o;
    }
}
__device__ __forceinline__ bf16x8 scale8(bf16x8 q, float s) {
    const v4u w = __builtin_bit_cast(v4u, q); v4u o;
    o.x = pk2(bflo(w.x) * s, bfhi(w.x) * s); o.y = pk2(bflo(w.y) * s, bfhi(w.y) * s); o.z = pk2(bflo(w.z) * s, bfhi(w.z) * s); o.w = pk2(bflo(w.w) * s, bfhi(w.w) * s);
    return __builtin_bit_cast(bf16x8, o);
}
__device__ __forceinline__ void ret_pair(Frame& F, int pair) {
    const int tid = F.tid, wave = F.wave; int lane = F.lane; asm volatile("" : "+v"(lane));
    const int i = lane & 31, hi = lane >> 5, grp = wave >> 2, w4 = wave & 3;
    const int cid = 2 * pair + grp, n = cid & 63, h = (cid >> 6) & 3, b = cid >> 8;
    const float lgf = lg2_sigmoid(F.dec_f[h]), lgb = lg2_sigmoid(F.dec_b[h]);
    const size_t row0 = (size_t)b * SEQ + (size_t)n * CHK;
    LAS unsigned char* Vl = F.lds + grp * 32768;
#pragma unroll
    for (int p = 0; p < 8; ++p) { const int idx = p * 256 + (tid & 255), key = idx >> 4, ch = idx & 15;
        const v4u val = *(const v4u*)(F.PROJ + (row0 + key) * NPROJ + C_RV + h * RV + ch * 8);
        *(LAS v4u*)(Vl + (ch >> 2) * (128 * 64) + (key >> 3) * 512 + (key & 7) * 64 + (ch & 3) * 16) = val; }
    __syncthreads();
    const int qi = 32 * w4 + i; const size_t qrow = row0 + qi;
    bf16x8 qf[4];
    { const bf16* qp = F.PROJ + qrow * NPROJ + C_RQ + h * RQK + hi * 8;
#pragma unroll
      for (int s = 0; s < 4; ++s) qf[s] = *(const bf16x8*)(qp + 16 * s); }
    f32x16 acc[4];
    bf16x8 kf[2][4];
#define RET_LOADK(T, buf) do { const bf16* kp_ = F.PROJ + (row0 + 32 * (T) + i) * NPROJ + C_RK + h * RQK + hi * 8; \
        _Pragma("unroll") for (int s_ = 0; s_ < 4; ++s_) kf[buf][s_] = *(const bf16x8*)(kp_ + 16 * s_); } while (0)
    RET_LOADK(0, 0);
#pragma unroll
    for (int T = 0; T < 4; ++T) {
        if (T + 1 < 4) RET_LOADK(T + 1, (T + 1) & 1);
        asm volatile("" ::: "memory");
        f32x16 a = {};
#pragma unroll
        for (int s = 0; s < 4; ++s) a = __builtin_amdgcn_mfma_f32_32x32x16_bf16(kf[T & 1][s], qf[s], a, 0, 0, 0);
        acc[T] = a;
    }
#undef RET_LOADK
#pragma unroll
    for (int T = 0; T < 4; ++T)
#pragma unroll
        for (int rr = 0; rr < 16; ++rr) { const int rel = qi - (32 * T + crow(rr, hi)); const float e = rel >= 0 ? lgf * (float)rel : -lgb * (float)rel; acc[T][rr] *= ex2(e); }
    f32x16 o[4]; o[0] = f32x16{}; o[1] = f32x16{}; o[2] = f32x16{}; o[3] = f32x16{};
    const LAS unsigned char* vb = Vl + ((lane >> 4) & 1) * 32 + (lane & 3) * 8 + (4 * hi + ((lane & 15) >> 2)) * 64;
#pragma unroll
    for (int T = 0; T < 4; ++T)
#pragma unroll
        for (int u = 0; u < 2; ++u) {
            v4u pw; pw.x = pk2(acc[T][8 * u + 0], acc[T][8 * u + 1]); pw.y = pk2(acc[T][8 * u + 2], acc[T][8 * u + 3]); pw.z = pk2(acc[T][8 * u + 4], acc[T][8 * u + 5]); pw.w = pk2(acc[T][8 * u + 6], acc[T][8 * u + 7]);
            const bf16x8 pb = __builtin_bit_cast(bf16x8, pw);
#pragma unroll
            for (int dvt = 0; dvt < 4; ++dvt) {
                const LAS unsigned char* a = vb + dvt * (128 * 64) + (4 * T + 2 * u) * 512;
                o[dvt] = __builtin_amdgcn_mfma_f32_32x32x16_bf16(cat8(vtr(a), vtr(a + 512)), pb, o[dvt], 0, 0, 0);
            }
            asm volatile("" ::: "memory");
        }
    {
        const float sf = ex2(lgf * (float)(qi + 1)), sb = ex2(lgb * (float)(CHK - qi));
        const bf16* pf = F.PREV + ((size_t)(((b * RH + h) * 2 + 0) * NCH + n)) * (RV * RQK) + (size_t)i * RQK + hi * 8;
        const bf16* pb_ = F.PREV + ((size_t)(((b * RH + h) * 2 + 1) * NCH + n)) * (RV * RQK) + (size_t)i * RQK + hi * 8;
#pragma unroll
        for (int s = 0; s < 4; ++s) {
            const bf16x8 qs_f = scale8(qf[s], sf), qs_b = scale8(qf[s], sb);
#pragma unroll
            for (int dvt = 0; dvt < 4; ++dvt) {
                const bf16x8 af = *(const bf16x8*)(pf + dvt * 32 * RQK + 16 * s), ab = *(const bf16x8*)(pb_ + dvt * 32 * RQK + 16 * s);
                o[dvt] = __builtin_amdgcn_mfma_f32_32x32x16_bf16(af, qs_f, o[dvt], 0, 0, 0);
                o[dvt] = __builtin_amdgcn_mfma_f32_32x32x16_bf16(ab, qs_b, o[dvt], 0, 0, 0);
            }
            asm volatile("" ::: "memory");
        }
    }
    float s1 = 0.f;
#pragma unroll
    for (int dvt = 0; dvt < 4; ++dvt)
#pragma unroll
        for (int rr = 0; rr < 16; ++rr) s1 += o[dvt][rr];
    s1 += __shfl_xor(s1, 32); const float mean = s1 * (1.f / RV);
    float s2 = 0.f;
#pragma unroll
    for (int dvt = 0; dvt < 4; ++dvt)
#pragma unroll
        for (int rr = 0; rr < 16; ++rr) { const float dlt = o[dvt][rr] - mean; s2 += dlt * dlt; }
    s2 += __shfl_xor(s2, 32); const float rstd = 1.f / sqrtf(s2 * (1.f / RV) + GN_EPS);
    const bf16* gp = F.PROJ + qrow * NPROJ + C_RG + h * RV; bf16* yp = F.Y + qrow * DM + h * RV;
#pragma unroll
    for (int dvt = 0; dvt < 4; ++dvt)
#pragma unroll
        for (int g = 0; g < 4; ++g) { const int dv = 32 * dvt + 8 * g + 4 * hi; const v2u gw = *(const v2u*)(gp + dv);
            float gv[4] = {bflo(gw.x), bfhi(gw.x), bflo(gw.y), bfhi(gw.y)}; float yv[4];
#pragma unroll
            for (int k = 0; k < 4; ++k) { const float sg = gv[k] * __builtin_amdgcn_rcpf(1.f + ex2(-gv[k] * LOG2E)); yv[k] = sg * (o[dvt][4 * g + k] - mean) * rstd; }
            v2u w; w.x = pk2(yv[0], yv[1]); w.y = pk2(yv[2], yv[3]); *(v2u*)(yp + dv) = w; }
    __syncthreads();
}
__device__ __forceinline__ void phase_p4(Frame& F) { for (int p = F.vcu; p < BATCH * RH * NCH / 2; p += F.G) ret_pair(F, p); }
constexpr int WR_PITCH = DM + 4;
__device__ __forceinline__ void phase_p6(Frame& F) {
    LAS float* wr = (LAS float*)F.lds;
    for (int idx = F.tid; idx < DM * NE; idx += NWAVES * 64) wr[(idx & 15) * WR_PITCH + (idx >> 4)] = F.w_router[idx];
    __syncthreads();
    const int gw = F.vcu * NWAVES + F.wave, NGW = F.G * NWAVES, lane = F.lane;
    for (int m = gw; m < MTOK; m += NGW) {
        const int b = m / SEQ, spos = m % SEQ; const float* mod = F.MOD + b * 6 * DM;
        const GAS f32x4* mr = (const GAS f32x4*)(F.MIXED + (size_t)m * DM) + lane;
        const GAS f32x4* xr = (const GAS f32x4*)(F.x + (size_t)m * DM) + lane;
        f32x4 v[4], xv[4]; float s = 0.f;
#pragma unroll
        for (int j = 0; j < 4; ++j) { v[j] = mr[64 * j]; xv[j] = xr[64 * j]; s += (v[j].x * v[j].x + v[j].y * v[j].y) + (v[j].z * v[j].z + v[j].w * v[j].w); }
        const float r1 = 1.f / sqrtf(wave_sum(s) * (1.f / DM) + RMS_EPS);
        float s2 = 0.f;
        GAS f32x4* orow = (GAS f32x4*)(F.out + (size_t)m * DM) + lane;
#pragma unroll
        for (int j = 0; j < 4; ++j) { const int c = 4 * lane + 256 * j;
            const f32x4 g = *(const f32x4*)(F.g_post_mix + c), gm = *(const f32x4*)(mod + 2 * DM + c);
            xv[j] = xv[j] + gm * (v[j] * r1 * g); orow[64 * j] = xv[j];
            s2 += (xv[j].x * xv[j].x + xv[j].y * xv[j].y) + (xv[j].z * xv[j].z + xv[j].w * xv[j].w); }
        const float r2 = 1.f / sqrtf(wave_sum(s2) * (1.f / DM) + RMS_EPS);
        GAS v2u* h8 = (GAS v2u*)(F.XN + (size_t)m * DM) + lane;
        float lg[NE];
#pragma unroll
        for (int e = 0; e < NE; ++e) lg[e] = 0.f;
#pragma unroll
        for (int j = 0; j < 4; ++j) { const int c = 4 * lane + 256 * j;
            const f32x4 g = *(const f32x4*)(F.g_pre_ffn + c), sc = *(const f32x4*)(mod + 4 * DM + c), sh = *(const f32x4*)(mod + 3 * DM + c);
            const f32x4 h = xv[j] * r2 * g * (sc + 1.f) + sh;
            v2u w; w.x = pk2(h.x, h.y); w.y = pk2(h.z, h.w); h8[64 * j] = w;
#pragma unroll
            for (int e = 0; e < NE; ++e) { const f32x4 wv = *(const LAS f32x4*)(wr + e * WR_PITCH + c); lg[e] += (h.x * wv.x + h.y * wv.y) + (h.z * wv.z + h.w * wv.w); }
            asm volatile("" ::: "memory"); }
        float mxl = -3.0e38f;
#pragma unroll
        for (int e = 0; e < NE; ++e) { lg[e] = wave_sum(lg[e]); mxl = fmaxf(mxl, lg[e]); }
        float den = 0.f;
#pragma unroll
        for (int e = 0; e < NE; ++e) { lg[e] = __expf(lg[e] - mxl); den += lg[e]; }
        const float invd = 1.f / den; float mine = 0.f;
#pragma unroll
        for (int e = 0; e < NE; ++e) mine = (lane == e) ? lg[e] * invd : mine;
        if (lane < NE) F.AFF[((size_t)b * NE + lane) * SEQ + spos] = mine;
    }
}
__device__ __forceinline__ int block_excl_scan(int v, LAS int* wsum, int tid, int lane, int wave, int& total) {
    int inc = v;
#pragma unroll
    for (int o = 1; o < 64; o <<= 1) { const int t = __shfl_up(inc, o); if (lane >= o) inc += t; }
    __syncthreads();
    if (lane == 63) wsum[wave] = inc;
    __syncthreads();
    int base = 0, tot = 0;
#pragma unroll
    for (int w = 0; w < NWAVES; ++w) { const int t = wsum[w]; if (w < wave) base += t; tot += t; }
    total = tot; (void)tid;
    return base + inc - v;
}
__device__ __forceinline__ void phase_p7(Frame& F) {
    if (F.vcu >= BATCH * NE) return;
    const int be = F.vcu, b = be / NE, e = be % NE, tid = F.tid;
    LAS int* hist = (LAS int*)F.lds; LAS int* wsum = hist + 256; LAS int* bc = hist + 272;
    const float* a = F.AFF + (size_t)be * SEQ;
    unsigned v[16];
#pragma unroll
    for (int q = 0; q < 4; ++q) { const v4u t = *(const v4u*)(a + tid * 16 + q * 4); v[4 * q] = t.x; v[4 * q + 1] = t.y; v[4 * q + 2] = t.z; v[4 * q + 3] = t.w; }
    unsigned prefix = 0u; int kk = CAP;
#pragma unroll 1
    for (int pass = 0; pass < 4; ++pass) {
        const int shift = 24 - 8 * pass; const unsigned hmask = (pass == 0) ? 0u : (0xffffffffu << (shift + 8));
        if (tid < 256) hist[tid] = 0;
        __syncthreads();
#pragma unroll
        for (int q = 0; q < 16; ++q) { if (((v[q] ^ prefix) & hmask) == 0u) __hip_atomic_fetch_add(&hist[(v[q] >> shift) & 255u], 1, __ATOMIC_RELAXED, __HIP_MEMORY_SCOPE_WORKGROUP); }
        __syncthreads();
        {
            const int hc = (tid < 256) ? hist[255 - tid] : 0; int tot_;
            const int excl = block_excl_scan(hc, wsum, tid, F.lane, F.wave, tot_);
            if (tid < 256 && excl < kk && kk <= excl + hc) { bc[0] = 255 - tid; bc[1] = kk - excl; }
        }
        __syncthreads();
        prefix |= (unsigned)bc[0] << shift; kk = bc[1];
        __syncthreads();
    }
    int ceq = 0;
#pragma unroll
    for (int q = 0; q < 16; ++q) ceq += (v[q] == prefix) ? 1 : 0;
    int tot; int eqbase = block_excl_scan(ceq, wsum, tid, F.lane, F.wave, tot);
    unsigned selmask = 0u; int csel = 0;
#pragma unroll
    for (int q = 0; q < 16; ++q) { bool s = v[q] > prefix; if (v[q] == prefix) { s = eqbase < kk; ++eqbase; } if (s) { selmask |= 1u << q; ++csel; } }
    __syncthreads();
    int slot = block_excl_scan(csel, wsum, tid, F.lane, F.wave, tot);
    const int rowbase = (e * BATCH + b) * CAP;
#pragma unroll
    for (int q = 0; q < 16; ++q) { const int tok = b * SEQ + tid * 16 + q; int so = -1;
        if (selmask & (1u << q)) { const int row = rowbase + (slot < CAP ? slot : CAP - 1); so = row; F.TOK[row] = tok; F.GATEV[row] = __uint_as_float(v[q]); ++slot; }
        F.SLOTOF[(size_t)tok * NE + e] = so; }
}
__device__ __forceinline__ void phase_p7b(Frame& F) {
    const int gw = F.vcu * NWAVES + F.wave, NGW = F.G * NWAVES;
    for (int r = gw; r < NSLOT; r += NGW) { const int t = F.TOK[r];
        const v4u* src = (const v4u*)(F.XN + (size_t)t * DM) + F.lane; v4u* dst = (v4u*)(F.XE + (size_t)r * DM) + F.lane;
        const v4u a = src[0], c = src[64]; dst[0] = a; dst[64] = c; }
}
__device__ __forceinline__ void phase_p10(Frame& F) {
    const int gw = F.vcu * NWAVES + F.wave, NGW = F.G * NWAVES, lane = F.lane;
    for (int m = gw; m < MTOK; m += NGW) {
        const int b = m / SEQ; const float* mod = F.MOD + b * 6 * DM;
        float acc[16];
#pragma unroll
        for (int k = 0; k < 16; ++k) acc[k] = 0.f;
        const int myslot = (lane < NE) ? F.SLOTOF[(size_t)m * NE + lane] : -1;
#pragma unroll 1
        for (int e = 0; e < NE; ++e) { const int r = __builtin_amdgcn_readlane(myslot, e);
            if (r >= 0) { const float g = F.GATEV[r]; const v4u* yr = (const v4u*)(F.YE + (size_t)r * DM) + lane;
#pragma unroll
                for (int j = 0; j < 2; ++j) { const v4u w = yr[64 * j];
                    acc[8 * j + 0] += g * bflo(w.x); acc[8 * j + 1] += g * bfhi(w.x); acc[8 * j + 2] += g * bflo(w.y); acc[8 * j + 3] += g * bfhi(w.y);
                    acc[8 * j + 4] += g * bflo(w.z); acc[8 * j + 5] += g * bfhi(w.z); acc[8 * j + 6] += g * bflo(w.w); acc[8 * j + 7] += g * bfhi(w.w); } } }
        float s = 0.f;
#pragma unroll
        for (int k = 0; k < 16; ++k) s += acc[k] * acc[k];
        const float rr = 1.f / sqrtf(wave_sum(s) * (1.f / DM) + RMS_EPS);
        float* orow = F.out + (size_t)m * DM;
#pragma unroll
        for (int j = 0; j < 2; ++j)
#pragma unroll
            for (int q = 0; q < 2; ++q) { const int c = 8 * lane + 512 * j + 4 * q;
                const f32x4 x1 = *(const f32x4*)(orow + c), g = *(const f32x4*)(F.g_post_ffn + c), gf = *(const f32x4*)(mod + 5 * DM + c);
                f32x4 a; a.x = acc[8 * j + 4 * q]; a.y = acc[8 * j + 4 * q + 1]; a.z = acc[8 * j + 4 * q + 2]; a.w = acc[8 * j + 4 * q + 3];
                *(f32x4*)(orow + c) = x1 + gf * (a * rr * g); }
    }
}
struct Args { const float* in[16]; float* out; unsigned char* ws; int ph_lo, ph_hi; };
__global__ void __launch_bounds__(NWAVES * 64, 2) mk_fwd(Args args) {
    extern __shared__ __attribute__((aligned(16))) unsigned char lds[];
    Frame F;
    F.lds = (LAS unsigned char*)lds;
    F.MISC = (volatile LAS unsigned*)(F.lds + MISC_OFF);
    F.tid = threadIdx.x; F.lane = F.tid & 63; F.wave = __builtin_amdgcn_readfirstlane(F.tid >> 6);
    F.G = gridDim.x; { const int bx = blockIdx.x; F.vcu = (F.G % 8 == 0) ? (bx % 8) * (F.G / 8) + bx / 8 : bx; }
    unsigned char* ws = args.ws;
    F.ctl = (gu32*)(ws + WS_CTL);
    F.x = args.in[0]; F.c = args.in[1]; F.w_ada = args.in[2]; F.b_ada = args.in[3]; F.g_pre_mix = args.in[4]; F.g_post_mix = args.in[5]; F.g_pre_ffn = args.in[6]; F.g_post_ffn = args.in[7];
    F.w_in = args.in[8]; F.dec_f = args.in[9]; F.dec_b = args.in[10]; F.w_out = args.in[11]; F.w_router = args.in[12]; F.w_gate = args.in[13]; F.w_up = args.in[14]; F.w_down = args.in[15];
    F.out = args.out;
    F.MOD = (float*)(ws + WS_MOD); F.AFF = (float*)(ws + WS_AFF); F.GATEV = (float*)(ws + WS_GATEV); F.LSE = (float*)(ws + WS_LSE); F.KV = (float*)(ws + WS_KV); F.MIXED = (float*)(ws + WS_MIXED);
    F.TOK = (int*)(ws + WS_TOK); F.SLOTOF = (int*)(ws + WS_SLOTOF);
    F.WIN = (bf16*)(ws + WS_WIN); F.WOUT = (bf16*)(ws + WS_WOUT); F.WGU = (bf16*)(ws + WS_WGU); F.WDN = (bf16*)(ws + WS_WDN); F.XN = (bf16*)(ws + WS_XN); F.PROJ = (bf16*)(ws + WS_PROJ);
    F.PREV = (bf16*)(ws + WS_PREV); F.ATTO = (bf16*)(ws + WS_ATTO); F.Y = (bf16*)(ws + WS_Y); F.XE = (bf16*)(ws + WS_XE); F.HH = (bf16*)(ws + WS_HH); F.YE = (bf16*)(ws + WS_YE);
    for (int u = F.tid; u < (LDS_BYTES - LDSCTL_OFF) / 4; u += NWAVES * 64) ((LAS unsigned*)(F.lds + LDSCTL_OFF))[u] = 0u;
    __syncthreads();
    const int lo = args.ph_lo, hi = args.ph_hi;
    XcdBarrier bar; bar.bar = (unsigned*)(F.ctl + CW_BAR); bar.x = 0; bar.st = nullptr;
    if (hi - lo > 1) bar = xcd_barrier_post((unsigned*)(F.ctl + CW_BAR), F.MISC + 8);
#ifndef PHASE_MASK
#define PHASE_MASK 0xffff
#endif
#define IN(k) (((PHASE_MASK >> (k)) & 1) && lo <= (k) && (k) < hi)
#ifndef REP_MASK
#define REP_MASK 0
#endif
#define NREP(k) ((((REP_MASK) >> (k)) & 1) ? 2 : 1)
#define SEAM(k) do { if (IN(k) && IN((k) + 1)) xcd_barrier(bar); } while (0)
    if (IN(0)) for (int rep_ = 0; rep_ < NREP(0); ++rep_) { phase_p0a(F); } SEAM(0);
    if (IN(1)) for (int rep_ = 0; rep_ < NREP(1); ++rep_) { phase_p0b(F); } SEAM(1);
    if (IN(2)) for (int rep_ = 0; rep_ < NREP(2); ++rep_) {
        pg8::Gemm g{F.XN, F.WIN, MTOK, NPROJ, DM}; pg8::StaticOrder S; S.init(MTOK, NPROJ, F.G, (int)blockIdx.x);
        pg8::EpiBf16S E{F.PROJ, NPROJ, 0xffff, 0.125f, 0.125f * LOG2E, 1};
        pg8::gemm_phase<pg8::EpiBf16S, pg8::StaticOrder, true, true>(F.lds, g, S, E);
    } SEAM(2);
    if (IN(3)) for (int rep_ = 0; rep_ < NREP(3); ++rep_) { phase_p2(F); } SEAM(3);
    if (IN(4)) for (int rep_ = 0; rep_ < NREP(4); ++rep_) { phase_p3(F); } SEAM(4);
    if (IN(5)) for (int rep_ = 0; rep_ < NREP(5); ++rep_) { phase_p4(F); } SEAM(5);
    if (IN(6)) for (int rep_ = 0; rep_ < NREP(6); ++rep_) {
        pg8::Gemm g{F.Y, F.WOUT, MTOK, DM, DM}; pg8::StaticOrder S; S.init(MTOK, DM, F.G, (int)blockIdx.x);
        pg8::EpiF32 E{F.MIXED, DM};
        pg8::gemm_phase<pg8::EpiF32, pg8::StaticOrder, true, true>(F.lds, g, S, E);
    } SEAM(6);
    if (IN(7)) for (int rep_ = 0; rep_ < NREP(7); ++rep_) { phase_p6(F); } SEAM(7);
    if (IN(8)) for (int rep_ = 0; rep_ < NREP(8); ++rep_) { phase_p7(F); } if (IN(8) && IN(10)) xcd_barrier(bar);
    if (IN(10)) for (int rep_ = 0; rep_ < NREP(10); ++rep_) {
        pg8::Gemm g{F.XN, F.WGU, NSLOT, NE * 2 * FF, DM}; pg8::MoeOrder S{16, F.G, F.vcu};
        pg8::EpiSwiGLU E{F.HH, FF};
        pg8::gemm_phase<pg8::EpiSwiGLU, pg8::MoeOrder, true, true, true>(F.lds, g, S, E, F.TOK, (LAS int*)(F.lds + MISC_OFF + 256));
    } SEAM(10);
    if (IN(11)) for (int rep_ = 0; rep_ < NREP(11); ++rep_) {
        pg8::Gemm g{F.HH, F.WDN, NSLOT, NE * DM, FF}; pg8::MoeOrder S{4, F.G, F.vcu};
        pg8::EpiBf16S E{F.YE, DM, 3, 1.f, 1.f, 0};
        pg8::gemm_phase<pg8::EpiBf16S, pg8::MoeOrder, true, true>(F.lds, g, S, E);
    } SEAM(11);
    if (IN(12)) for (int rep_ = 0; rep_ < NREP(12); ++rep_) { phase_p10(F); }
#undef IN
#undef SEAM
}

extern "C" void kernel_launch(void* const* d_in, const int* in_sizes, int n_in, void* d_out, int out_size, void* d_ws, size_t ws_size, hipStream_t stream) {
    static int grid = 0;
    if (grid == 0) {
        if (n_in != 16 || in_sizes[0] != MTOK * DM || out_size != MTOK * DM || ws_size < WS_END) { fprintf(stderr, "kernel_launch: unexpected shapes: n_in %d in0 %d out %d ws %zu (need %zu)\n", n_in, n_in > 0 ? in_sizes[0] : -1, out_size, ws_size, (size_t)WS_END); grid = -1; return; }
        int dev = 0, cus = 0;
        if (hipGetDevice(&dev) != hipSuccess || hipDeviceGetAttribute(&cus, hipDeviceAttributeMultiprocessorCount, dev) != hipSuccess) { grid = -1; return; }
        if (hipFuncSetAttribute((const void*)mk_fwd, hipFuncAttributeMaxDynamicSharedMemorySize, LDS_BYTES) != hipSuccess) { fprintf(stderr, "kernel_launch: hipFuncSetAttribute failed\n"); grid = -1; return; }
        int per_cu = 0;
        if (hipOccupancyMaxActiveBlocksPerMultiprocessor(&per_cu, (const void*)mk_fwd, NWAVES * 64, LDS_BYTES) != hipSuccess || per_cu < 1) fprintf(stderr, "kernel_launch: occupancy query says %d blocks per CU\n", per_cu);
        (void)hipGetLastError();
        grid = cus;
    }
    if (grid < 0) return;
    (void)hipMemsetAsync((char*)d_ws + WS_CTL, 0, CTL_ZERO_BYTES, stream);
    Args a{};
    for (int i = 0; i < 16; ++i) a.in[i] = (const float*)d_in[i];
    a.out = (float*)d_out; a.ws = (unsigned char*)d_ws;
#if MK_ONE_LAUNCH
    a.ph_lo = 0; a.ph_hi = NPHASE;
    hipLaunchKernelGGL(mk_fwd, dim3(grid), dim3(NWAVES * 64), LDS_BYTES, stream, a);
#else
    for (int p = 0; p < NPHASE; ++p) { a.ph_lo = p; a.ph_hi = p + 1; hipLaunchKernelGGL(mk_fwd, dim3(grid), dim3(NWAVES * 64), LDS_BYTES, stream, a); }
#endif
}
```

```cpp
#include <hip/hip_runtime.h>
#include <cstdio>
#include <cstdint>
namespace pg8 {
#define PG8_LAS __attribute__((address_space(3)))
typedef unsigned short bf16_t;
typedef short bf16x8 __attribute__((ext_vector_type(8)));
typedef float f32x4 __attribute__((ext_vector_type(4)));
typedef unsigned u32x4 __attribute__((ext_vector_type(4)));
constexpr int BM = 256, BK = 64, HALF = 128, HTB = HALF * BK * 2  , STAGE_BYTES = 8 * HTB, NXCD = 8, WGM = 8;

__host__ __device__ __forceinline__ int lds_byte(int r, int c) { const int st = (r >> 4) * 2 + (c >> 5), rr = r & 15, cc = c & 31, ob = rr * 64 + cc * 2; return st * 1024 + (ob ^ (((ob >> 9) & 1) << 5)); }
__host__ __device__ __forceinline__ void stage_rc(int b, int& R, int& C) { const int st = b / 1024, sb = b % 1024, swz = sb ^ (((sb >> 9) & 1) << 5); R = (st >> 1) * 16 + swz / 64; C = (st & 1) * 32 + (swz % 64) / 2; }
__host__ __device__ __forceinline__ int perm32(int rho) { const int n = rho >> 4, i = rho & 15; return 8 * (i >> 2) + 4 * n + (i & 3); }

struct Unit { int pm, pn; };
struct Gemm { const bf16_t* A; const bf16_t* Bt; int M, N, K; };

struct StaticOrder {
    int nM, nN, nwg, G, c;
    __host__ __device__ void init(int M, int N, int G_, int c_) { nM = M / BM; nN = N / BM; nwg = nM * nN; G = G_; c = c_; }
    __host__ __device__ bool next(int i, Unit& u) const {
        const long L = (long)i * G + c; if (L >= nwg) return false;
        int wgid = (int)L; { const int q = nwg / NXCD, r = nwg % NXCD, xcd = wgid % NXCD, off = wgid / NXCD; wgid = (xcd < r ? xcd * (q + 1) : r * (q + 1) + (xcd - r) * q) + off; }
        const int nig = WGM * nN, gid = wgid / nig, fm = gid * WGM, gsz = (nM - fm) < WGM ? (nM - fm) : WGM;
        u.pm = fm + ((wgid % nig) % gsz); u.pn = (wgid % nig) / gsz; return true;
    }
    __device__ __forceinline__ void a_ready(const Unit&) const {}
    __device__ __forceinline__ void done(const Unit&) const {}
};

__device__ __forceinline__ unsigned cvt_pk_bf16(float lo, float hi) { unsigned r; asm volatile("v_cvt_pk_bf16_f32 %0, %1, %2" : "=v"(r) : "v"(lo), "v"(hi)); return r; }
typedef float f32x2 __attribute__((ext_vector_type(2)));
typedef unsigned u32x2 __attribute__((ext_vector_type(2)));
constexpr float LOG2E_F = 1.4426950408889634f;
struct EpiF32 {
    static constexpr bool PERM = false, AFTER_DRAIN = false;
    float* C; int ldc;
    __device__ __forceinline__ void operator()(const f32x4 (&acc)[2][2][4][2], const Unit& u, int wr, int wc, int fr, int fq) const {
        const int row0 = u.pm * BM + wr * 64 + fr, col0 = u.pn * BM + wc * 32 + 4 * fq;
#pragma unroll
        for (int ai = 0; ai < 2; ++ai)
#pragma unroll
            for (int m = 0; m < 4; ++m) { float* rowp = C + (size_t)(row0 + ai * HALF + m * 16) * ldc + col0;
#pragma unroll
                for (int bj = 0; bj < 2; ++bj)
#pragma unroll
                    for (int n = 0; n < 2; ++n) *(f32x4*)(rowp + bj * HALF + n * 16) = acc[ai][bj][m][n]; }
    }
};
struct EpiBf16S {
    static constexpr bool PERM = true, AFTER_DRAIN = false;
    bf16_t* O; int ldc; int pn_mask; float s_rk, s_aq; int proj;
    __device__ __forceinline__ void operator()(const f32x4 (&acc)[2][2][4][2], const Unit& u, int wr, int wc, int fr, int fq) const {
        const int pn = u.pn & pn_mask;
        const int row0 = u.pm * BM + wr * 64 + fr, col0 = pn * BM + wc * 32 + 8 * fq;
        float sc = 1.f; if (proj) sc = (pn == 1) ? s_rk : ((pn == 6 || pn == 7) ? s_aq : 1.f);
#pragma unroll
        for (int ai = 0; ai < 2; ++ai)
#pragma unroll
            for (int m = 0; m < 4; ++m) { bf16_t* rowp = O + (size_t)(row0 + ai * HALF + m * 16) * ldc + col0;
#pragma unroll
                for (int bj = 0; bj < 2; ++bj) { const f32x4 v0 = acc[ai][bj][m][0] * sc, v1 = acc[ai][bj][m][1] * sc;
                    u32x4 w; w.x = cvt_pk_bf16(v0[0], v0[1]); w.y = cvt_pk_bf16(v0[2], v0[3]); w.z = cvt_pk_bf16(v1[0], v1[1]); w.w = cvt_pk_bf16(v1[2], v1[3]);
                    *(u32x4*)(rowp + bj * HALF) = w; } }
    }
};
struct EpiSwiGLU {
    static constexpr bool PERM = true, AFTER_DRAIN = false;
    bf16_t* O; int ldc;
    __device__ __forceinline__ float act(float g, float up) const { return g * up * __builtin_amdgcn_rcpf(1.f + __builtin_amdgcn_exp2f(-g * LOG2E_F)); }
    __device__ __forceinline__ void operator()(const f32x4 (&acc)[2][2][4][2], const Unit& u, int wr, int wc, int fr, int fq) const {
        const int row0 = u.pm * BM + wr * 64 + fr, col0 = (u.pn & 15) * HALF + wc * 32 + 8 * fq;
#pragma unroll
        for (int ai = 0; ai < 2; ++ai)
#pragma unroll
            for (int m = 0; m < 4; ++m) { bf16_t* rowp = O + (size_t)(row0 + ai * HALF + m * 16) * ldc + col0;
                const f32x4 g0 = acc[ai][0][m][0], g1 = acc[ai][0][m][1], u0 = acc[ai][1][m][0], u1 = acc[ai][1][m][1];
                u32x4 w; w.x = cvt_pk_bf16(act(g0[0], u0[0]), act(g0[1], u0[1])); w.y = cvt_pk_bf16(act(g0[2], u0[2]), act(g0[3], u0[3]));
                w.z = cvt_pk_bf16(act(g1[0], u1[0]), act(g1[1], u1[1])); w.w = cvt_pk_bf16(act(g1[2], u1[2]), act(g1[3], u1[3]));
                *(u32x4*)rowp = w; }
    }
};
struct MoeOrder {
    int ntile, G, vcu;
    __device__ __forceinline__ bool next(int i, Unit& u) const {
        const int total = 16 * 8 * ntile; int L;
        if ((G & 7) == 0) { const int g8 = G >> 3, x = vcu / g8, c = vcu % g8, share = total >> 3, l = i * g8 + c; if (l >= share) return false; L = x * share + l; }
        else { L = i * G + vcu; if (L >= total) return false; }
        const int e = L / (8 * ntile), rem = L % (8 * ntile);
        u.pm = e * 8 + (rem & 7); u.pn = e * ntile + (rem >> 3); return true;
    }
    __device__ __forceinline__ void a_ready(const Unit&) const {}
    __device__ __forceinline__ void done(const Unit&) const {}
};
template <class Epi, class Sched, bool ALIGN_EPI = false, bool SP2 = false, bool GATHER = false>
__device__ __forceinline__ void gemm_phase(PG8_LAS unsigned char* lds, const Gemm g, const Sched& S, const Epi& E, const int* rowmap = nullptr, PG8_LAS int* ldsrow = nullptr) {
    const int tid = threadIdx.x, wid = __builtin_amdgcn_readfirstlane(tid >> 6), lane = tid & 63, wr = wid >> 2, wc = wid & 3, fr = lane & 15, fq = lane >> 4;
    const int K = g.K, nt = K / BK;
    unsigned voffA[2], voffB[2];
#pragma unroll
    for (int i = 0; i < 2; ++i) { int R, C; stage_rc(tid * 16 + i * 8192, R, C); const int Rb = Epi::PERM ? ((R & ~31) + perm32(R & 31)) : R;
        voffA[i] = (unsigned)(R * K + C) * 2u; voffB[i] = (unsigned)(Rb * K + C) * 2u; }
    unsigned gC[2][2] = {{0u, 0u}, {0u, 0u}}, gN[2][2] = {{0u, 0u}, {0u, 0u}}; int gR[2] = {0, 0}; unsigned gCb[2] = {0u, 0u};
    if constexpr (GATHER) {
#pragma unroll
        for (int i = 0; i < 2; ++i) { int R, C; stage_rc(tid * 16 + i * 8192, R, C); gR[i] = R; gCb[i] = (unsigned)C * 2u; }
        Unit uu;
        for (int ui_ = 0; ui_ < 8; ++ui_) { if (!S.next(ui_, uu)) break; if (tid < 256) ldsrow[ui_ * 256 + tid] = rowmap[uu.pm * BM + tid]; }
        __syncthreads();
#pragma unroll
        for (int h = 0; h < 2; ++h)
#pragma unroll
            for (int i = 0; i < 2; ++i) gC[h][i] = (unsigned)ldsrow[h * HALF + gR[i]] * (unsigned)(K * 2) + gCb[i];
    }
    const size_t kstep = (size_t)(BK * 2);
    const size_t hstep = (size_t)HALF * K * 2;
    const size_t tstep = 2 * hstep;
    const unsigned ldsw = (unsigned)wid * 1024u;
    const int aoff = lds_byte(wr * 64 + fr, fq * 8), boff = lds_byte(wc * 32 + fr, fq * 8);
#define PG8_SA(b, h) (((b) * 2 + (h)) * HTB)
#define PG8_SB(b, h) ((4 + (b) * 2 + (h)) * HTB)
#define PG8_STAGE(bufoff, gbase, voff) do { _Pragma("unroll") for (int _i = 0; _i < 2; ++_i) \
        __builtin_amdgcn_global_load_lds((const unsigned*)((const char*)(gbase) + (voff)[_i]), (PG8_LAS unsigned*)(lds + (bufoff) + ldsw + _i * 8192), 16, 0, 0); } while (0)
#define PG8_STAGE_A(bufoff, isnext, half, koff) do { \
        if constexpr (GATHER) { _Pragma("unroll") for (int _i = 0; _i < 2; ++_i) { const unsigned vo_ = (isnext) ? gN[half][_i] : gC[half][_i]; \
            __builtin_amdgcn_global_load_lds((const unsigned*)((const char*)g.A + (koff) + vo_), (PG8_LAS unsigned*)(lds + (bufoff) + ldsw + _i * 8192), 16, 0, 0); } } \
        else { const char* b_ = ((isnext) ? nA : cA) + (half) * hstep + (koff); PG8_STAGE(bufoff, b_, voffA); } } while (0)
#define PG8_LDA(dst, b, h) do { _Pragma("unroll") for (int m = 0; m < 4; ++m) _Pragma("unroll") for (int k = 0; k < 2; ++k) dst[m][k] = *(const PG8_LAS bf16x8*)(lds + PG8_SA(b, h) + aoff + m * 2048 + k * 1024); } while (0)
#define PG8_LDB(dst, b, h) do { _Pragma("unroll") for (int n = 0; n < 2; ++n) _Pragma("unroll") for (int k = 0; k < 2; ++k) dst[n][k] = *(const PG8_LAS bf16x8*)(lds + PG8_SB(b, h) + boff + n * 2048 + k * 1024); } while (0)
#define PG8_MMA(ai, bj, At, Bt) do { __builtin_amdgcn_s_setprio(1); _Pragma("unroll") for (int m = 0; m < 4; ++m) _Pragma("unroll") for (int n = 0; n < 2; ++n) _Pragma("unroll") for (int k = 0; k < 2; ++k) \
        acc[ai][bj][m][n] = __builtin_amdgcn_mfma_f32_16x16x32_bf16(Bt[n][k], At[m][k], acc[ai][bj][m][n], 0, 0, 0); __builtin_amdgcn_s_setprio(0); } while (0)
#define PG8_WAIT_V(n) asm volatile("s_waitcnt vmcnt(" #n ")" ::: "memory")
#define PG8_WAIT_L(n) asm volatile("s_waitcnt lgkmcnt(" #n ")" ::: "memory")
#define PG8_BAR __builtin_amdgcn_s_barrier()
#define PG8_SCHED __builtin_amdgcn_sched_barrier(0)
    Unit cur, nxt; int ui = 0;
    if (!S.next(0, cur)) return;
    f32x4 acc[2][2][4][2];
#pragma unroll
    for (int a = 0; a < 2; ++a)
#pragma unroll
        for (int b = 0; b < 2; ++b)
#pragma unroll
            for (int m = 0; m < 4; ++m)
#pragma unroll
                for (int n = 0; n < 2; ++n) acc[a][b][m][n] = (f32x4){0.f, 0.f, 0.f, 0.f};
    bf16x8 At[4][2], B0[2][2], B1[2][2];
    const char* cA = (const char*)g.A + (size_t)cur.pm * tstep; const char* cB = (const char*)g.Bt + (size_t)cur.pn * tstep;
    S.a_ready(cur);
    const char* nA = cA; (void)nA;
    if constexpr (SP2) {
        PG8_STAGE(PG8_SB(0, 0), cB, voffB); PG8_STAGE(PG8_SB(0, 1), cB + hstep, voffB); PG8_STAGE_A(PG8_SA(0, 0), false, 0, (size_t)0); PG8_STAGE_A(PG8_SA(0, 1), false, 1, (size_t)0);
        if (wr == 1) PG8_BAR;
        PG8_WAIT_V(2); PG8_BAR;
        PG8_STAGE(PG8_SB(1, 0), cB + kstep, voffB); PG8_STAGE_A(PG8_SA(1, 0), false, 0, kstep); PG8_STAGE(PG8_SB(1, 1), cB + hstep + kstep, voffB);
        PG8_WAIT_V(6); PG8_BAR;
    } else {
        PG8_STAGE(PG8_SB(0, 0), cB, voffB); PG8_STAGE_A(PG8_SA(0, 0), false, 0, (size_t)0); PG8_STAGE(PG8_SB(0, 1), cB + hstep, voffB); PG8_STAGE_A(PG8_SA(0, 1), false, 1, (size_t)0);
        if (wr == 1) PG8_BAR;
        PG8_WAIT_V(4); PG8_BAR;
        PG8_STAGE(PG8_SB(1, 0), cB + kstep, voffB); PG8_STAGE_A(PG8_SA(1, 0), false, 0, kstep); PG8_STAGE(PG8_SB(1, 1), cB + hstep + kstep, voffB);
        PG8_WAIT_V(6); PG8_BAR;
    }
    for (;;) {
        const bool has_next = S.next(ui + 1, nxt);
        if constexpr (GATHER) {
#pragma unroll
            for (int h = 0; h < 2; ++h)
#pragma unroll
                for (int i = 0; i < 2; ++i) gN[h][i] = has_next ? (unsigned)ldsrow[(ui + 1) * 256 + h * HALF + gR[i]] * (unsigned)(K * 2) + gCb[i] : gC[h][i];
        }
        const char* nA = has_next ? (const char*)g.A + (size_t)nxt.pm * tstep : cA; const char* nB = has_next ? (const char*)g.Bt + (size_t)nxt.pn * tstep : cB;
        for (int t = 0; t < nt; t += 2) {
            const bool last = (t == nt - 2);
            const size_t k1 = (size_t)(t + 1) * kstep, k2 = last ? (size_t)0 : (size_t)(t + 2) * kstep, k3 = k2 + kstep;
            const char* a1 = cA + (size_t)(t + 1) * kstep;
            const char* a2 = last ? nA : cA + (size_t)(t + 2) * kstep; const char* b2 = last ? nB : cB + (size_t)(t + 2) * kstep;
            const char* a3 = a2 + kstep; const char* b3 = b2 + kstep;
            if (last && has_next) S.a_ready(nxt);
            if constexpr (SP2) {
            PG8_LDB(B0, 0, 0); PG8_LDB(B1, 0, 1); PG8_SCHED; PG8_LDA(At, 0, 0); PG8_STAGE_A(PG8_SA(1, 1), false, 1, k1);
            PG8_WAIT_V(8); PG8_WAIT_L(0); PG8_BAR; PG8_MMA(0, 0, At, B0); PG8_MMA(0, 1, At, B1); PG8_BAR; PG8_SCHED;
            PG8_LDA(At, 0, 1); PG8_STAGE(PG8_SB(0, 0), b2, voffB); PG8_STAGE(PG8_SB(0, 1), b2 + hstep, voffB); PG8_STAGE_A(PG8_SA(0, 0), last, 0, k2);
            PG8_WAIT_V(8); PG8_WAIT_L(0); PG8_BAR; PG8_MMA(1, 0, At, B0); PG8_MMA(1, 1, At, B1); PG8_BAR; PG8_SCHED;
            PG8_LDB(B0, 1, 0); PG8_LDB(B1, 1, 1); PG8_SCHED; PG8_LDA(At, 1, 0); PG8_STAGE_A(PG8_SA(0, 1), last, 1, k2);
            PG8_WAIT_V(8); PG8_WAIT_L(0); PG8_BAR; PG8_MMA(0, 0, At, B0); PG8_MMA(0, 1, At, B1); PG8_BAR; PG8_SCHED;
            PG8_LDA(At, 1, 1); PG8_STAGE(PG8_SB(1, 0), b3, voffB); PG8_STAGE(PG8_SB(1, 1), b3 + hstep, voffB); PG8_STAGE_A(PG8_SA(1, 0), last, 0, k3);
            PG8_WAIT_V(8); PG8_WAIT_L(0); PG8_BAR; PG8_MMA(1, 0, At, B0); PG8_MMA(1, 1, At, B1); PG8_BAR; PG8_SCHED;
            } else {
            PG8_LDB(B0, 0, 0); PG8_SCHED; PG8_LDA(At, 0, 0); PG8_STAGE_A(PG8_SA(1, 1), false, 1, k1);
            PG8_WAIT_L(8); PG8_BAR; PG8_WAIT_L(0); PG8_MMA(0, 0, At, B0); PG8_BAR; PG8_SCHED;
            PG8_LDB(B1, 0, 1); PG8_STAGE(PG8_SB(0, 0), b2, voffB);
            PG8_BAR; PG8_WAIT_L(0); PG8_MMA(0, 1, At, B1); PG8_BAR;
            PG8_LDA(At, 0, 1); PG8_STAGE_A(PG8_SA(0, 0), last, 0, k2);
            PG8_BAR; PG8_WAIT_L(0); PG8_MMA(1, 0, At, B0); PG8_BAR; PG8_SCHED;
            PG8_STAGE(PG8_SB(0, 1), b2 + hstep, voffB);
            PG8_WAIT_V(6); PG8_BAR; PG8_MMA(1, 1, At, B1); PG8_BAR;
            PG8_LDB(B0, 1, 0); PG8_SCHED; PG8_LDA(At, 1, 0); PG8_STAGE_A(PG8_SA(0, 1), last, 1, k2);
            PG8_WAIT_L(8); PG8_BAR; PG8_WAIT_L(0); PG8_MMA(0, 0, At, B0); PG8_BAR; PG8_SCHED;
            PG8_LDB(B1, 1, 1); PG8_STAGE(PG8_SB(1, 0), b3, voffB);
            PG8_BAR; PG8_WAIT_L(0); PG8_MMA(0, 1, At, B1); PG8_BAR;
            PG8_LDA(At, 1, 1); PG8_STAGE_A(PG8_SA(1, 0), last, 0, k3);
            PG8_BAR; PG8_WAIT_L(0); PG8_MMA(1, 0, At, B0); PG8_BAR; PG8_SCHED;
            PG8_STAGE(PG8_SB(1, 1), b3 + hstep, voffB);
            PG8_WAIT_V(6); PG8_BAR; PG8_MMA(1, 1, At, B1); PG8_BAR;
            }
        }
        if constexpr (ALIGN_EPI) { if (wr == 0) PG8_BAR; }
        if constexpr (!Epi::AFTER_DRAIN) { E(acc, cur, wr, wc, fr, fq); S.done(cur); }
        if (!has_next) break;
#pragma unroll
        for (int a = 0; a < 2; ++a)
#pragma unroll
            for (int b = 0; b < 2; ++b)
#pragma unroll
                for (int m = 0; m < 4; ++m)
#pragma unroll
                    for (int n = 0; n < 2; ++n) acc[a][b][m][n] = (f32x4){0.f, 0.f, 0.f, 0.f};
        cur = nxt; cA = nA; cB = nB; ++ui;
        if constexpr (GATHER) { gC[0][0] = gN[0][0]; gC[0][1] = gN[0][1]; gC[1][0] = gN[1][0]; gC[1][1] = gN[1][1]; }
        if constexpr (ALIGN_EPI) { if (wr == 1) PG8_BAR; }
    }
    PG8_WAIT_V(0);
    if constexpr (!ALIGN_EPI) { if (wr == 0) PG8_BAR; }
    PG8_BAR;
    if constexpr (Epi::AFTER_DRAIN) { E.fused(acc, cur, wr, wc, fr, fq, lds, wid, lane); S.done(cur); }
#undef PG8_SA
#undef PG8_SB
#undef PG8_STAGE
#undef PG8_STAGE_A
#undef PG8_LDA
#undef PG8_LDB
#undef PG8_MMA
#undef PG8_WAIT_V
#undef PG8_WAIT_L
#undef PG8_BAR
#undef PG8_SCHED
}
}
constexpr int BATCH = 2, SEQ = 8192, DM = 1024, MTOK = BATCH * SEQ;
constexpr int RH = 4, RQK = 64, RV = 128, CHK = 128, NCH = SEQ / CHK;
constexpr int AH = 8, AD = 64;
constexpr int NE = 16, CAP = 1024, FF = 2048, NSLOT = NE * BATCH * CAP;
constexpr int NPROJ = 3072;
constexpr int C_RQ = 0, C_RK = 256, C_RV = 512, C_RG = 1024, C_AQ = 1536, C_AK = 2048, C_AV = 2560;
constexpr float RMS_EPS = 1e-6f, GN_EPS = 1e-5f;
constexpr float LOG2E = 1.4426950408889634f;
constexpr int NWAVES = 8;
#ifndef MK_ONE_LAUNCH
#define MK_ONE_LAUNCH 1
#endif
constexpr int NPHASE = 13;
constexpr size_t MiB = 1u << 20;
constexpr size_t WS_CTL = 0, CTL_ZERO_BYTES = 1 * MiB;
constexpr size_t WS_MOD = 1 * MiB;
constexpr size_t WS_AFF = 2 * MiB;
constexpr size_t WS_TOK = 3 * MiB;
constexpr size_t WS_GATEV = 3 * MiB + 128 * 1024;
constexpr size_t WS_SLOTOF = 3 * MiB + 256 * 1024;
constexpr size_t WS_LSE = 5 * MiB;
constexpr size_t WS_WIN = 8 * MiB;
constexpr size_t WS_WOUT = 14 * MiB;
constexpr size_t WS_WGU = 16 * MiB;
constexpr size_t WS_WDN = 144 * MiB;
constexpr size_t WS_XN = 208 * MiB;
constexpr size_t WS_R = 240 * MiB;
constexpr size_t WS_PROJ = WS_R;
constexpr size_t WS_KV = WS_R + 96 * MiB;
constexpr size_t WS_PREV = WS_R + 128 * MiB;
constexpr size_t WS_ATTO = WS_R + 144 * MiB;
constexpr size_t WS_Y = WS_R + 192 * MiB;
constexpr size_t WS_MIXED = WS_R;
constexpr size_t WS_XE = WS_R + 64 * MiB;
constexpr size_t WS_HH = WS_R + 128 * MiB;
constexpr size_t WS_YE = WS_R;
constexpr size_t WS_END = WS_R + 256 * MiB;
constexpr int CW_BAR = 4096;
constexpr int RING_BYTES = 131072;
constexpr int LDSCTL_OFF = RING_BYTES, MISC_OFF = LDSCTL_OFF + 320;
constexpr int LDS_BYTES = 147456;

#define GAS __attribute__((address_space(1)))
#define LAS __attribute__((address_space(3)))
typedef unsigned short bf16;
typedef unsigned v4u __attribute__((ext_vector_type(4)));
typedef unsigned v2u __attribute__((ext_vector_type(2)));
typedef float f32x4 __attribute__((ext_vector_type(4)));
typedef float f32x16 __attribute__((ext_vector_type(16)));
typedef short bf16x8 __attribute__((ext_vector_type(8)));
typedef short s16x4 __attribute__((ext_vector_type(4)));
typedef GAS unsigned gu32;
#define RLX_AGENT __ATOMIC_RELAXED, __HIP_MEMORY_SCOPE_AGENT
#define LDS_WAIT() asm volatile("s_waitcnt lgkmcnt(0)" ::: "memory")
typedef float f32x2_t __attribute__((ext_vector_type(2))); typedef __bf16 bf16x2_t __attribute__((ext_vector_type(2)));
__device__ __forceinline__ unsigned pk2(float lo, float hi) { f32x2_t v = {lo, hi}; bf16x2_t b = __builtin_convertvector(v, bf16x2_t); return __builtin_bit_cast(unsigned, b); }
__device__ __forceinline__ float bflo(unsigned w) { return __uint_as_float(w << 16); }
__device__ __forceinline__ float bfhi(unsigned w) { return __uint_as_float(w & 0xffff0000u); }
__device__ __forceinline__ float ex2(float x) { return __builtin_amdgcn_exp2f(x); }
__device__ __forceinline__ int crow(int r, int hi) { return (r & 3) + 8 * (r >> 2) + 4 * hi; }
__device__ __forceinline__ s16x4 vtr(const LAS unsigned char* p) { typedef short v4i16_t __attribute__((ext_vector_type(4))); return __builtin_bit_cast(s16x4, __builtin_amdgcn_ds_read_tr16_b64_v4i16((LAS v4i16_t*)p)); }
__device__ __forceinline__ bf16x8 cat8(s16x4 a, s16x4 b) { return (bf16x8){a[0], a[1], a[2], a[3], b[0], b[1], b[2], b[3]}; }
__device__ __forceinline__ float wave_sum(float v) {
#pragma unroll
    for (int o = 1; o < 64; o <<= 1) v += __shfl_xor(v, o);
    return v;
}
#define XB_TMO      128
#define XB_XCNT(j)  (256  + 64 * (j))
#define XB_XSUB(j)  (1280 + 64 * (j))
#define XB_XGEN(j)  (2304 + 64 * (j))
#define XB_TOP      3328
#define XB_TOPGEN   3392
#define XCD_BAR_WORDS 3456
#define XB_SPIN_CAP (1u << 18)

__device__ __forceinline__ unsigned xb_ld(unsigned* p)              { return __hip_atomic_load(p, __ATOMIC_RELAXED, __HIP_MEMORY_SCOPE_AGENT); }
__device__ __forceinline__ unsigned xb_add(unsigned* p, unsigned v) { return __hip_atomic_fetch_add(p, v, __ATOMIC_RELAXED, __HIP_MEMORY_SCOPE_AGENT); }
__device__ __forceinline__ unsigned xb_xcc_id() { return (unsigned)__builtin_amdgcn_s_getreg((3 << 11) | 20) & 0xFu; }
#define XB_SPIN(cond, bar) do { unsigned _sp = 0; while (cond) { __builtin_amdgcn_s_sleep(1); \
    if ((++_sp & 255u) == 0u) { if (xb_ld(&(bar)[XB_TMO])) break; if (_sp > XB_SPIN_CAP) { atomicAdd(&(bar)[XB_TMO], 1u); break; } } } } while (0)

struct XcdBarrier {
    unsigned* bar; unsigned x;
    volatile LAS unsigned* st;
};

__device__ __forceinline__ XcdBarrier xcd_barrier_post(unsigned* bar, volatile LAS unsigned* st) {
    XcdBarrier b; b.bar = bar; b.x = xb_xcc_id(); b.st = st;
    if (threadIdx.x == 0) (void)xb_add(&bar[XB_XCNT(b.x)], 1u);
    return b;
}
__device__ __forceinline__ void xcd_barrier_complete(unsigned* bar, unsigned x, unsigned& nloc, unsigned& nx) {
    const unsigned G = gridDim.x * gridDim.y * gridDim.z;
    unsigned sum, cnt, mine, sp = 0u;
    for (;;) {
        sum = 0u; cnt = 0u; mine = 0u;
#pragma unroll
        for (unsigned j = 0; j < 16; ++j) { const unsigned c = xb_ld(&bar[XB_XCNT(j)]); sum += c; cnt += (c > 0u) ? 1u : 0u; mine = (j == x) ? c : mine; }
        if (sum == G) break;
        __builtin_amdgcn_s_sleep(1);
        if ((++sp & 255u) == 0u) { if (xb_ld(&bar[XB_TMO])) break; if (sp > XB_SPIN_CAP) { atomicAdd(&bar[XB_TMO], 1u); break; } }
    }
    nloc = mine > 0u ? mine : 1u; nx = cnt > 0u ? cnt : 1u;
}

__device__ __forceinline__ void xcd_barrier(const XcdBarrier& b) {
    asm volatile("s_waitcnt vmcnt(0)" ::: "memory");
    __syncthreads();
    if (threadIdx.x == 0) {
        unsigned* bar = b.bar;
        __builtin_amdgcn_s_waitcnt(0);
        unsigned nloc = b.st[0], nx = b.st[1];
        if (nloc == 0u) { xcd_barrier_complete(bar, b.x, nloc, nx); b.st[0] = nloc; b.st[1] = nx; }
        const unsigned old = xb_add(&bar[XB_XSUB(b.x)], 1u);
        const unsigned gen = old / nloc;
        if (old + 1u == (gen + 1u) * nloc) {
            __builtin_amdgcn_fence(__ATOMIC_RELEASE, "agent");
            asm volatile("s_waitcnt vmcnt(0)" ::: "memory");
            const unsigned og = xb_add(&bar[XB_TOP], 1u);
            const unsigned tg = og / nx;
            if (og + 1u == (tg + 1u) * nx) xb_add(&bar[XB_TOPGEN], 1u);
            else XB_SPIN(xb_ld(&bar[XB_TOPGEN]) == tg, bar);
            __builtin_amdgcn_fence(__ATOMIC_ACQUIRE, "agent");
            xb_add(&bar[XB_XGEN(b.x)], 1u);
            asm volatile("s_waitcnt vmcnt(0)" ::: "memory");
        } else {
            XB_SPIN(xb_ld(&bar[XB_XGEN(b.x)]) == gen, bar);
            __builtin_amdgcn_fence(__ATOMIC_ACQUIRE, "agent");
            asm volatile("s_waitcnt vmcnt(0)" ::: "memory");
        }
    }
    __syncthreads();
}
struct Frame {
    LAS unsigned char* lds;
    volatile LAS unsigned* MISC;
    gu32* ctl;
    int tid, lane, wave;
    int vcu, G;
    const float *x, *c, *w_ada, *b_ada, *g_pre_mix, *g_post_mix, *g_pre_ffn, *g_post_ffn, *w_in, *dec_f, *dec_b, *w_out, *w_router, *w_gate, *w_up, *w_down;
    float* out;
    float *MOD, *AFF, *GATEV, *LSE, *KV, *MIXED;
    int *TOK, *SLOTOF;
    bf16 *WIN, *WOUT, *WGU, *WDN, *XN, *PROJ, *PREV, *ATTO, *Y, *XE, *HH, *YE;
};

__device__ __forceinline__ void p0_transpose_item(const float* W, int K, int N, bf16* WT, int k0, int n0, int drow0, LAS float* scr, int lane) {
#pragma unroll 8
    for (int i = 0; i < 32; ++i) { const int kk = 2 * i + (lane >> 5); scr[kk * 33 + (lane & 31)] = W[(size_t)(k0 + kk) * N + n0 + (lane & 31)]; }
    LDS_WAIT(); asm volatile("" ::: "memory");
    const int c = lane & 7;
#pragma unroll
    for (int j = 0; j < 4; ++j) { const int n = (lane >> 3) + 8 * j; const LAS float* s = scr + (8 * c) * 33 + n;
        v4u o; o.x = pk2(s[0 * 33], s[1 * 33]); o.y = pk2(s[2 * 33], s[3 * 33]); o.z = pk2(s[4 * 33], s[5 * 33]); o.w = pk2(s[6 * 33], s[7 * 33]);
        *(GAS v4u*)(WT + (size_t)(drow0 + n) * K + k0 + 8 * c) = o; }
    LDS_WAIT(); asm volatile("" ::: "memory");
}
__device__ __forceinline__ void phase_p0a(Frame& F) {
    LAS float* sc = (LAS float*)(F.lds + 98304);
    for (int i = F.tid; i < 2 * DM; i += NWAVES * 64) { const float v = F.c[i]; sc[i] = v / (1.f + __expf(-v)); }
    __syncthreads();
    { const int gwm = F.wave * F.G + F.vcu;
      for (int it = gwm; it < 6 * DM / 16; it += F.G * NWAVES) {
        const int col = it * 16 + (F.lane & 15), kq = F.lane >> 4; float a0 = 0.f, a1 = 0.f;
#pragma unroll 8
        for (int k = kq; k < DM; k += 4) { const float w = F.w_ada[(size_t)k * (6 * DM) + col]; a0 += sc[k] * w; a1 += sc[DM + k] * w; }
        a0 += __shfl_xor(a0, 16); a0 += __shfl_xor(a0, 32); a1 += __shfl_xor(a1, 16); a1 += __shfl_xor(a1, 32);
        if (kq == 0) { const float bb = F.b_ada[col]; F.MOD[col] = a0 + bb; F.MOD[6 * DM + col] = a1 + bb; }
      } }
    LAS float* scr = (LAS float*)(F.lds + F.wave * 12288);
    const int gw = F.vcu * NWAVES + F.wave, NGW = F.G * NWAVES;
    constexpr int I_IN = (DM / 64) * (NPROJ / 32), I_OUT = (DM / 64) * (DM / 32), I_G1 = (DM / 64) * (FF / 32), I_G = NE * I_G1, I_D1 = (FF / 64) * (DM / 32), I_D = NE * I_D1;
    constexpr int NITEMS = I_IN + I_OUT + 2 * I_G + I_D;
    for (int it = gw; it < NITEMS; it += NGW) {
        int r = it;
        if (r < I_IN) { const int nblk = NPROJ / 32, kb = r / nblk, nb = r % nblk; p0_transpose_item(F.w_in, DM, NPROJ, F.WIN, 64 * kb, 32 * nb, 32 * nb, scr, F.lane); continue; } r -= I_IN;
        if (r < I_OUT) { const int nblk = DM / 32, kb = r / nblk, nb = r % nblk; p0_transpose_item(F.w_out, DM, DM, F.WOUT, 64 * kb, 32 * nb, 32 * nb, scr, F.lane); continue; } r -= I_OUT;
        if (r < 2 * I_G) { const int half = r / I_G; r -= half * I_G; const int e = r / I_G1, q = r % I_G1, nblk = FF / 32, kb = q / nblk, nb = q % nblk, n0 = 32 * nb;
            const float* W = (half ? F.w_up : F.w_gate) + (size_t)e * DM * FF;
            p0_transpose_item(W, DM, FF, F.WGU + (size_t)e * (2 * FF) * DM, 64 * kb, n0, (n0 >> 7) * 256 + half * 128 + (n0 & 127), scr, F.lane); continue; } r -= 2 * I_G;
        { const int e = r / I_D1, q = r % I_D1, nblk = DM / 32, kb = q / nblk, nb = q % nblk;
          p0_transpose_item(F.w_down + (size_t)e * FF * DM, FF, DM, F.WDN + (size_t)e * DM * FF, 64 * kb, 32 * nb, 32 * nb, scr, F.lane); }
    }
}
__device__ __forceinline__ void phase_p0b(Frame& F) {
    const int gw = F.vcu * NWAVES + F.wave, NGW = F.G * NWAVES;
    for (int m = gw; m < MTOK; m += NGW) {
        const int b = m / SEQ; const float* mod = F.MOD + b * 6 * DM;
        const GAS f32x4* xr = (const GAS f32x4*)(F.x + (size_t)m * DM) + F.lane;
        f32x4 v[4]; float s = 0.f;
#pragma unroll
        for (int j = 0; j < 4; ++j) { v[j] = xr[64 * j]; s += (v[j].x * v[j].x + v[j].y * v[j].y) + (v[j].z * v[j].z + v[j].w * v[j].w); }
        const float r = 1.f / sqrtf(wave_sum(s) * (1.f / DM) + RMS_EPS);
        GAS v2u* o8 = (GAS v2u*)(F.XN + (size_t)m * DM) + F.lane;
#pragma unroll
        for (int j = 0; j < 4; ++j) { const int c = 4 * F.lane + 256 * j;
            const f32x4 g = *(const f32x4*)(F.g_pre_mix + c), sc = *(const f32x4*)(mod + DM + c), sh = *(const f32x4*)(mod + c);
            const f32x4 h = v[j] * r * g * (sc + 1.f) + sh;
            v2u w; w.x = pk2(h.x, h.y); w.y = pk2(h.z, h.w); o8[64 * j] = w; }
    }
}
__device__ __forceinline__ float lg2_sigmoid(float x) { return -log1pf(__expf(-x)) * LOG2E; }
struct AttnDesc { int b, h, cfg, r, qblk; };
__device__ __forceinline__ AttnDesc attn_decode(int u) {
    AttnDesc a; const int blk = u & 31; a.h = (u >> 5) & 7; a.b = (u >> 8) & 1; a.cfg = u >> 9;
    const int d = (a.cfg == 0) ? 1 : ((a.cfg == 1) ? 4 : 16), nq = (SEQ / d) / 256; a.r = blk / nq; a.qblk = blk % nq; return a;
}
constexpr int ATT_KOFF = 0, ATT_VOFF = 49152;
__device__ __forceinline__ void attn_prefetch(Frame& F, const AttnDesc& a, v4u (&kr)[6], v4u (&vr)[6]) {
    const int d = (a.cfg == 0) ? 1 : ((a.cfg == 1) ? 4 : 16), L = SEQ / d;
    const bf16* P = F.PROJ + (size_t)a.b * SEQ * NPROJ;
    const int wl0 = 256 * a.qblk - 64, ch = F.tid & 7;
#pragma unroll
    for (int p = 0; p < 6; ++p) {
        int l = wl0 + p * 64 + (F.tid >> 3); l = l < 0 ? 0 : (l > L - 1 ? L - 1 : l);
        const bf16* rp = P + (size_t)(l * d + a.r) * NPROJ + a.h * AD + ch * 8;
        kr[p] = *(const v4u*)(rp + C_AK); vr[p] = *(const v4u*)(rp + C_AV);
    }
}
__device__ __forceinline__ void attn_stage(Frame& F, const v4u (&kr)[6], const v4u (&vr)[6]) {
    const int ch = F.tid & 7;
#pragma unroll
    for (int p = 0; p < 6; ++p) { const int kidx = p * 64 + (F.tid >> 3);
        *(LAS v4u*)(F.lds + ATT_KOFF + kidx * 128 + ((ch ^ (kidx & 7)) << 4)) = kr[p];
        *(LAS v4u*)(F.lds + ATT_VOFF + (ch >> 2) * (384 * 64) + (kidx >> 3) * 512 + (kidx & 7) * 64 + (ch & 3) * 16) = vr[p]; }
}
__device__ __forceinline__ void attn_compute(Frame& F, const AttnDesc& a) {
    const int cfg = a.cfg, h = a.h, b = a.b, r = a.r, qblk = a.qblk;
    const int d = (cfg == 0) ? 1 : ((cfg == 1) ? 4 : 16), L = SEQ / d;
    const int wave = F.wave; int lane = F.lane; asm volatile("" : "+v"(lane));
    const int i = lane & 31, hi = lane >> 5;
    const bf16* P = F.PROJ + (size_t)b * SEQ * NPROJ;
    const int lw0 = 256 * qblk + 32 * wave - 64;
    const int ql = 256 * qblk + 32 * wave + i;
    bf16x8 qf[4];
    { const bf16* qp = P + (size_t)(ql * d + r) * NPROJ + C_AQ + h * AD + hi * 8;
#pragma unroll
      for (int s = 0; s < 4; ++s) qf[s] = *(const bf16x8*)(qp + 16 * s); }
    const float slope2 = ex2(-(float)(h + 1)) * (float)d * LOG2E;
    f32x16 acc[5];
    const int a0 = i + 64 - 4 * hi;
    const LAS unsigned char* Kl = F.lds + ATT_KOFF;
#pragma unroll
    for (int T = 0; T < 5; ++T) {
        const float cinit = (T < 2) ? -slope2 * (float)(a0 - 32 * T) : ((T > 2) ? slope2 * (float)(a0 - 32 * T) : 0.f);
        f32x16 c;
#pragma unroll
        for (int rr = 0; rr < 16; ++rr) c[rr] = cinit;
        const int key = 32 * wave + 32 * T + i;
#pragma unroll
        for (int s = 0; s < 4; ++s) { const bf16x8 kf = *(const LAS bf16x8*)(Kl + key * 128 + (((2 * s + hi) ^ (key & 7)) << 4));
            c = __builtin_amdgcn_mfma_f32_32x32x16_bf16(kf, qf[s], c, 0, 0, 0); }
        acc[T] = c;
    }
    if (lw0 < 0 || lw0 + 160 > L) {
#pragma unroll
        for (int T = 0; T < 5; ++T)
#pragma unroll
            for (int rr = 0; rr < 16; ++rr) { const int kl = lw0 + 32 * T + crow(rr, hi); if (kl < 0 || kl >= L) acc[T][rr] = -1.0e30f; }
    }
    const int th0 = i - 4 * hi; const float fa2 = (float)(a0 - 64);
    float mx = -3.0e38f;
#pragma unroll
    for (int rr = 0; rr < 16; ++rr) { const int c0 = (rr & 3) + 8 * (rr >> 2); const float sc0 = slope2 * (float)c0;
        float v0 = acc[0][rr] + sc0; v0 = (c0 >= th0) ? v0 : -1.0e30f;
        const float v1 = acc[1][rr] + sc0;
        const float v2 = acc[2][rr] - slope2 * fabsf(fa2 - (float)c0);
        const float v3 = acc[3][rr] - sc0;
        float v4 = acc[4][rr] - sc0; v4 = (c0 <= th0) ? v4 : -1.0e30f;
        acc[0][rr] = v0; acc[1][rr] = v1; acc[2][rr] = v2; acc[3][rr] = v3; acc[4][rr] = v4;
        mx = fmaxf(mx, fmaxf(fmaxf(v0, v1), fmaxf(fmaxf(v2, v3), v4))); }
    mx = fmaxf(mx, __shfl_xor(mx, 32));
    float lsum = 0.f;
#pragma unroll
    for (int T = 0; T < 5; ++T)
#pragma unroll
        for (int rr = 0; rr < 16; ++rr) { const float p = ex2(acc[T][rr] - mx); acc[T][rr] = p; lsum += p; }
    lsum += __shfl_xor(lsum, 32);
    f32x16 o[2]; o[0] = f32x16{}; o[1] = f32x16{};
    const LAS unsigned char* vb = F.lds + ATT_VOFF + ((lane >> 4) & 1) * 32 + (lane & 3) * 8 + (4 * hi + ((lane & 15) >> 2)) * 64;
#pragma unroll
    for (int T = 0; T < 5; ++T)
#pragma unroll
        for (int u = 0; u < 2; ++u) {
            v4u pw; pw.x = pk2(acc[T][8 * u + 0], acc[T][8 * u + 1]); pw.y = pk2(acc[T][8 * u + 2], acc[T][8 * u + 3]); pw.z = pk2(acc[T][8 * u + 4], acc[T][8 * u + 5]); pw.w = pk2(acc[T][8 * u + 6], acc[T][8 * u + 7]);
            const bf16x8 pb = __builtin_bit_cast(bf16x8, pw);
            const int kbase = 32 * wave + 32 * T + 16 * u;
#pragma unroll
            for (int dt = 0; dt < 2; ++dt) {
                const LAS unsigned char* aa = vb + dt * (384 * 64) + (kbase >> 3) * 512;
                const bf16x8 va = cat8(vtr(aa), vtr(aa + 512));
                o[dt] = __builtin_amdgcn_mfma_f32_32x32x16_bf16(va, pb, o[dt], 0, 0, 0);
            }
        }
    const float inv = 1.f / lsum;
    const size_t row = (size_t)b * SEQ + (size_t)(ql * d + r);
    bf16* op = F.ATTO + ((size_t)cfg * MTOK + row) * (AH * AD) + h * AD;
#pragma unroll
    for (int dt = 0; dt < 2; ++dt)
#pragma unroll
        for (int g = 0; g < 4; ++g) { v2u w; w.x = pk2(o[dt][4 * g] * inv, o[dt][4 * g + 1] * inv); w.y = pk2(o[dt][4 * g + 2] * inv, o[dt][4 * g + 3] * inv);
            *(v2u*)(op + 32 * dt + 8 * g + 4 * hi) = w; }
    if (hi == 0) F.LSE[((size_t)cfg * MTOK + row) * AH + h] = mx + __builtin_amdgcn_logf(lsum);
}
__device__ __forceinline__ void kv_unit(Frame& F, int b, int h, int n) {
    const int tid = F.tid, wave = F.wave; int lane = F.lane; asm volatile("" : "+v"(lane));
    const int hi = lane >> 5;
    const float lgf = lg2_sigmoid(F.dec_f[h]), lgb = lg2_sigmoid(F.dec_b[h]);
    const size_t row0 = (size_t)b * SEQ + (size_t)n * CHK;
    LAS unsigned char* Vl = F.lds;
    LAS unsigned char* Kl = F.lds + 32768;
#pragma unroll
    for (int p = 0; p < 4; ++p) { const int idx = p * 512 + tid, key = idx >> 4, ch = idx & 15;
        const v4u val = *(const v4u*)(F.PROJ + (row0 + key) * NPROJ + C_RV + h * RV + ch * 8);
        *(LAS v4u*)(Vl + (ch >> 2) * (128 * 64) + (key >> 3) * 512 + (key & 7) * 64 + (ch & 3) * 16) = val; }
#pragma unroll
    for (int p = 0; p < 2; ++p) { const int idx = p * 512 + tid, key = idx >> 3, ch = idx & 7;
        const v4u val = *(const v4u*)(F.PROJ + (row0 + key) * NPROJ + C_RK + h * RQK + ch * 8);
        const float sf = ex2(lgf * (float)(127 - key)), sb = ex2(lgb * (float)key);
        v4u wf, wb;
        wf.x = pk2(bflo(val.x) * sf, bfhi(val.x) * sf); wf.y = pk2(bflo(val.y) * sf, bfhi(val.y) * sf); wf.z = pk2(bflo(val.z) * sf, bfhi(val.z) * sf); wf.w = pk2(bflo(val.w) * sf, bfhi(val.w) * sf);
        wb.x = pk2(bflo(val.x) * sb, bfhi(val.x) * sb); wb.y = pk2(bflo(val.y) * sb, bfhi(val.y) * sb); wb.z = pk2(bflo(val.z) * sb, bfhi(val.z) * sb); wb.w = pk2(bflo(val.w) * sb, bfhi(val.w) * sb);
        const int off = (ch >> 2) * (128 * 64) + (key >> 3) * 512 + (key & 7) * 64 + (ch & 3) * 16;
        *(LAS v4u*)(Kl + off) = wf; *(LAS v4u*)(Kl + 16384 + off) = wb; }
    __syncthreads();
    const int dir = wave >> 2, dvt = wave & 3;
    const int lofs = ((lane >> 4) & 1) * 32 + (lane & 3) * 8 + (4 * hi + ((lane & 15) >> 2)) * 64;
    const LAS unsigned char* va = Vl + dvt * (128 * 64) + lofs;
    float* kvout = F.KV + ((size_t)(((b * RH + h) * 2 + dir) * NCH + n)) * (RV * RQK);
#pragma unroll
    for (int dkt = 0; dkt < 2; ++dkt) {
        const LAS unsigned char* ka = Kl + dir * 16384 + dkt * (128 * 64) + lofs;
        f32x16 a = {};
#pragma unroll
        for (int s = 0; s < 8; ++s) {
            const bf16x8 A = cat8(vtr(va + s * 1024), vtr(va + s * 1024 + 512));
            const bf16x8 B = cat8(vtr(ka + s * 1024), vtr(ka + s * 1024 + 512));
            a = __builtin_amdgcn_mfma_f32_32x32x16_bf16(A, B, a, 0, 0, 0);
        }
#pragma unroll
        for (int rr = 0; rr < 16; ++rr) kvout[(32 * dvt + crow(rr, hi)) * RQK + 32 * dkt + (lane & 31)] = a[rr];
    }
    __syncthreads();
}
__device__ __forceinline__ void phase_p2(Frame& F) {
    constexpr int NATT = BATCH * AH * 3 * (SEQ / 256);
    if (F.vcu < NATT) {
        v4u kr[6], vr[6];
        attn_prefetch(F, attn_decode(F.vcu), kr, vr);
        for (int u = F.vcu; u < NATT; u += F.G) {
            attn_stage(F, kr, vr);
            __syncthreads();
            if (u + F.G < NATT) attn_prefetch(F, attn_decode(u + F.G), kr, vr);
            attn_compute(F, attn_decode(u));
            __syncthreads();
        }
    }
    constexpr int NKV = BATCH * RH * NCH;
    for (int u = F.vcu; u < NKV; u += F.G) kv_unit(F, u >> 8, (u >> 6) & 3, u & 63);
}
__device__ __forceinline__ void phase_p3(Frame& F) {
    for (int g = F.vcu * (NWAVES * 64) + F.tid; g < BATCH * RH * 2 * (RV * RQK); g += F.G * NWAVES * 64) {
        const int bhd = g >> 13, e = g & 8191, dir = bhd & 1, h = (bhd >> 1) & 3;
        const float lam = ex2(128.f * lg2_sigmoid(dir ? F.dec_b[h] : F.dec_f[h]));
        const float* kv = F.KV + (size_t)bhd * NCH * 8192 + e; bf16* pv = F.PREV + (size_t)bhd * NCH * 8192 + e;
        float st = 0.f;
        for (int n0 = 0; n0 < NCH; n0 += 8) {
            float v[8];
#pragma unroll
            for (int k = 0; k < 8; ++k) { const int n = dir ? (NCH - 1 - (n0 + k)) : (n0 + k); v[k] = kv[(size_t)n * 8192]; }
#pragma unroll
            for (int k = 0; k < 8; ++k) { const int n = dir ? (NCH - 1 - (n0 + k)) : (n0 + k); pv[(size_t)n * 8192] = (bf16)(pk2(st, 0.f) & 0xffffu); st = lam * st + v[k]; }
        }
    }
    const int gw = F.vcu * NWAVES + F.wave, NGW = F.G * NWAVES;
    for (int m = gw; m < MTOK; m += NGW) {
        const int hd = F.lane >> 3, part = F.lane & 7;
        const float l0 = F.LSE[(size_t)m * AH + hd], l1 = F.LSE[((size_t)MTOK + m) * AH + hd], l2 = F.LSE[((size_t)2 * MTOK + m) * AH + hd];
        const float mx = fmaxf(l0, fmaxf(l1, l2)); float w0 = ex2(l0 - mx), w1 = ex2(l1 - mx), w2 = ex2(l2 - mx); const float inv = 1.f / (w0 + w1 + w2); w0 *= inv; w1 *= inv; w2 *= inv;
        const v4u a = *(const v4u*)(F.ATTO + (size_t)m * 512 + F.lane * 8), bq = *(const v4u*)(F.ATTO + ((size_t)MTOK + m) * 512 + F.lane * 8), cq = *(const v4u*)(F.ATTO + ((size_t)2 * MTOK + m) * 512 + F.lane * 8);
        (void)part;
        v4u o;
        o.x = pk2(w0 * bflo(a.x) + w1 * bflo(bq.x) + w2 * bflo(cq.x), w0 * bfhi(a.x) + w1 * bfhi(bq.x) + w2 * bfhi(cq.x));
        o.y = pk2(w0 * bflo(a.y) + w1 * bflo(bq.y) + w2 * bflo(cq.y), w0 * bfhi(a.y) + w1 * bfhi(bq.y) + w2 * bfhi(cq.y));
        o.z = pk2(w0 * bflo(a.z) + w1 * bflo(bq.z) + w2 * bflo(cq.z), w0 * bfhi(a.z) + w1 * bfhi(bq.z) + w2 * bfhi(cq.z));
        o.w = pk2(w0 * bflo(a.w) + w1 * bflo(bq.w) + w2 * bflo(cq.w), w0 * bfhi(a.w) + w1 * bfhi(bq.w) + w2 * bfhi(cq.w));
        *(v4u*)(F.Y + (size_t)m * DM + 512 + F.lane * 8) = o;
    }
}
__device__ __forceinline__ bf16x8 scale8(bf16x8 q, float s) {
    const v4u w = __builtin_bit_cast(v4u, q); v4u o;
    o.x = pk2(bflo(w.x) * s, bfhi(w.x) * s); o.y = pk2(bflo(w.y) * s, bfhi(w.y) * s); o.z = pk2(bflo(w.z) * s, bfhi(w.z) * s); o.w = pk2(bflo(w.w) * s, bfhi(w.w) * s);
    return __builtin_bit_cast(bf16x8, o);
}
__device__ __forceinline__ void ret_pair(Frame& F, int pair) {
    const int tid = F.tid, wave = F.wave; int lane = F.lane; asm volatile("" : "+v"(lane));
    const int i = lane & 31, hi = lane >> 5, grp = wave >> 2, w4 = wave & 3;
    const int cid = 2 * pair + grp, n = cid & 63, h = (cid >> 6) & 3, b = cid >> 8;
    const float lgf = lg2_sigmoid(F.dec_f[h]), lgb = lg2_sigmoid(F.dec_b[h]);
    const size_t row0 = (size_t)b * SEQ + (size_t)n * CHK;
    LAS unsigned char* Vl = F.lds + grp * 65536;
    LAS unsigned char* Pl = Vl + 32768;
    const int qi = 32 * w4 + i; const size_t qrow = row0 + qi;
    {
        const int t4 = tid & 255;
        v4u vreg[8], preg[8];
#pragma unroll
        for (int p = 0; p < 8; ++p) { const int idx = p * 256 + t4, key = idx >> 4, ch = idx & 15;
            vreg[p] = *(const v4u*)(F.PROJ + (row0 + key) * NPROJ + C_RV + h * RV + ch * 8); }
        const bf16* pf = F.PREV + ((size_t)(((b * RH + h) * 2 + 0) * NCH + n)) * (RV * RQK);
        const bf16* pb_ = F.PREV + ((size_t)(((b * RH + h) * 2 + 1) * NCH + n)) * (RV * RQK);
#pragma unroll
        for (int p = 0; p < 4; ++p) { const int idx = p * 256 + t4;
            preg[p] = *(const v4u*)(pf + (size_t)idx * 8); preg[4 + p] = *(const v4u*)(pb_ + (size_t)idx * 8); }
#pragma unroll
        for (int p = 0; p < 8; ++p) { const int idx = p * 256 + t4, key = idx >> 4, ch = idx & 15;
            *(LAS v4u*)(Vl + (ch >> 2) * (128 * 64) + (key >> 3) * 512 + (key & 7) * 64 + (ch & 3) * 16) = vreg[p]; }
#pragma unroll
        for (int p = 0; p < 4; ++p) { const int idx = p * 256 + t4, rw = idx >> 3, ch = idx & 7; const int off = rw * 128 + ((ch ^ (rw & 7)) << 4);
            *(LAS v4u*)(Pl + off) = preg[p]; *(LAS v4u*)(Pl + 16384 + off) = preg[4 + p]; }
    }
    bf16x8 qf[4];
    { const bf16* qp = F.PROJ + qrow * NPROJ + C_RQ + h * RQK + hi * 8;
#pragma unroll
      for (int s = 0; s < 4; ++s) qf[s] = *(const bf16x8*)(qp + 16 * s); }
    f32x16 acc[4];
    bf16x8 kf[2][4];
#define RET_LOADK(T, buf) do { const bf16* kp_ = F.PROJ + (row0 + 32 * (T) + i) * NPROJ + C_RK + h * RQK + hi * 8; \
        _Pragma("unroll") for (int s_ = 0; s_ < 4; ++s_) kf[buf][s_] = *(const bf16x8*)(kp_ + 16 * s_); } while (0)
    RET_LOADK(0, 0);
    v2u gw[4][4];
    { const bf16* gp = F.PROJ + qrow * NPROJ + C_RG + h * RV + 4 * hi;
#pragma unroll
      for (int dvt = 0; dvt < 4; ++dvt)
#pragma unroll
          for (int g = 0; g < 4; ++g) gw[dvt][g] = *(const v2u*)(gp + 32 * dvt + 8 * g); }
    __syncthreads();
#pragma unroll
    for (int T = 0; T < 4; ++T) {
        if (T + 1 < 4) RET_LOADK(T + 1, (T + 1) & 1);
        asm volatile("" ::: "memory");
        f32x16 a = {};
#pragma unroll
        for (int s = 0; s < 4; ++s) a = __builtin_amdgcn_mfma_f32_32x32x16_bf16(kf[T & 1][s], qf[s], a, 0, 0, 0);
        acc[T] = a;
    }
#undef RET_LOADK
#pragma unroll
    for (int T = 0; T < 4; ++T)
#pragma unroll
        for (int rr = 0; rr < 16; ++rr) { const int rel = qi - (32 * T + crow(rr, hi)); const float e = rel >= 0 ? lgf * (float)rel : -lgb * (float)rel; acc[T][rr] *= ex2(e); }
    f32x16 o[4]; o[0] = f32x16{}; o[1] = f32x16{}; o[2] = f32x16{}; o[3] = f32x16{};
    const LAS unsigned char* vb = Vl + ((lane >> 4) & 1) * 32 + (lane & 3) * 8 + (4 * hi + ((lane & 15) >> 2)) * 64;
#pragma unroll
    for (int T = 0; T < 4; ++T)
#pragma unroll
        for (int u = 0; u < 2; ++u) {
            v4u pw; pw.x = pk2(acc[T][8 * u + 0], acc[T][8 * u + 1]); pw.y = pk2(acc[T][8 * u + 2], acc[T][8 * u + 3]); pw.z = pk2(acc[T][8 * u + 4], acc[T][8 * u + 5]); pw.w = pk2(acc[T][8 * u + 6], acc[T][8 * u + 7]);
            const bf16x8 pb = __builtin_bit_cast(bf16x8, pw);
#pragma unroll
            for (int dvt = 0; dvt < 4; ++dvt) {
                const LAS unsigned char* a = vb + dvt * (128 * 64) + (4 * T + 2 * u) * 512;
                o[dvt] = __builtin_amdgcn_mfma_f32_32x32x16_bf16(cat8(vtr(a), vtr(a + 512)), pb, o[dvt], 0, 0, 0);
            }
            asm volatile("" ::: "memory");
        }
    {
        const float sf = ex2(lgf * (float)(qi + 1)), sb = ex2(lgb * (float)(CHK - qi));
#pragma unroll
        for (int s = 0; s < 4; ++s) {
            const bf16x8 qs_f = scale8(qf[s], sf), qs_b = scale8(qf[s], sb);
#pragma unroll
            for (int dvt = 0; dvt < 4; ++dvt) { const int rw = 32 * dvt + i; const int off = rw * 128 + (((2 * s + hi) ^ (rw & 7)) << 4);
                const bf16x8 af = *(const LAS bf16x8*)(Pl + off), ab = *(const LAS bf16x8*)(Pl + 16384 + off);
                o[dvt] = __builtin_amdgcn_mfma_f32_32x32x16_bf16(af, qs_f, o[dvt], 0, 0, 0);
                o[dvt] = __builtin_amdgcn_mfma_f32_32x32x16_bf16(ab, qs_b, o[dvt], 0, 0, 0);
            }
            asm volatile("" ::: "memory");
        }
    }
    float s1 = 0.f;
#pragma unroll
    for (int dvt = 0; dvt < 4; ++dvt)
#pragma unroll
        for (int rr = 0; rr < 16; ++rr) s1 += o[dvt][rr];
    s1 += __shfl_xor(s1, 32); const float mean = s1 * (1.f / RV);
    float s2 = 0.f;
#pragma unroll
    for (int dvt = 0; dvt < 4; ++dvt)
#pragma unroll
        for (int rr = 0; rr < 16; ++rr) { const float dlt = o[dvt][rr] - mean; s2 += dlt * dlt; }
    s2 += __shfl_xor(s2, 32); const float rstd = 1.f / sqrtf(s2 * (1.f / RV) + GN_EPS);
    bf16* yp = F.Y + qrow * DM + h * RV;
#pragma unroll
    for (int dvt = 0; dvt < 4; ++dvt)
#pragma unroll
        for (int g = 0; g < 4; ++g) { const int dv = 32 * dvt + 8 * g + 4 * hi; const v2u gwv = gw[dvt][g];
            float gv[4] = {bflo(gwv.x), bfhi(gwv.x), bflo(gwv.y), bfhi(gwv.y)}; float yv[4];
#pragma unroll
            for (int k = 0; k < 4; ++k) { const float sg = gv[k] * __builtin_amdgcn_rcpf(1.f + ex2(-gv[k] * LOG2E)); yv[k] = sg * (o[dvt][4 * g + k] - mean) * rstd; }
            v2u w; w.x = pk2(yv[0], yv[1]); w.y = pk2(yv[2], yv[3]); *(v2u*)(yp + dv) = w; }
    __syncthreads();
}
__device__ __forceinline__ void phase_p4(Frame& F) { for (int p = F.vcu; p < BATCH * RH * NCH / 2; p += F.G) ret_pair(F, p); }
constexpr int WR_PITCH = DM + 4;
__device__ __forceinline__ void phase_p6(Frame& F) {
    LAS float* wr = (LAS float*)F.lds;
    for (int idx = F.tid; idx < DM * NE; idx += NWAVES * 64) wr[(idx & 15) * WR_PITCH + (idx >> 4)] = F.w_router[idx];
    __syncthreads();
    const int gw = F.vcu * NWAVES + F.wave, NGW = F.G * NWAVES, lane = F.lane;
    for (int m = gw; m < MTOK; m += NGW) {
        const int b = m / SEQ, spos = m % SEQ; const float* mod = F.MOD + b * 6 * DM;
        const GAS f32x4* mr = (const GAS f32x4*)(F.MIXED + (size_t)m * DM) + lane;
        const GAS f32x4* xr = (const GAS f32x4*)(F.x + (size_t)m * DM) + lane;
        f32x4 v[4], xv[4]; float s = 0.f;
#pragma unroll
        for (int j = 0; j < 4; ++j) { v[j] = mr[64 * j]; xv[j] = xr[64 * j]; s += (v[j].x * v[j].x + v[j].y * v[j].y) + (v[j].z * v[j].z + v[j].w * v[j].w); }
        const float r1 = 1.f / sqrtf(wave_sum(s) * (1.f / DM) + RMS_EPS);
        float s2 = 0.f;
        GAS f32x4* orow = (GAS f32x4*)(F.out + (size_t)m * DM) + lane;
#pragma unroll
        for (int j = 0; j < 4; ++j) { const int c = 4 * lane + 256 * j;
            const f32x4 g = *(const f32x4*)(F.g_post_mix + c), gm = *(const f32x4*)(mod + 2 * DM + c);
            xv[j] = xv[j] + gm * (v[j] * r1 * g); orow[64 * j] = xv[j];
            s2 += (xv[j].x * xv[j].x + xv[j].y * xv[j].y) + (xv[j].z * xv[j].z + xv[j].w * xv[j].w); }
        const float r2 = 1.f / sqrtf(wave_sum(s2) * (1.f / DM) + RMS_EPS);
        GAS v2u* h8 = (GAS v2u*)(F.XN + (size_t)m * DM) + lane;
        float lg[NE];
#pragma unroll
        for (int e = 0; e < NE; ++e) lg[e] = 0.f;
#pragma unroll
        for (int j = 0; j < 4; ++j) { const int c = 4 * lane + 256 * j;
            const f32x4 g = *(const f32x4*)(F.g_pre_ffn + c), sc = *(const f32x4*)(mod + 4 * DM + c), sh = *(const f32x4*)(mod + 3 * DM + c);
            const f32x4 h = xv[j] * r2 * g * (sc + 1.f) + sh;
            v2u w; w.x = pk2(h.x, h.y); w.y = pk2(h.z, h.w); h8[64 * j] = w;
#pragma unroll
            for (int e = 0; e < NE; ++e) { const f32x4 wv = *(const LAS f32x4*)(wr + e * WR_PITCH + c); lg[e] += (h.x * wv.x + h.y * wv.y) + (h.z * wv.z + h.w * wv.w); }
            asm volatile("" ::: "memory"); }
        float mxl = -3.0e38f;
#pragma unroll
        for (int e = 0; e < NE; ++e) { lg[e] = wave_sum(lg[e]); mxl = fmaxf(mxl, lg[e]); }
        float den = 0.f;
#pragma unroll
        for (int e = 0; e < NE; ++e) { lg[e] = __expf(lg[e] - mxl); den += lg[e]; }
        const float invd = 1.f / den; float mine = 0.f;
#pragma unroll
        for (int e = 0; e < NE; ++e) mine = (lane == e) ? lg[e] * invd : mine;
        if (lane < NE) F.AFF[((size_t)b * NE + lane) * SEQ + spos] = mine;
    }
}
__device__ __forceinline__ int block_excl_scan(int v, LAS int* wsum, int tid, int lane, int wave, int& total) {
    int inc = v;
#pragma unroll
    for (int o = 1; o < 64; o <<= 1) { const int t = __shfl_up(inc, o); if (lane >= o) inc += t; }
    __syncthreads();
    if (lane == 63) wsum[wave] = inc;
    __syncthreads();
    int base = 0, tot = 0;
#pragma unroll
    for (int w = 0; w < NWAVES; ++w) { const int t = wsum[w]; if (w < wave) base += t; tot += t; }
    total = tot; (void)tid;
    return base + inc - v;
}
__device__ __forceinline__ void phase_p7(Frame& F) {
    if (F.vcu >= BATCH * NE) return;
    const int be = F.vcu, b = be / NE, e = be % NE, tid = F.tid;
    LAS int* hist = (LAS int*)F.lds; LAS int* wsum = hist + 256; LAS int* bc = hist + 272;
    const float* a = F.AFF + (size_t)be * SEQ;
    unsigned v[16];
#pragma unroll
    for (int q = 0; q < 4; ++q) { const v4u t = *(const v4u*)(a + tid * 16 + q * 4); v[4 * q] = t.x; v[4 * q + 1] = t.y; v[4 * q + 2] = t.z; v[4 * q + 3] = t.w; }
    unsigned prefix = 0u; int kk = CAP;
#pragma unroll 1
    for (int pass = 0; pass < 4; ++pass) {
        const int shift = 24 - 8 * pass; const unsigned hmask = (pass == 0) ? 0u : (0xffffffffu << (shift + 8));
        if (tid < 256) hist[tid] = 0;
        __syncthreads();
#pragma unroll
        for (int q = 0; q < 16; ++q) { if (((v[q] ^ prefix) & hmask) == 0u) __hip_atomic_fetch_add(&hist[(v[q] >> shift) & 255u], 1, __ATOMIC_RELAXED, __HIP_MEMORY_SCOPE_WORKGROUP); }
        __syncthreads();
        {
            const int hc = (tid < 256) ? hist[255 - tid] : 0; int tot_;
            const int excl = block_excl_scan(hc, wsum, tid, F.lane, F.wave, tot_);
            if (tid < 256 && excl < kk && kk <= excl + hc) { bc[0] = 255 - tid; bc[1] = kk - excl; }
        }
        __syncthreads();
        prefix |= (unsigned)bc[0] << shift; kk = bc[1];
        __syncthreads();
    }
    int ceq = 0;
#pragma unroll
    for (int q = 0; q < 16; ++q) ceq += (v[q] == prefix) ? 1 : 0;
    int tot; int eqbase = block_excl_scan(ceq, wsum, tid, F.lane, F.wave, tot);
    unsigned selmask = 0u; int csel = 0;
#pragma unroll
    for (int q = 0; q < 16; ++q) { bool s = v[q] > prefix; if (v[q] == prefix) { s = eqbase < kk; ++eqbase; } if (s) { selmask |= 1u << q; ++csel; } }
    __syncthreads();
    int slot = block_excl_scan(csel, wsum, tid, F.lane, F.wave, tot);
    const int rowbase = (e * BATCH + b) * CAP;
#pragma unroll
    for (int q = 0; q < 16; ++q) { const int tok = b * SEQ + tid * 16 + q; int so = -1;
        if (selmask & (1u << q)) { const int row = rowbase + (slot < CAP ? slot : CAP - 1); so = row; F.TOK[row] = tok; F.GATEV[row] = __uint_as_float(v[q]); ++slot; }
        F.SLOTOF[(size_t)tok * NE + e] = so; }
}
__device__ __forceinline__ void phase_p7b(Frame& F) {
    const int gw = F.vcu * NWAVES + F.wave, NGW = F.G * NWAVES;
    for (int r = gw; r < NSLOT; r += NGW) { const int t = F.TOK[r];
        const v4u* src = (const v4u*)(F.XN + (size_t)t * DM) + F.lane; v4u* dst = (v4u*)(F.XE + (size_t)r * DM) + F.lane;
        const v4u a = src[0], c = src[64]; dst[0] = a; dst[64] = c; }
}
__device__ __forceinline__ void phase_p10(Frame& F) {
    const int gw = F.vcu * NWAVES + F.wave, NGW = F.G * NWAVES, lane = F.lane;
    for (int m = gw; m < MTOK; m += NGW) {
        const int b = m / SEQ; const float* mod = F.MOD + b * 6 * DM;
        float acc[16];
#pragma unroll
        for (int k = 0; k < 16; ++k) acc[k] = 0.f;
        const int myslot = (lane < NE) ? F.SLOTOF[(size_t)m * NE + lane] : -1;
#pragma unroll 1
        for (int e = 0; e < NE; ++e) { const int r = __builtin_amdgcn_readlane(myslot, e);
            if (r >= 0) { const float g = F.GATEV[r]; const v4u* yr = (const v4u*)(F.YE + (size_t)r * DM) + lane;
#pragma unroll
                for (int j = 0; j < 2; ++j) { const v4u w = yr[64 * j];
                    acc[8 * j + 0] += g * bflo(w.x); acc[8 * j + 1] += g * bfhi(w.x); acc[8 * j + 2] += g * bflo(w.y); acc[8 * j + 3] += g * bfhi(w.y);
                    acc[8 * j + 4] += g * bflo(w.z); acc[8 * j + 5] += g * bfhi(w.z); acc[8 * j + 6] += g * bflo(w.w); acc[8 * j + 7] += g * bfhi(w.w); } } }
        float s = 0.f;
#pragma unroll
        for (int k = 0; k < 16; ++k) s += acc[k] * acc[k];
        const float rr = 1.f / sqrtf(wave_sum(s) * (1.f / DM) + RMS_EPS);
        float* orow = F.out + (size_t)m * DM;
#pragma unroll
        for (int j = 0; j < 2; ++j)
#pragma unroll
            for (int q = 0; q < 2; ++q) { const int c = 8 * lane + 512 * j + 4 * q;
                const f32x4 x1 = *(const f32x4*)(orow + c), g = *(const f32x4*)(F.g_post_ffn + c), gf = *(const f32x4*)(mod + 5 * DM + c);
                f32x4 a; a.x = acc[8 * j + 4 * q]; a.y = acc[8 * j + 4 * q + 1]; a.z = acc[8 * j + 4 * q + 2]; a.w = acc[8 * j + 4 * q + 3];
                *(f32x4*)(orow + c) = x1 + gf * (a * rr * g); }
    }
}
struct Args { const float* in[16]; float* out; unsigned char* ws; int ph_lo, ph_hi; };
__global__ void __launch_bounds__(NWAVES * 64, 2) mk_fwd(Args args) {
    extern __shared__ __attribute__((aligned(16))) unsigned char lds[];
    Frame F;
    F.lds = (LAS unsigned char*)lds;
    F.MISC = (volatile LAS unsigned*)(F.lds + MISC_OFF);
    F.tid = threadIdx.x; F.lane = F.tid & 63; F.wave = __builtin_amdgcn_readfirstlane(F.tid >> 6);
    F.G = gridDim.x; { const int bx = blockIdx.x; F.vcu = (F.G % 8 == 0) ? (bx % 8) * (F.G / 8) + bx / 8 : bx; }
    unsigned char* ws = args.ws;
    F.ctl = (gu32*)(ws + WS_CTL);
    F.x = args.in[0]; F.c = args.in[1]; F.w_ada = args.in[2]; F.b_ada = args.in[3]; F.g_pre_mix = args.in[4]; F.g_post_mix = args.in[5]; F.g_pre_ffn = args.in[6]; F.g_post_ffn = args.in[7];
    F.w_in = args.in[8]; F.dec_f = args.in[9]; F.dec_b = args.in[10]; F.w_out = args.in[11]; F.w_router = args.in[12]; F.w_gate = args.in[13]; F.w_up = args.in[14]; F.w_down = args.in[15];
    F.out = args.out;
    F.MOD = (float*)(ws + WS_MOD); F.AFF = (float*)(ws + WS_AFF); F.GATEV = (float*)(ws + WS_GATEV); F.LSE = (float*)(ws + WS_LSE); F.KV = (float*)(ws + WS_KV); F.MIXED = (float*)(ws + WS_MIXED);
    F.TOK = (int*)(ws + WS_TOK); F.SLOTOF = (int*)(ws + WS_SLOTOF);
    F.WIN = (bf16*)(ws + WS_WIN); F.WOUT = (bf16*)(ws + WS_WOUT); F.WGU = (bf16*)(ws + WS_WGU); F.WDN = (bf16*)(ws + WS_WDN); F.XN = (bf16*)(ws + WS_XN); F.PROJ = (bf16*)(ws + WS_PROJ);
    F.PREV = (bf16*)(ws + WS_PREV); F.ATTO = (bf16*)(ws + WS_ATTO); F.Y = (bf16*)(ws + WS_Y); F.XE = (bf16*)(ws + WS_XE); F.HH = (bf16*)(ws + WS_HH); F.YE = (bf16*)(ws + WS_YE);
    for (int u = F.tid; u < (LDS_BYTES - LDSCTL_OFF) / 4; u += NWAVES * 64) ((LAS unsigned*)(F.lds + LDSCTL_OFF))[u] = 0u;
    __syncthreads();
    const int lo = args.ph_lo, hi = args.ph_hi;
    XcdBarrier bar; bar.bar = (unsigned*)(F.ctl + CW_BAR); bar.x = 0; bar.st = nullptr;
    if (hi - lo > 1) bar = xcd_barrier_post((unsigned*)(F.ctl + CW_BAR), F.MISC + 8);
#ifndef PHASE_MASK
#define PHASE_MASK 0xffff
#endif
#define IN(k) (((PHASE_MASK >> (k)) & 1) && lo <= (k) && (k) < hi)
#ifndef REP_MASK
#define REP_MASK 0
#endif
#define NREP(k) ((((REP_MASK) >> (k)) & 1) ? 2 : 1)
#define SEAM(k) do { if (IN(k) && IN((k) + 1)) xcd_barrier(bar); } while (0)
    if (IN(0)) for (int rep_ = 0; rep_ < NREP(0); ++rep_) { phase_p0a(F); } SEAM(0);
    if (IN(1)) for (int rep_ = 0; rep_ < NREP(1); ++rep_) { phase_p0b(F); } SEAM(1);
    if (IN(2)) for (int rep_ = 0; rep_ < NREP(2); ++rep_) {
        pg8::Gemm g{F.XN, F.WIN, MTOK, NPROJ, DM}; pg8::StaticOrder S; S.init(MTOK, NPROJ, F.G, (int)blockIdx.x);
        pg8::EpiBf16S E{F.PROJ, NPROJ, 0xffff, 0.125f, 0.125f * LOG2E, 1};
        pg8::gemm_phase<pg8::EpiBf16S, pg8::StaticOrder, true, true>(F.lds, g, S, E);
    } SEAM(2);
    if (IN(3)) for (int rep_ = 0; rep_ < NREP(3); ++rep_) { phase_p2(F); } SEAM(3);
    if (IN(4)) for (int rep_ = 0; rep_ < NREP(4); ++rep_) { phase_p3(F); } SEAM(4);
    if (IN(5)) for (int rep_ = 0; rep_ < NREP(5); ++rep_) { phase_p4(F); } SEAM(5);
    if (IN(6)) for (int rep_ = 0; rep_ < NREP(6); ++rep_) {
        pg8::Gemm g{F.Y, F.WOUT, MTOK, DM, DM}; pg8::StaticOrder S; S.init(MTOK, DM, F.G, (int)blockIdx.x);
        pg8::EpiF32 E{F.MIXED, DM};
        pg8::gemm_phase<pg8::EpiF32, pg8::StaticOrder, true, true>(F.lds, g, S, E);
    } SEAM(6);
    if (IN(7)) for (int rep_ = 0; rep_ < NREP(7); ++rep_) { phase_p6(F); } SEAM(7);
    if (IN(8)) for (int rep_ = 0; rep_ < NREP(8); ++rep_) { phase_p7(F); } if (IN(8) && IN(10)) xcd_barrier(bar);
    if (IN(10)) for (int rep_ = 0; rep_ < NREP(10); ++rep_) {
        pg8::Gemm g{F.XN, F.WGU, NSLOT, NE * 2 * FF, DM}; pg8::MoeOrder S{16, F.G, F.vcu};
        pg8::EpiSwiGLU E{F.HH, FF};
        pg8::gemm_phase<pg8::EpiSwiGLU, pg8::MoeOrder, true, true, true>(F.lds, g, S, E, F.TOK, (LAS int*)(F.lds + MISC_OFF + 256));
    } SEAM(10);
    if (IN(11)) for (int rep_ = 0; rep_ < NREP(11); ++rep_) {
        pg8::Gemm g{F.HH, F.WDN, NSLOT, NE * DM, FF}; pg8::MoeOrder S{4, F.G, F.vcu};
        pg8::EpiBf16S E{F.YE, DM, 3, 1.f, 1.f, 0};
        pg8::gemm_phase<pg8::EpiBf16S, pg8::MoeOrder, true, true>(F.lds, g, S, E);
    } SEAM(11);
    if (IN(12)) for (int rep_ = 0; rep_ < NREP(12); ++rep_) { phase_p10(F); }
#undef IN
#undef SEAM
}

extern "C" void kernel_launch(void* const* d_in, const int* in_sizes, int n_in, void* d_out, int out_size, void* d_ws, size_t ws_size, hipStream_t stream) {
    static int grid = 0;
    if (grid == 0) {
        if (n_in != 16 || in_sizes[0] != MTOK * DM || out_size != MTOK * DM || ws_size < WS_END) { fprintf(stderr, "kernel_launch: unexpected shapes: n_in %d in0 %d out %d ws %zu (need %zu)\n", n_in, n_in > 0 ? in_sizes[0] : -1, out_size, ws_size, (size_t)WS_END); grid = -1; return; }
        int dev = 0, cus = 0;
        if (hipGetDevice(&dev) != hipSuccess || hipDeviceGetAttribute(&cus, hipDeviceAttributeMultiprocessorCount, dev) != hipSuccess) { grid = -1; return; }
        if (hipFuncSetAttribute((const void*)mk_fwd, hipFuncAttributeMaxDynamicSharedMemorySize, LDS_BYTES) != hipSuccess) { fprintf(stderr, "kernel_launch: hipFuncSetAttribute failed\n"); grid = -1; return; }
        int per_cu = 0;
        if (hipOccupancyMaxActiveBlocksPerMultiprocessor(&per_cu, (const void*)mk_fwd, NWAVES * 64, LDS_BYTES) != hipSuccess || per_cu < 1) fprintf(stderr, "kernel_launch: occupancy query says %d blocks per CU\n", per_cu);
        (void)hipGetLastError();
        grid = cus;
    }
    if (grid < 0) return;
    (void)hipMemsetAsync((char*)d_ws + WS_CTL, 0, CTL_ZERO_BYTES, stream);
    Args a{};
    for (int i = 0; i < 16; ++i) a.in[i] = (const float*)d_in[i];
    a.out = (float*)d_out; a.ws = (unsigned char*)d_ws;
#if MK_ONE_LAUNCH
    a.ph_lo = 0; a.ph_hi = NPHASE;
    hipLaunchKernelGGL(mk_fwd, dim3(grid), dim3(NWAVES * 64), LDS_BYTES, stream, a);
#else
    for (int p = 0; p < NPHASE; ++p) { a.ph_lo = p; a.ph_hi = p + 1; hipLaunchKernelGGL(mk_fwd, dim3(grid), dim3(NWAVES * 64), LDS_BYTES, stream, a); }
#endif
}
```

```cpp
#include <hip/hip_runtime.h>
#include <cstdio>
#include <cstdint>
namespace pg8 {
#define PG8_LAS __attribute__((address_space(3)))
typedef unsigned short bf16_t;
typedef short bf16x8 __attribute__((ext_vector_type(8)));
typedef float f32x4 __attribute__((ext_vector_type(4)));
typedef unsigned u32x4 __attribute__((ext_vector_type(4)));
constexpr int BM = 256, BK = 64, HALF = 128, HTB = HALF * BK * 2  , STAGE_BYTES = 8 * HTB, NXCD = 8, WGM = 8;

__host__ __device__ __forceinline__ int lds_byte(int r, int c) { const int st = (r >> 4) * 2 + (c >> 5), rr = r & 15, cc = c & 31, ob = rr * 64 + cc * 2; return st * 1024 + (ob ^ (((ob >> 9) & 1) << 5)); }
__host__ __device__ __forceinline__ void stage_rc(int b, int& R, int& C) { const int st = b / 1024, sb = b % 1024, swz = sb ^ (((sb >> 9) & 1) << 5); R = (st >> 1) * 16 + swz / 64; C = (st & 1) * 32 + (swz % 64) / 2; }
__host__ __device__ __forceinline__ int perm32(int rho) { const int n = rho >> 4, i = rho & 15; return 8 * (i >> 2) + 4 * n + (i & 3); }

struct Unit { int pm, pn; };
struct Gemm { const bf16_t* A; const bf16_t* Bt; int M, N, K; };

struct StaticOrder {
    int nM, nN, nwg, G, c;
    __host__ __device__ void init(int M, int N, int G_, int c_) { nM = M / BM; nN = N / BM; nwg = nM * nN; G = G_; c = c_; }
    __host__ __device__ bool next(int i, Unit& u) const {
        const long L = (long)i * G + c; if (L >= nwg) return false;
        int wgid = (int)L; { const int q = nwg / NXCD, r = nwg % NXCD, xcd = wgid % NXCD, off = wgid / NXCD; wgid = (xcd < r ? xcd * (q + 1) : r * (q + 1) + (xcd - r) * q) + off; }
        const int nig = WGM * nN, gid = wgid / nig, fm = gid * WGM, gsz = (nM - fm) < WGM ? (nM - fm) : WGM;
        u.pm = fm + ((wgid % nig) % gsz); u.pn = (wgid % nig) / gsz; return true;
    }
    __device__ __forceinline__ void a_ready(const Unit&) const {}
    __device__ __forceinline__ void done(const Unit&) const {}
};

__device__ __forceinline__ unsigned cvt_pk_bf16(float lo, float hi) { unsigned r; asm volatile("v_cvt_pk_bf16_f32 %0, %1, %2" : "=v"(r) : "v"(lo), "v"(hi)); return r; }
typedef float f32x2 __attribute__((ext_vector_type(2)));
typedef unsigned u32x2 __attribute__((ext_vector_type(2)));
constexpr float LOG2E_F = 1.4426950408889634f;
struct EpiF32 {
    static constexpr bool PERM = false, AFTER_DRAIN = false;
    float* C; int ldc;
    __device__ __forceinline__ void operator()(const f32x4 (&acc)[2][2][4][2], const Unit& u, int wr, int wc, int fr, int fq) const {
        const int row0 = u.pm * BM + wr * 64 + fr, col0 = u.pn * BM + wc * 32 + 4 * fq;
#pragma unroll
        for (int ai = 0; ai < 2; ++ai)
#pragma unroll
            for (int m = 0; m < 4; ++m) { float* rowp = C + (size_t)(row0 + ai * HALF + m * 16) * ldc + col0;
#pragma unroll
                for (int bj = 0; bj < 2; ++bj)
#pragma unroll
                    for (int n = 0; n < 2; ++n) *(f32x4*)(rowp + bj * HALF + n * 16) = acc[ai][bj][m][n]; }
    }
};
struct EpiBf16S {
    static constexpr bool PERM = true, AFTER_DRAIN = false;
    bf16_t* O; int ldc; int pn_mask; float s_rk, s_aq; int proj;
    __device__ __forceinline__ void operator()(const f32x4 (&acc)[2][2][4][2], const Unit& u, int wr, int wc, int fr, int fq) const {
        const int pn = u.pn & pn_mask;
        const int row0 = u.pm * BM + wr * 64 + fr, col0 = pn * BM + wc * 32 + 8 * fq;
        float sc = 1.f; if (proj) sc = (pn == 1) ? s_rk : ((pn == 6 || pn == 7) ? s_aq : 1.f);
#pragma unroll
        for (int ai = 0; ai < 2; ++ai)
#pragma unroll
            for (int m = 0; m < 4; ++m) { bf16_t* rowp = O + (size_t)(row0 + ai * HALF + m * 16) * ldc + col0;
#pragma unroll
                for (int bj = 0; bj < 2; ++bj) { const f32x4 v0 = acc[ai][bj][m][0] * sc, v1 = acc[ai][bj][m][1] * sc;
                    u32x4 w; w.x = cvt_pk_bf16(v0[0], v0[1]); w.y = cvt_pk_bf16(v0[2], v0[3]); w.z = cvt_pk_bf16(v1[0], v1[1]); w.w = cvt_pk_bf16(v1[2], v1[3]);
                    *(u32x4*)(rowp + bj * HALF) = w; } }
    }
};
struct EpiSwiGLU {
    static constexpr bool PERM = true, AFTER_DRAIN = false;
    bf16_t* O; int ldc;
    __device__ __forceinline__ float act(float g, float up) const { return g * up * __builtin_amdgcn_rcpf(1.f + __builtin_amdgcn_exp2f(-g * LOG2E_F)); }
    __device__ __forceinline__ void operator()(const f32x4 (&acc)[2][2][4][2], const Unit& u, int wr, int wc, int fr, int fq) const {
        const int row0 = u.pm * BM + wr * 64 + fr, col0 = (u.pn & 15) * HALF + wc * 32 + 8 * fq;
#pragma unroll
        for (int ai = 0; ai < 2; ++ai)
#pragma unroll
            for (int m = 0; m < 4; ++m) { bf16_t* rowp = O + (size_t)(row0 + ai * HALF + m * 16) * ldc + col0;
                const f32x4 g0 = acc[ai][0][m][0], g1 = acc[ai][0][m][1], u0 = acc[ai][1][m][0], u1 = acc[ai][1][m][1];
                u32x4 w; w.x = cvt_pk_bf16(act(g0[0], u0[0]), act(g0[1], u0[1])); w.y = cvt_pk_bf16(act(g0[2], u0[2]), act(g0[3], u0[3]));
                w.z = cvt_pk_bf16(act(g1[0], u1[0]), act(g1[1], u1[1])); w.w = cvt_pk_bf16(act(g1[2], u1[2]), act(g1[3], u1[3]));
                *(u32x4*)rowp = w; }
    }
};
struct MoeOrder {
    int ntile, G, vcu;
    __device__ __forceinline__ bool next(int i, Unit& u) const {
        const int total = 16 * 8 * ntile; int L;
        if ((G & 7) == 0) { const int g8 = G >> 3, x = vcu / g8, c = vcu % g8, share = total >> 3, l = i * g8 + c; if (l >= share) return false; L = x * share + l; }
        else { L = i * G + vcu; if (L >= total) return false; }
        const int e = L / (8 * ntile), rem = L % (8 * ntile);
        u.pm = e * 8 + (rem & 7); u.pn = e * ntile + (rem >> 3); return true;
    }
    __device__ __forceinline__ void a_ready(const Unit&) const {}
    __device__ __forceinline__ void done(const Unit&) const {}
};
template <class Epi, class Sched, bool ALIGN_EPI = false, bool SP2 = false, bool GATHER = false>
__device__ __forceinline__ void gemm_phase(PG8_LAS unsigned char* lds, const Gemm g, const Sched& S, const Epi& E, const int* rowmap = nullptr, PG8_LAS int* ldsrow = nullptr) {
    const int tid = threadIdx.x, wid = __builtin_amdgcn_readfirstlane(tid >> 6), lane = tid & 63, wr = wid >> 2, wc = wid & 3, fr = lane & 15, fq = lane >> 4;
    const int K = g.K, nt = K / BK;
    unsigned voffA[2], voffB[2];
#pragma unroll
    for (int i = 0; i < 2; ++i) { int R, C; stage_rc(tid * 16 + i * 8192, R, C); const int Rb = Epi::PERM ? ((R & ~31) + perm32(R & 31)) : R;
        voffA[i] = (unsigned)(R * K + C) * 2u; voffB[i] = (unsigned)(Rb * K + C) * 2u; }
    unsigned gC[2][2] = {{0u, 0u}, {0u, 0u}}, gN[2][2] = {{0u, 0u}, {0u, 0u}}; int gR[2] = {0, 0}; unsigned gCb[2] = {0u, 0u};
    if constexpr (GATHER) {
#pragma unroll
        for (int i = 0; i < 2; ++i) { int R, C; stage_rc(tid * 16 + i * 8192, R, C); gR[i] = R; gCb[i] = (unsigned)C * 2u; }
        Unit uu;
        for (int ui_ = 0; ui_ < 8; ++ui_) { if (!S.next(ui_, uu)) break; if (tid < 256) ldsrow[ui_ * 256 + tid] = rowmap[uu.pm * BM + tid]; }
        __syncthreads();
#pragma unroll
        for (int h = 0; h < 2; ++h)
#pragma unroll
            for (int i = 0; i < 2; ++i) gC[h][i] = (unsigned)ldsrow[h * HALF + gR[i]] * (unsigned)(K * 2) + gCb[i];
    }
    const size_t kstep = (size_t)(BK * 2);
    const size_t hstep = (size_t)HALF * K * 2;
    const size_t tstep = 2 * hstep;
    const unsigned ldsw = (unsigned)wid * 1024u;
    const int aoff = lds_byte(wr * 64 + fr, fq * 8), boff = lds_byte(wc * 32 + fr, fq * 8);
#define PG8_SA(b, h) (((b) * 2 + (h)) * HTB)
#define PG8_SB(b, h) ((4 + (b) * 2 + (h)) * HTB)
#define PG8_STAGE(bufoff, gbase, voff) do { _Pragma("unroll") for (int _i = 0; _i < 2; ++_i) \
        __builtin_amdgcn_global_load_lds((const unsigned*)((const char*)(gbase) + (voff)[_i]), (PG8_LAS unsigned*)(lds + (bufoff) + ldsw + _i * 8192), 16, 0, 0); } while (0)
#define PG8_STAGE_A(bufoff, isnext, half, koff) do { \
        if constexpr (GATHER) { _Pragma("unroll") for (int _i = 0; _i < 2; ++_i) { const unsigned vo_ = (isnext) ? gN[half][_i] : gC[half][_i]; \
            __builtin_amdgcn_global_load_lds((const unsigned*)((const char*)g.A + (koff) + vo_), (PG8_LAS unsigned*)(lds + (bufoff) + ldsw + _i * 8192), 16, 0, 0); } } \
        else { const char* b_ = ((isnext) ? nA : cA) + (half) * hstep + (koff); PG8_STAGE(bufoff, b_, voffA); } } while (0)
#define PG8_LDA(dst, b, h) do { _Pragma("unroll") for (int m = 0; m < 4; ++m) _Pragma("unroll") for (int k = 0; k < 2; ++k) dst[m][k] = *(const PG8_LAS bf16x8*)(lds + PG8_SA(b, h) + aoff + m * 2048 + k * 1024); } while (0)
#define PG8_LDB(dst, b, h) do { _Pragma("unroll") for (int n = 0; n < 2; ++n) _Pragma("unroll") for (int k = 0; k < 2; ++k) dst[n][k] = *(const PG8_LAS bf16x8*)(lds + PG8_SB(b, h) + boff + n * 2048 + k * 1024); } while (0)
#define PG8_MMA(ai, bj, At, Bt) do { __builtin_amdgcn_s_setprio(1); _Pragma("unroll") for (int m = 0; m < 4; ++m) _Pragma("unroll") for (int n = 0; n < 2; ++n) _Pragma("unroll") for (int k = 0; k < 2; ++k) \
        acc[ai][bj][m][n] = __builtin_amdgcn_mfma_f32_16x16x32_bf16(Bt[n][k], At[m][k], acc[ai][bj][m][n], 0, 0, 0); __builtin_amdgcn_s_setprio(0); } while (0)
#define PG8_WAIT_V(n) asm volatile("s_waitcnt vmcnt(" #n ")" ::: "memory")
#define PG8_WAIT_L(n) asm volatile("s_waitcnt lgkmcnt(" #n ")" ::: "memory")
#define PG8_BAR __builtin_amdgcn_s_barrier()
#define PG8_SCHED __builtin_amdgcn_sched_barrier(0)
    Unit cur, nxt; int ui = 0;
    if (!S.next(0, cur)) return;
    f32x4 acc[2][2][4][2];
#pragma unroll
    for (int a = 0; a < 2; ++a)
#pragma unroll
        for (int b = 0; b < 2; ++b)
#pragma unroll
            for (int m = 0; m < 4; ++m)
#pragma unroll
                for (int n = 0; n < 2; ++n) acc[a][b][m][n] = (f32x4){0.f, 0.f, 0.f, 0.f};
    bf16x8 At[4][2], B0[2][2], B1[2][2];
    const char* cA = (const char*)g.A + (size_t)cur.pm * tstep; const char* cB = (const char*)g.Bt + (size_t)cur.pn * tstep;
    S.a_ready(cur);
    const char* nA = cA; (void)nA;
    if constexpr (SP2) {
        PG8_STAGE(PG8_SB(0, 0), cB, voffB); PG8_STAGE(PG8_SB(0, 1), cB + hstep, voffB); PG8_STAGE_A(PG8_SA(0, 0), false, 0, (size_t)0); PG8_STAGE_A(PG8_SA(0, 1), false, 1, (size_t)0);
        if (wr == 1) PG8_BAR;
        PG8_WAIT_V(2); PG8_BAR;
        PG8_STAGE(PG8_SB(1, 0), cB + kstep, voffB); PG8_STAGE_A(PG8_SA(1, 0), false, 0, kstep); PG8_STAGE(PG8_SB(1, 1), cB + hstep + kstep, voffB);
        PG8_WAIT_V(6); PG8_BAR;
    } else {
        PG8_STAGE(PG8_SB(0, 0), cB, voffB); PG8_STAGE_A(PG8_SA(0, 0), false, 0, (size_t)0); PG8_STAGE(PG8_SB(0, 1), cB + hstep, voffB); PG8_STAGE_A(PG8_SA(0, 1), false, 1, (size_t)0);
        if (wr == 1) PG8_BAR;
        PG8_WAIT_V(4); PG8_BAR;
        PG8_STAGE(PG8_SB(1, 0), cB + kstep, voffB); PG8_STAGE_A(PG8_SA(1, 0), false, 0, kstep); PG8_STAGE(PG8_SB(1, 1), cB + hstep + kstep, voffB);
        PG8_WAIT_V(6); PG8_BAR;
    }
    for (;;) {
        const bool has_next = S.next(ui + 1, nxt);
        if constexpr (GATHER) {
#pragma unroll
            for (int h = 0; h < 2; ++h)
#pragma unroll
                for (int i = 0; i < 2; ++i) gN[h][i] = has_next ? (unsigned)ldsrow[(ui + 1) * 256 + h * HALF + gR[i]] * (unsigned)(K * 2) + gCb[i] : gC[h][i];
        }
        const char* nA = has_next ? (const char*)g.A + (size_t)nxt.pm * tstep : cA; const char* nB = has_next ? (const char*)g.Bt + (size_t)nxt.pn * tstep : cB;
        for (int t = 0; t < nt; t += 2) {
            const bool last = (t == nt - 2);
            const size_t k1 = (size_t)(t + 1) * kstep, k2 = last ? (size_t)0 : (size_t)(t + 2) * kstep, k3 = k2 + kstep;
            const char* a1 = cA + (size_t)(t + 1) * kstep;
            const char* a2 = last ? nA : cA + (size_t)(t + 2) * kstep; const char* b2 = last ? nB : cB + (size_t)(t + 2) * kstep;
            const char* a3 = a2 + kstep; const char* b3 = b2 + kstep;
            if (last && has_next) S.a_ready(nxt);
            if constexpr (SP2) {
            PG8_LDB(B0, 0, 0); PG8_LDB(B1, 0, 1); PG8_SCHED; PG8_LDA(At, 0, 0); PG8_STAGE_A(PG8_SA(1, 1), false, 1, k1);
            PG8_WAIT_V(8); PG8_WAIT_L(0); PG8_BAR; PG8_MMA(0, 0, At, B0); PG8_MMA(0, 1, At, B1); PG8_BAR; PG8_SCHED;
            PG8_LDA(At, 0, 1); PG8_STAGE(PG8_SB(0, 0), b2, voffB); PG8_STAGE(PG8_SB(0, 1), b2 + hstep, voffB); PG8_STAGE_A(PG8_SA(0, 0), last, 0, k2);
            PG8_WAIT_V(8); PG8_WAIT_L(0); PG8_BAR; PG8_MMA(1, 0, At, B0); PG8_MMA(1, 1, At, B1); PG8_BAR; PG8_SCHED;
            PG8_LDB(B0, 1, 0); PG8_LDB(B1, 1, 1); PG8_SCHED; PG8_LDA(At, 1, 0); PG8_STAGE_A(PG8_SA(0, 1), last, 1, k2);
            PG8_WAIT_V(8); PG8_WAIT_L(0); PG8_BAR; PG8_MMA(0, 0, At, B0); PG8_MMA(0, 1, At, B1); PG8_BAR; PG8_SCHED;
            PG8_LDA(At, 1, 1); PG8_STAGE(PG8_SB(1, 0), b3, voffB); PG8_STAGE(PG8_SB(1, 1), b3 + hstep, voffB); PG8_STAGE_A(PG8_SA(1, 0), last, 0, k3);
            PG8_WAIT_V(8); PG8_WAIT_L(0); PG8_BAR; PG8_MMA(1, 0, At, B0); PG8_MMA(1, 1, At, B1); PG8_BAR; PG8_SCHED;
            } else {
            PG8_LDB(B0, 0, 0); PG8_SCHED; PG8_LDA(At, 0, 0); PG8_STAGE_A(PG8_SA(1, 1), false, 1, k1);
            PG8_WAIT_L(8); PG8_BAR; PG8_WAIT_L(0); PG8_MMA(0, 0, At, B0); PG8_BAR; PG8_SCHED;
            PG8_LDB(B1, 0, 1); PG8_STAGE(PG8_SB(0, 0), b2, voffB);
            PG8_BAR; PG8_WAIT_L(0); PG8_MMA(0, 1, At, B1); PG8_BAR;
            PG8_LDA(At, 0, 1); PG8_STAGE_A(PG8_SA(0, 0), last, 0, k2);
            PG8_BAR; PG8_WAIT_L(0); PG8_MMA(1, 0, At, B0); PG8_BAR; PG8_SCHED;
            PG8_STAGE(PG8_SB(0, 1), b2 + hstep, voffB);
            PG8_WAIT_V(6); PG8_BAR; PG8_MMA(1, 1, At, B1); PG8_BAR;
            PG8_LDB(B0, 1, 0); PG8_SCHED; PG8_LDA(At, 1, 0); PG8_STAGE_A(PG8_SA(0, 1), last, 1, k2);
            PG8_WAIT_L(8); PG8_BAR; PG8_WAIT_L(0); PG8_MMA(0, 0, At, B0); PG8_BAR; PG8_SCHED;
            PG8_LDB(B1, 1, 1); PG8_STAGE(PG8_SB(1, 0), b3, voffB);
            PG8_BAR; PG8_WAIT_L(0); PG8_MMA(0, 1, At, B1); PG8_BAR;
            PG8_LDA(At, 1, 1); PG8_STAGE_A(PG8_SA(1, 0), last, 0, k3);
            PG8_BAR; PG8_WAIT_L(0); PG8_MMA(1, 0, At, B0); PG8_BAR; PG8_SCHED;
            PG8_STAGE(PG8_SB(1, 1), b3 + hstep, voffB);
            PG8_WAIT_V(6); PG8_BAR; PG8_MMA(1, 1, At, B1); PG8_BAR;
            }
        }
        if constexpr (ALIGN_EPI) { if (wr == 0) PG8_BAR; }
        if constexpr (!Epi::AFTER_DRAIN) { E(acc, cur, wr, wc, fr, fq); S.done(cur); }
        if (!has_next) break;
#pragma unroll
        for (int a = 0; a < 2; ++a)
#pragma unroll
            for (int b = 0; b < 2; ++b)
#pragma unroll
                for (int m = 0; m < 4; ++m)
#pragma unroll
                    for (int n = 0; n < 2; ++n) acc[a][b][m][n] = (f32x4){0.f, 0.f, 0.f, 0.f};
        cur = nxt; cA = nA; cB = nB; ++ui;
        if constexpr (GATHER) { gC[0][0] = gN[0][0]; gC[0][1] = gN[0][1]; gC[1][0] = gN[1][0]; gC[1][1] = gN[1][1]; }
        if constexpr (ALIGN_EPI) { if (wr == 1) PG8_BAR; }
    }
    PG8_WAIT_V(0);
    if constexpr (!ALIGN_EPI) { if (wr == 0) PG8_BAR; }
    PG8_BAR;
    if constexpr (Epi::AFTER_DRAIN) { E.fused(acc, cur, wr, wc, fr, fq, lds, wid, lane); S.done(cur); }
#undef PG8_SA
#undef PG8_SB
#undef PG8_STAGE
#undef PG8_STAGE_A
#undef PG8_LDA
#undef PG8_LDB
#undef PG8_MMA
#undef PG8_WAIT_V
#undef PG8_WAIT_L
#undef PG8_BAR
#undef PG8_SCHED
}
}
constexpr int BATCH = 2, SEQ = 8192, DM = 1024, MTOK = BATCH * SEQ;
constexpr int RH = 4, RQK = 64, RV = 128, CHK = 128, NCH = SEQ / CHK;
constexpr int AH = 8, AD = 64;
constexpr int NE = 16, CAP = 1024, FF = 2048, NSLOT = NE * BATCH * CAP;
constexpr int NPROJ = 3072;
constexpr int C_RQ = 0, C_RK = 256, C_RV = 512, C_RG = 1024, C_AQ = 1536, C_AK = 2048, C_AV = 2560;
constexpr float RMS_EPS = 1e-6f, GN_EPS = 1e-5f;
constexpr float LOG2E = 1.4426950408889634f;
constexpr int NWAVES = 8;
#ifndef MK_ONE_LAUNCH
#define MK_ONE_LAUNCH 1
#endif
constexpr int NPHASE = 13;
constexpr size_t MiB = 1u << 20;
constexpr size_t WS_CTL = 0, CTL_ZERO_BYTES = 1 * MiB;
constexpr size_t WS_MOD = 1 * MiB;
constexpr size_t WS_AFF = 2 * MiB;
constexpr size_t WS_TOK = 3 * MiB;
constexpr size_t WS_GATEV = 3 * MiB + 128 * 1024;
constexpr size_t WS_SLOTOF = 3 * MiB + 256 * 1024;
constexpr size_t WS_LSE = 5 * MiB;
constexpr size_t WS_WIN = 8 * MiB;
constexpr size_t WS_WOUT = 14 * MiB;
constexpr size_t WS_WGU = 16 * MiB;
constexpr size_t WS_WDN = 144 * MiB;
constexpr size_t WS_XN = 208 * MiB;
constexpr size_t WS_R = 240 * MiB;
constexpr size_t WS_PROJ = WS_R;
constexpr size_t WS_KV = WS_R + 96 * MiB;
constexpr size_t WS_PREV = WS_R + 128 * MiB;
constexpr size_t WS_ATTO = WS_R + 144 * MiB;
constexpr size_t WS_Y = WS_R + 192 * MiB;
constexpr size_t WS_MIXED = WS_R;
constexpr size_t WS_XE = WS_R + 64 * MiB;
constexpr size_t WS_HH = WS_R + 128 * MiB;
constexpr size_t WS_YE = WS_R;
constexpr size_t WS_END = WS_R + 256 * MiB;
constexpr int CW_BAR = 4096;
constexpr int RING_BYTES = 131072;
constexpr int LDSCTL_OFF = RING_BYTES, MISC_OFF = LDSCTL_OFF + 320;
constexpr int LDS_BYTES = 147456;

#define GAS __attribute__((address_space(1)))
#define LAS __attribute__((address_space(3)))
typedef unsigned short bf16;
typedef unsigned v4u __attribute__((ext_vector_type(4)));
typedef unsigned v2u __attribute__((ext_vector_type(2)));
typedef float f32x4 __attribute__((ext_vector_type(4)));
typedef float f32x16 __attribute__((ext_vector_type(16)));
typedef short bf16x8 __attribute__((ext_vector_type(8)));
typedef short s16x4 __attribute__((ext_vector_type(4)));
typedef GAS unsigned gu32;
#define RLX_AGENT __ATOMIC_RELAXED, __HIP_MEMORY_SCOPE_AGENT
#define LDS_WAIT() asm volatile("s_waitcnt lgkmcnt(0)" ::: "memory")
typedef float f32x2_t __attribute__((ext_vector_type(2))); typedef __bf16 bf16x2_t __attribute__((ext_vector_type(2)));
__device__ __forceinline__ unsigned pk2(float lo, float hi) { f32x2_t v = {lo, hi}; bf16x2_t b = __builtin_convertvector(v, bf16x2_t); return __builtin_bit_cast(unsigned, b); }
__device__ __forceinline__ float bflo(unsigned w) { return __uint_as_float(w << 16); }
__device__ __forceinline__ float bfhi(unsigned w) { return __uint_as_float(w & 0xffff0000u); }
__device__ __forceinline__ float ex2(float x) { return __builtin_amdgcn_exp2f(x); }
__device__ __forceinline__ int crow(int r, int hi) { return (r & 3) + 8 * (r >> 2) + 4 * hi; }
__device__ __forceinline__ s16x4 vtr(const LAS unsigned char* p) { typedef short v4i16_t __attribute__((ext_vector_type(4))); return __builtin_bit_cast(s16x4, __builtin_amdgcn_ds_read_tr16_b64_v4i16((LAS v4i16_t*)p)); }
__device__ __forceinline__ bf16x8 cat8(s16x4 a, s16x4 b) { return (bf16x8){a[0], a[1], a[2], a[3], b[0], b[1], b[2], b[3]}; }
__device__ __forceinline__ float wave_sum(float v) {
#pragma unroll
    for (int o = 1; o < 64; o <<= 1) v += __shfl_xor(v, o);
    return v;
}
#define XB_TMO      128
#define XB_XCNT(j)  (256  + 64 * (j))
#define XB_XSUB(j)  (1280 + 64 * (j))
#define XB_XGEN(j)  (2304 + 64 * (j))
#define XB_TOP      3328
#define XB_TOPGEN   3392
#define XCD_BAR_WORDS 3456
#define XB_SPIN_CAP (1u << 18)

__device__ __forceinline__ unsigned xb_ld(unsigned* p)              { return __hip_atomic_load(p, __ATOMIC_RELAXED, __HIP_MEMORY_SCOPE_AGENT); }
__device__ __forceinline__ unsigned xb_add(unsigned* p, unsigned v) { return __hip_atomic_fetch_add(p, v, __ATOMIC_RELAXED, __HIP_MEMORY_SCOPE_AGENT); }
__device__ __forceinline__ unsigned xb_xcc_id() { return (unsigned)__builtin_amdgcn_s_getreg((3 << 11) | 20) & 0xFu; }
#define XB_SPIN(cond, bar) do { unsigned _sp = 0; while (cond) { __builtin_amdgcn_s_sleep(1); \
    if ((++_sp & 255u) == 0u) { if (xb_ld(&(bar)[XB_TMO])) break; if (_sp > XB_SPIN_CAP) { atomicAdd(&(bar)[XB_TMO], 1u); break; } } } } while (0)

struct XcdBarrier {
    unsigned* bar; unsigned x;
    volatile LAS unsigned* st;
};

__device__ __forceinline__ XcdBarrier xcd_barrier_post(unsigned* bar, volatile LAS unsigned* st) {
    XcdBarrier b; b.bar = bar; b.x = xb_xcc_id(); b.st = st;
    if (threadIdx.x == 0) (void)xb_add(&bar[XB_XCNT(b.x)], 1u);
    return b;
}
__device__ __forceinline__ void xcd_barrier_complete(unsigned* bar, unsigned x, unsigned& nloc, unsigned& nx) {
    const unsigned G = gridDim.x * gridDim.y * gridDim.z;
    unsigned sum, cnt, mine, sp = 0u;
    for (;;) {
        sum = 0u; cnt = 0u; mine = 0u;
#pragma unroll
        for (unsigned j = 0; j < 16; ++j) { const unsigned c = xb_ld(&bar[XB_XCNT(j)]); sum += c; cnt += (c > 0u) ? 1u : 0u; mine = (j == x) ? c : mine; }
        if (sum == G) break;
        __builtin_amdgcn_s_sleep(1);
        if ((++sp & 255u) == 0u) { if (xb_ld(&bar[XB_TMO])) break; if (sp > XB_SPIN_CAP) { atomicAdd(&bar[XB_TMO], 1u); break; } }
    }
    nloc = mine > 0u ? mine : 1u; nx = cnt > 0u ? cnt : 1u;
}

__device__ __forceinline__ void xcd_barrier(const XcdBarrier& b) {
    asm volatile("s_waitcnt vmcnt(0)" ::: "memory");
    __syncthreads();
    if (threadIdx.x == 0) {
        unsigned* bar = b.bar;
        __builtin_amdgcn_s_waitcnt(0);
        unsigned nloc = b.st[0], nx = b.st[1];
        if (nloc == 0u) { xcd_barrier_complete(bar, b.x, nloc, nx); b.st[0] = nloc; b.st[1] = nx; }
        const unsigned old = xb_add(&bar[XB_XSUB(b.x)], 1u);
        const unsigned gen = old / nloc;
        if (old + 1u == (gen + 1u) * nloc) {
            __builtin_amdgcn_fence(__ATOMIC_RELEASE, "agent");
            asm volatile("s_waitcnt vmcnt(0)" ::: "memory");
            const unsigned og = xb_add(&bar[XB_TOP], 1u);
            const unsigned tg = og / nx;
            if (og + 1u == (tg + 1u) * nx) xb_add(&bar[XB_TOPGEN], 1u);
            else XB_SPIN(xb_ld(&bar[XB_TOPGEN]) == tg, bar);
            __builtin_amdgcn_fence(__ATOMIC_ACQUIRE, "agent");
            xb_add(&bar[XB_XGEN(b.x)], 1u);
            asm volatile("s_waitcnt vmcnt(0)" ::: "memory");
        } else {
            XB_SPIN(xb_ld(&bar[XB_XGEN(b.x)]) == gen, bar);
            __builtin_amdgcn_fence(__ATOMIC_ACQUIRE, "agent");
            asm volatile("s_waitcnt vmcnt(0)" ::: "memory");
        }
    }
    __syncthreads();
}
struct Frame {
    LAS unsigned char* lds;
    volatile LAS unsigned* MISC;
    gu32* ctl;
    int tid, lane, wave;
    int vcu, G;
    const float *x, *c, *w_ada, *b_ada, *g_pre_mix, *g_post_mix, *g_pre_ffn, *g_post_ffn, *w_in, *dec_f, *dec_b, *w_out, *w_router, *w_gate, *w_up, *w_down;
    float* out;
    float *MOD, *AFF, *GATEV, *LSE, *KV, *MIXED;
    int *TOK, *SLOTOF;
    bf16 *WIN, *WOUT, *WGU, *WDN, *XN, *PROJ, *PREV, *ATTO, *Y, *XE, *HH, *YE, *MIXB;
};

__device__ __forceinline__ void p0_transpose_item(const float* W, int K, int N, bf16* WT, int k0, int n0, int drow0, LAS float* scr, int lane) {
#pragma unroll 8
    for (int i = 0; i < 32; ++i) { const int kk = 2 * i + (lane >> 5); scr[kk * 33 + (lane & 31)] = W[(size_t)(k0 + kk) * N + n0 + (lane & 31)]; }
    LDS_WAIT(); asm volatile("" ::: "memory");
    const int c = lane & 7;
#pragma unroll
    for (int j = 0; j < 4; ++j) { const int n = (lane >> 3) + 8 * j; const LAS float* s = scr + (8 * c) * 33 + n;
        v4u o; o.x = pk2(s[0 * 33], s[1 * 33]); o.y = pk2(s[2 * 33], s[3 * 33]); o.z = pk2(s[4 * 33], s[5 * 33]); o.w = pk2(s[6 * 33], s[7 * 33]);
        *(GAS v4u*)(WT + (size_t)(drow0 + n) * K + k0 + 8 * c) = o; }
    LDS_WAIT(); asm volatile("" ::: "memory");
}
__device__ __forceinline__ void phase_p0a(Frame& F) {
    LAS float* sc = (LAS float*)(F.lds + 98304);
    for (int i = F.tid; i < 2 * DM; i += NWAVES * 64) { const float v = F.c[i]; sc[i] = v / (1.f + __expf(-v)); }
    __syncthreads();
    { const int gwm = F.wave * F.G + F.vcu;
      for (int it = gwm; it < 6 * DM / 16; it += F.G * NWAVES) {
        const int col = it * 16 + (F.lane & 15), kq = F.lane >> 4; float a0 = 0.f, a1 = 0.f;
#pragma unroll 8
        for (int k = kq; k < DM; k += 4) { const float w = F.w_ada[(size_t)k * (6 * DM) + col]; a0 += sc[k] * w; a1 += sc[DM + k] * w; }
        a0 += __shfl_xor(a0, 16); a0 += __shfl_xor(a0, 32); a1 += __shfl_xor(a1, 16); a1 += __shfl_xor(a1, 32);
        if (kq == 0) { const float bb = F.b_ada[col]; F.MOD[col] = a0 + bb; F.MOD[6 * DM + col] = a1 + bb; }
      } }
    LAS float* scr = (LAS float*)(F.lds + F.wave * 12288);
    const int gw = F.vcu * NWAVES + F.wave, NGW = F.G * NWAVES;
    constexpr int I_IN = (DM / 64) * (NPROJ / 32), I_OUT = (DM / 64) * (DM / 32), I_G1 = (DM / 64) * (FF / 32), I_G = NE * I_G1, I_D1 = (FF / 64) * (DM / 32), I_D = NE * I_D1;
    constexpr int NITEMS = I_IN + I_OUT + 2 * I_G + I_D;
    for (int it = gw; it < NITEMS; it += NGW) {
        int r = it;
        if (r < I_IN) { const int nblk = NPROJ / 32, kb = r / nblk, nb = r % nblk; p0_transpose_item(F.w_in, DM, NPROJ, F.WIN, 64 * kb, 32 * nb, 32 * nb, scr, F.lane); continue; } r -= I_IN;
        if (r < I_OUT) { const int nblk = DM / 32, kb = r / nblk, nb = r % nblk; p0_transpose_item(F.w_out, DM, DM, F.WOUT, 64 * kb, 32 * nb, 32 * nb, scr, F.lane); continue; } r -= I_OUT;
        if (r < 2 * I_G) { const int half = r / I_G; r -= half * I_G; const int e = r / I_G1, q = r % I_G1, nblk = FF / 32, kb = q / nblk, nb = q % nblk, n0 = 32 * nb;
            const float* W = (half ? F.w_up : F.w_gate) + (size_t)e * DM * FF;
            p0_transpose_item(W, DM, FF, F.WGU + (size_t)e * (2 * FF) * DM, 64 * kb, n0, (n0 >> 7) * 256 + half * 128 + (n0 & 127), scr, F.lane); continue; } r -= 2 * I_G;
        { const int e = r / I_D1, q = r % I_D1, nblk = DM / 32, kb = q / nblk, nb = q % nblk;
          p0_transpose_item(F.w_down + (size_t)e * FF * DM, FF, DM, F.WDN + (size_t)e * DM * FF, 64 * kb, 32 * nb, 32 * nb, scr, F.lane); }
    }
}
__device__ __forceinline__ void phase_p0b(Frame& F) {
    const int gw = F.vcu * NWAVES + F.wave, NGW = F.G * NWAVES;
    constexpr int RB = 4;
    for (int m0 = gw; m0 < MTOK; m0 += RB * NGW) {
        f32x4 v[RB][4]; float s[RB];
#pragma unroll
        for (int q = 0; q < RB; ++q) { const int m = m0 + q * NGW; const GAS f32x4* xr = (const GAS f32x4*)(F.x + (size_t)(m < MTOK ? m : m0) * DM) + F.lane;
#pragma unroll
            for (int j = 0; j < 4; ++j) v[q][j] = xr[64 * j]; }
#pragma unroll
        for (int q = 0; q < RB; ++q) { float t = 0.f;
#pragma unroll
            for (int j = 0; j < 4; ++j) t += (v[q][j].x * v[q][j].x + v[q][j].y * v[q][j].y) + (v[q][j].z * v[q][j].z + v[q][j].w * v[q][j].w);
            s[q] = 1.f / sqrtf(wave_sum(t) * (1.f / DM) + RMS_EPS); }
#pragma unroll
        for (int q = 0; q < RB; ++q) { const int m = m0 + q * NGW; if (m >= MTOK) break;
            const float* mod = F.MOD + (m / SEQ) * 6 * DM; GAS v2u* o8 = (GAS v2u*)(F.XN + (size_t)m * DM) + F.lane;
#pragma unroll
            for (int j = 0; j < 4; ++j) { const int c = 4 * F.lane + 256 * j;
                const f32x4 g = *(const f32x4*)(F.g_pre_mix + c), sc = *(const f32x4*)(mod + DM + c), sh = *(const f32x4*)(mod + c);
                const f32x4 h = v[q][j] * s[q] * g * (sc + 1.f) + sh;
                v2u w; w.x = pk2(h.x, h.y); w.y = pk2(h.z, h.w); o8[64 * j] = w; } }
    }
}
__device__ __forceinline__ float lg2_sigmoid(float x) { return -log1pf(__expf(-x)) * LOG2E; }
struct AttnDesc { int b, h, cfg, r, qblk; };
__device__ __forceinline__ AttnDesc attn_decode(int u) {
    AttnDesc a; const int blk = u & 31; a.h = (u >> 5) & 7; a.b = (u >> 8) & 1; a.cfg = u >> 9;
    const int d = (a.cfg == 0) ? 1 : ((a.cfg == 1) ? 4 : 16), nq = (SEQ / d) / 256; a.r = blk / nq; a.qblk = blk % nq; return a;
}
constexpr int ATT_KOFF = 0, ATT_VOFF = 49152;
__device__ __forceinline__ void attn_prefetch(Frame& F, const AttnDesc& a, v4u (&kr)[6], v4u (&vr)[6]) {
    const int d = (a.cfg == 0) ? 1 : ((a.cfg == 1) ? 4 : 16), L = SEQ / d;
    const bf16* P = F.PROJ + (size_t)a.b * SEQ * NPROJ;
    const int wl0 = 256 * a.qblk - 64, ch = F.tid & 7;
#pragma unroll
    for (int p = 0; p < 6; ++p) {
        int l = wl0 + p * 64 + (F.tid >> 3); l = l < 0 ? 0 : (l > L - 1 ? L - 1 : l);
        const bf16* rp = P + (size_t)(l * d + a.r) * NPROJ + a.h * AD + ch * 8;
        kr[p] = *(const v4u*)(rp + C_AK); vr[p] = *(const v4u*)(rp + C_AV);
    }
}
__device__ __forceinline__ void attn_stage(Frame& F, const v4u (&kr)[6], const v4u (&vr)[6]) {
    const int ch = F.tid & 7;
#pragma unroll
    for (int p = 0; p < 6; ++p) { const int kidx = p * 64 + (F.tid >> 3);
        *(LAS v4u*)(F.lds + ATT_KOFF + kidx * 128 + ((ch ^ (kidx & 7)) << 4)) = kr[p];
        *(LAS v4u*)(F.lds + ATT_VOFF + (ch >> 2) * (384 * 64) + (kidx >> 3) * 512 + (kidx & 7) * 64 + (ch & 3) * 16) = vr[p]; }
}
__device__ __forceinline__ void attn_compute(Frame& F, const AttnDesc& a) {
    const int cfg = a.cfg, h = a.h, b = a.b, r = a.r, qblk = a.qblk;
    const int d = (cfg == 0) ? 1 : ((cfg == 1) ? 4 : 16), L = SEQ / d;
    const int wave = F.wave; int lane = F.lane; asm volatile("" : "+v"(lane));
    const int i = lane & 31, hi = lane >> 5;
    const bf16* P = F.PROJ + (size_t)b * SEQ * NPROJ;
    const int lw0 = 256 * qblk + 32 * wave - 64;
    const int ql = 256 * qblk + 32 * wave + i;
    bf16x8 qf[4];
    { const bf16* qp = P + (size_t)(ql * d + r) * NPROJ + C_AQ + h * AD + hi * 8;
#pragma unroll
      for (int s = 0; s < 4; ++s) qf[s] = *(const bf16x8*)(qp + 16 * s); }
    const float slope2 = ex2(-(float)(h + 1)) * (float)d * LOG2E;
    f32x16 acc[5];
    const int a0 = i + 64 - 4 * hi;
    const LAS unsigned char* Kl = F.lds + ATT_KOFF;
#pragma unroll
    for (int T = 0; T < 5; ++T) {
        const float cinit = (T < 2) ? -slope2 * (float)(a0 - 32 * T) : ((T > 2) ? slope2 * (float)(a0 - 32 * T) : 0.f);
        f32x16 c;
#pragma unroll
        for (int rr = 0; rr < 16; ++rr) c[rr] = cinit;
        const int key = 32 * wave + 32 * T + i;
#pragma unroll
        for (int s = 0; s < 4; ++s) { const bf16x8 kf = *(const LAS bf16x8*)(Kl + key * 128 + (((2 * s + hi) ^ (key & 7)) << 4));
            c = __builtin_amdgcn_mfma_f32_32x32x16_bf16(kf, qf[s], c, 0, 0, 0); }
        acc[T] = c;
    }
    if (lw0 < 0 || lw0 + 160 > L) {
#pragma unroll
        for (int T = 0; T < 5; ++T)
#pragma unroll
            for (int rr = 0; rr < 16; ++rr) { const int kl = lw0 + 32 * T + crow(rr, hi); if (kl < 0 || kl >= L) acc[T][rr] = -1.0e30f; }
    }
    const int th0 = i - 4 * hi; const float fa2 = (float)(a0 - 64);
    float mx = -3.0e38f;
#pragma unroll
    for (int rr = 0; rr < 16; ++rr) { const int c0 = (rr & 3) + 8 * (rr >> 2); const float sc0 = slope2 * (float)c0;
        float v0 = acc[0][rr] + sc0; v0 = (c0 >= th0) ? v0 : -1.0e30f;
        const float v1 = acc[1][rr] + sc0;
        const float v2 = acc[2][rr] - slope2 * fabsf(fa2 - (float)c0);
        const float v3 = acc[3][rr] - sc0;
        float v4 = acc[4][rr] - sc0; v4 = (c0 <= th0) ? v4 : -1.0e30f;
        acc[0][rr] = v0; acc[1][rr] = v1; acc[2][rr] = v2; acc[3][rr] = v3; acc[4][rr] = v4;
        mx = fmaxf(mx, fmaxf(fmaxf(v0, v1), fmaxf(fmaxf(v2, v3), v4))); }
    mx = fmaxf(mx, __shfl_xor(mx, 32));
    float lsum = 0.f;
#pragma unroll
    for (int T = 0; T < 5; ++T)
#pragma unroll
        for (int rr = 0; rr < 16; ++rr) { const float p = ex2(acc[T][rr] - mx); acc[T][rr] = p; lsum += p; }
    lsum += __shfl_xor(lsum, 32);
    f32x16 o[2]; o[0] = f32x16{}; o[1] = f32x16{};
    const LAS unsigned char* vb = F.lds + ATT_VOFF + ((lane >> 4) & 1) * 32 + (lane & 3) * 8 + (4 * hi + ((lane & 15) >> 2)) * 64;
#pragma unroll
    for (int T = 0; T < 5; ++T)
#pragma unroll
        for (int u = 0; u < 2; ++u) {
            v4u pw; pw.x = pk2(acc[T][8 * u + 0], acc[T][8 * u + 1]); pw.y = pk2(acc[T][8 * u + 2], acc[T][8 * u + 3]); pw.z = pk2(acc[T][8 * u + 4], acc[T][8 * u + 5]); pw.w = pk2(acc[T][8 * u + 6], acc[T][8 * u + 7]);
            const bf16x8 pb = __builtin_bit_cast(bf16x8, pw);
            const int kbase = 32 * wave + 32 * T + 16 * u;
#pragma unroll
            for (int dt = 0; dt < 2; ++dt) {
                const LAS unsigned char* aa = vb + dt * (384 * 64) + (kbase >> 3) * 512;
                const bf16x8 va = cat8(vtr(aa), vtr(aa + 512));
                o[dt] = __builtin_amdgcn_mfma_f32_32x32x16_bf16(va, pb, o[dt], 0, 0, 0);
            }
        }
    const float inv = 1.f / lsum;
    const size_t row = (size_t)b * SEQ + (size_t)(ql * d + r);
    bf16* op = F.ATTO + ((size_t)cfg * MTOK + row) * (AH * AD) + h * AD;
#pragma unroll
    for (int dt = 0; dt < 2; ++dt)
#pragma unroll
        for (int g = 0; g < 4; ++g) { v2u w; w.x = pk2(o[dt][4 * g] * inv, o[dt][4 * g + 1] * inv); w.y = pk2(o[dt][4 * g + 2] * inv, o[dt][4 * g + 3] * inv);
            *(v2u*)(op + 32 * dt + 8 * g + 4 * hi) = w; }
    if (hi == 0) F.LSE[((size_t)cfg * MTOK + row) * AH + h] = mx + __builtin_amdgcn_logf(lsum);
}
__device__ __forceinline__ void kv_unit(Frame& F, int b, int h, int n) {
    const int tid = F.tid, wave = F.wave; int lane = F.lane; asm volatile("" : "+v"(lane));
    const int hi = lane >> 5;
    const float lgf = lg2_sigmoid(F.dec_f[h]), lgb = lg2_sigmoid(F.dec_b[h]);
    const size_t row0 = (size_t)b * SEQ + (size_t)n * CHK;
    LAS unsigned char* Vl = F.lds;
    LAS unsigned char* Kl = F.lds + 32768;
#pragma unroll
    for (int p = 0; p < 4; ++p) { const int idx = p * 512 + tid, key = idx >> 4, ch = idx & 15;
        const v4u val = *(const v4u*)(F.PROJ + (row0 + key) * NPROJ + C_RV + h * RV + ch * 8);
        *(LAS v4u*)(Vl + (ch >> 2) * (128 * 64) + (key >> 3) * 512 + (key & 7) * 64 + (ch & 3) * 16) = val; }
#pragma unroll
    for (int p = 0; p < 2; ++p) { const int idx = p * 512 + tid, key = idx >> 3, ch = idx & 7;
        const v4u val = *(const v4u*)(F.PROJ + (row0 + key) * NPROJ + C_RK + h * RQK + ch * 8);
        const float sf = ex2(lgf * (float)(127 - key)), sb = ex2(lgb * (float)key);
        v4u wf, wb;
        wf.x = pk2(bflo(val.x) * sf, bfhi(val.x) * sf); wf.y = pk2(bflo(val.y) * sf, bfhi(val.y) * sf); wf.z = pk2(bflo(val.z) * sf, bfhi(val.z) * sf); wf.w = pk2(bflo(val.w) * sf, bfhi(val.w) * sf);
        wb.x = pk2(bflo(val.x) * sb, bfhi(val.x) * sb); wb.y = pk2(bflo(val.y) * sb, bfhi(val.y) * sb); wb.z = pk2(bflo(val.z) * sb, bfhi(val.z) * sb); wb.w = pk2(bflo(val.w) * sb, bfhi(val.w) * sb);
        const int off = (ch >> 2) * (128 * 64) + (key >> 3) * 512 + (key & 7) * 64 + (ch & 3) * 16;
        *(LAS v4u*)(Kl + off) = wf; *(LAS v4u*)(Kl + 16384 + off) = wb; }
    __syncthreads();
    const int dir = wave >> 2, dvt = wave & 3;
    const int lofs = ((lane >> 4) & 1) * 32 + (lane & 3) * 8 + (4 * hi + ((lane & 15) >> 2)) * 64;
    const LAS unsigned char* va = Vl + dvt * (128 * 64) + lofs;
    float* kvout = F.KV + ((size_t)(((b * RH + h) * 2 + dir) * NCH + n)) * (RV * RQK);
#pragma unroll
    for (int dkt = 0; dkt < 2; ++dkt) {
        const LAS unsigned char* ka = Kl + dir * 16384 + dkt * (128 * 64) + lofs;
        f32x16 a = {};
#pragma unroll
        for (int s = 0; s < 8; ++s) {
            const bf16x8 A = cat8(vtr(va + s * 1024), vtr(va + s * 1024 + 512));
            const bf16x8 B = cat8(vtr(ka + s * 1024), vtr(ka + s * 1024 + 512));
            a = __builtin_amdgcn_mfma_f32_32x32x16_bf16(A, B, a, 0, 0, 0);
        }
#pragma unroll
        for (int rr = 0; rr < 16; ++rr) kvout[(32 * dvt + crow(rr, hi)) * RQK + 32 * dkt + (lane & 31)] = a[rr];
    }
    __syncthreads();
}
__device__ __forceinline__ void phase_p2(Frame& F) {
    constexpr int NATT = BATCH * AH * 3 * (SEQ / 256);
    if (F.vcu < NATT) {
        v4u kr[6], vr[6];
        attn_prefetch(F, attn_decode(F.vcu), kr, vr);
        for (int u = F.vcu; u < NATT; u += F.G) {
            attn_stage(F, kr, vr);
            __syncthreads();
            if (u + F.G < NATT) attn_prefetch(F, attn_decode(u + F.G), kr, vr);
            attn_compute(F, attn_decode(u));
            __syncthreads();
        }
    }
    constexpr int NKV = BATCH * RH * NCH;
    for (int u = F.vcu; u < NKV; u += F.G) kv_unit(F, u >> 8, (u >> 6) & 3, u & 63);
}
__device__ __forceinline__ void phase_p3(Frame& F) {
    for (int g = F.vcu * (NWAVES * 64) + F.tid; g < BATCH * RH * 2 * (RV * RQK); g += F.G * NWAVES * 64) {
        const int bhd = g >> 13, e = g & 8191, dir = bhd & 1, h = (bhd >> 1) & 3;
        const float lam = ex2(128.f * lg2_sigmoid(dir ? F.dec_b[h] : F.dec_f[h]));
        const float* kv = F.KV + (size_t)bhd * NCH * 8192 + e; bf16* pv = F.PREV + (size_t)bhd * NCH * 8192 + e;
        float st = 0.f;
        for (int n0 = 0; n0 < NCH; n0 += 8) {
            float v[8];
#pragma unroll
            for (int k = 0; k < 8; ++k) { const int n = dir ? (NCH - 1 - (n0 + k)) : (n0 + k); v[k] = kv[(size_t)n * 8192]; }
#pragma unroll
            for (int k = 0; k < 8; ++k) { const int n = dir ? (NCH - 1 - (n0 + k)) : (n0 + k); pv[(size_t)n * 8192] = (bf16)(pk2(st, 0.f) & 0xffffu); st = lam * st + v[k]; }
        }
    }
    const int gw = F.vcu * NWAVES + F.wave, NGW = F.G * NWAVES;
    constexpr int RB = 4;
    for (int m0 = gw; m0 < MTOK; m0 += RB * NGW) {
        v4u a[RB][3]; float l[RB][3];
#pragma unroll
        for (int q = 0; q < RB; ++q) { const int mm = m0 + q * NGW; const size_t m = mm < MTOK ? mm : m0;
#pragma unroll
            for (int c = 0; c < 3; ++c) { a[q][c] = *(const v4u*)(F.ATTO + ((size_t)c * MTOK + m) * 512 + F.lane * 8); l[q][c] = F.LSE[((size_t)c * MTOK + m) * AH + (F.lane >> 3)]; } }
#pragma unroll
        for (int q = 0; q < RB; ++q) { const int m = m0 + q * NGW; if (m >= MTOK) break;
            const float mx = fmaxf(l[q][0], fmaxf(l[q][1], l[q][2])); float w0 = ex2(l[q][0] - mx), w1 = ex2(l[q][1] - mx), w2 = ex2(l[q][2] - mx); const float inv = 1.f / (w0 + w1 + w2); w0 *= inv; w1 *= inv; w2 *= inv;
            const v4u x = a[q][0], y = a[q][1], z = a[q][2]; v4u o;
            o.x = pk2(w0 * bflo(x.x) + w1 * bflo(y.x) + w2 * bflo(z.x), w0 * bfhi(x.x) + w1 * bfhi(y.x) + w2 * bfhi(z.x));
            o.y = pk2(w0 * bflo(x.y) + w1 * bflo(y.y) + w2 * bflo(z.y), w0 * bfhi(x.y) + w1 * bfhi(y.y) + w2 * bfhi(z.y));
            o.z = pk2(w0 * bflo(x.z) + w1 * bflo(y.z) + w2 * bflo(z.z), w0 * bfhi(x.z) + w1 * bfhi(y.z) + w2 * bfhi(z.z));
            o.w = pk2(w0 * bflo(x.w) + w1 * bflo(y.w) + w2 * bflo(z.w), w0 * bfhi(x.w) + w1 * bfhi(y.w) + w2 * bfhi(z.w));
            *(v4u*)(F.Y + (size_t)m * DM + 512 + F.lane * 8) = o; }
    }
}
__device__ __forceinline__ bf16x8 scale8(bf16x8 q, float s) {
    const v4u w = __builtin_bit_cast(v4u, q); v4u o;
    o.x = pk2(bflo(w.x) * s, bfhi(w.x) * s); o.y = pk2(bflo(w.y) * s, bfhi(w.y) * s); o.z = pk2(bflo(w.z) * s, bfhi(w.z) * s); o.w = pk2(bflo(w.w) * s, bfhi(w.w) * s);
    return __builtin_bit_cast(bf16x8, o);
}
__device__ __forceinline__ void ret_pair(Frame& F, int pair) {
    const int tid = F.tid, wave = F.wave; int lane = F.lane; asm volatile("" : "+v"(lane));
    const int i = lane & 31, hi = lane >> 5, grp = wave >> 2, w4 = wave & 3;
    const int cid = 2 * pair + grp, n = cid & 63, h = (cid >> 6) & 3, b = cid >> 8;
    const float lgf = lg2_sigmoid(F.dec_f[h]), lgb = lg2_sigmoid(F.dec_b[h]);
    const size_t row0 = (size_t)b * SEQ + (size_t)n * CHK;
    LAS unsigned char* Vl = F.lds + grp * 65536;
    LAS unsigned char* Pl = Vl + 32768;
    const int qi = 32 * w4 + i; const size_t qrow = row0 + qi;
    {
        const int t4 = tid & 255;
        v4u vreg[8], preg[8];
#pragma unroll
        for (int p = 0; p < 8; ++p) { const int idx = p * 256 + t4, key = idx >> 4, ch = idx & 15;
            vreg[p] = *(const v4u*)(F.PROJ + (row0 + key) * NPROJ + C_RV + h * RV + ch * 8); }
        const bf16* pf = F.PREV + ((size_t)(((b * RH + h) * 2 + 0) * NCH + n)) * (RV * RQK);
        const bf16* pb_ = F.PREV + ((size_t)(((b * RH + h) * 2 + 1) * NCH + n)) * (RV * RQK);
#pragma unroll
        for (int p = 0; p < 4; ++p) { const int idx = p * 256 + t4;
            preg[p] = *(const v4u*)(pf + (size_t)idx * 8); preg[4 + p] = *(const v4u*)(pb_ + (size_t)idx * 8); }
#pragma unroll
        for (int p = 0; p < 8; ++p) { const int idx = p * 256 + t4, key = idx >> 4, ch = idx & 15;
            *(LAS v4u*)(Vl + (ch >> 2) * (128 * 64) + (key >> 3) * 512 + (key & 7) * 64 + (ch & 3) * 16) = vreg[p]; }
#pragma unroll
        for (int p = 0; p < 4; ++p) { const int idx = p * 256 + t4, rw = idx >> 3, ch = idx & 7; const int off = rw * 128 + ((ch ^ (rw & 7)) << 4);
            *(LAS v4u*)(Pl + off) = preg[p]; *(LAS v4u*)(Pl + 16384 + off) = preg[4 + p]; }
    }
    bf16x8 qf[4];
    { const bf16* qp = F.PROJ + qrow * NPROJ + C_RQ + h * RQK + hi * 8;
#pragma unroll
      for (int s = 0; s < 4; ++s) qf[s] = *(const bf16x8*)(qp + 16 * s); }
    f32x16 acc[4];
    bf16x8 kf[2][4];
#define RET_LOADK(T, buf) do { const bf16* kp_ = F.PROJ + (row0 + 32 * (T) + i) * NPROJ + C_RK + h * RQK + hi * 8; \
        _Pragma("unroll") for (int s_ = 0; s_ < 4; ++s_) kf[buf][s_] = *(const bf16x8*)(kp_ + 16 * s_); } while (0)
    RET_LOADK(0, 0);
    v2u gw[4][4];
    { const bf16* gp = F.PROJ + qrow * NPROJ + C_RG + h * RV + 4 * hi;
#pragma unroll
      for (int dvt = 0; dvt < 4; ++dvt)
#pragma unroll
          for (int g = 0; g < 4; ++g) gw[dvt][g] = *(const v2u*)(gp + 32 * dvt + 8 * g); }
    __syncthreads();
#pragma unroll
    for (int T = 0; T < 4; ++T) {
        if (T + 1 < 4) RET_LOADK(T + 1, (T + 1) & 1);
        asm volatile("" ::: "memory");
        f32x16 a = {};
#pragma unroll
        for (int s = 0; s < 4; ++s) a = __builtin_amdgcn_mfma_f32_32x32x16_bf16(kf[T & 1][s], qf[s], a, 0, 0, 0);
        acc[T] = a;
    }
#undef RET_LOADK
#pragma unroll
    for (int T = 0; T < 4; ++T)
#pragma unroll
        for (int rr = 0; rr < 16; ++rr) { const int rel = qi - (32 * T + crow(rr, hi)); const float e = rel >= 0 ? lgf * (float)rel : -lgb * (float)rel; acc[T][rr] *= ex2(e); }
    f32x16 o[4]; o[0] = f32x16{}; o[1] = f32x16{}; o[2] = f32x16{}; o[3] = f32x16{};
    const LAS unsigned char* vb = Vl + ((lane >> 4) & 1) * 32 + (lane & 3) * 8 + (4 * hi + ((lane & 15) >> 2)) * 64;
#pragma unroll
    for (int T = 0; T < 4; ++T)
#pragma unroll
        for (int u = 0; u < 2; ++u) {
            v4u pw; pw.x = pk2(acc[T][8 * u + 0], acc[T][8 * u + 1]); pw.y = pk2(acc[T][8 * u + 2], acc[T][8 * u + 3]); pw.z = pk2(acc[T][8 * u + 4], acc[T][8 * u + 5]); pw.w = pk2(acc[T][8 * u + 6], acc[T][8 * u + 7]);
            const bf16x8 pb = __builtin_bit_cast(bf16x8, pw);
#pragma unroll
            for (int dvt = 0; dvt < 4; ++dvt) {
                const LAS unsigned char* a = vb + dvt * (128 * 64) + (4 * T + 2 * u) * 512;
                o[dvt] = __builtin_amdgcn_mfma_f32_32x32x16_bf16(cat8(vtr(a), vtr(a + 512)), pb, o[dvt], 0, 0, 0);
            }
            asm volatile("" ::: "memory");
        }
    {
        const float sf = ex2(lgf * (float)(qi + 1)), sb = ex2(lgb * (float)(CHK - qi));
#pragma unroll
        for (int s = 0; s < 4; ++s) {
            const bf16x8 qs_f = scale8(qf[s], sf), qs_b = scale8(qf[s], sb);
#pragma unroll
            for (int dvt = 0; dvt < 4; ++dvt) { const int rw = 32 * dvt + i; const int off = rw * 128 + (((2 * s + hi) ^ (rw & 7)) << 4);
                const bf16x8 af = *(const LAS bf16x8*)(Pl + off), ab = *(const LAS bf16x8*)(Pl + 16384 + off);
                o[dvt] = __builtin_amdgcn_mfma_f32_32x32x16_bf16(af, qs_f, o[dvt], 0, 0, 0);
                o[dvt] = __builtin_amdgcn_mfma_f32_32x32x16_bf16(ab, qs_b, o[dvt], 0, 0, 0);
            }
            asm volatile("" ::: "memory");
        }
    }
    float s1 = 0.f;
#pragma unroll
    for (int dvt = 0; dvt < 4; ++dvt)
#pragma unroll
        for (int rr = 0; rr < 16; ++rr) s1 += o[dvt][rr];
    s1 += __shfl_xor(s1, 32); const float mean = s1 * (1.f / RV);
    float s2 = 0.f;
#pragma unroll
    for (int dvt = 0; dvt < 4; ++dvt)
#pragma unroll
        for (int rr = 0; rr < 16; ++rr) { const float dlt = o[dvt][rr] - mean; s2 += dlt * dlt; }
    s2 += __shfl_xor(s2, 32); const float rstd = 1.f / sqrtf(s2 * (1.f / RV) + GN_EPS);
    bf16* yp = F.Y + qrow * DM + h * RV;
#pragma unroll
    for (int dvt = 0; dvt < 4; ++dvt)
#pragma unroll
        for (int g = 0; g < 4; ++g) { const int dv = 32 * dvt + 8 * g + 4 * hi; const v2u gwv = gw[dvt][g];
            float gv[4] = {bflo(gwv.x), bfhi(gwv.x), bflo(gwv.y), bfhi(gwv.y)}; float yv[4];
#pragma unroll
            for (int k = 0; k < 4; ++k) { const float sg = gv[k] * __builtin_amdgcn_rcpf(1.f + ex2(-gv[k] * LOG2E)); yv[k] = sg * (o[dvt][4 * g + k] - mean) * rstd; }
            v2u w; w.x = pk2(yv[0], yv[1]); w.y = pk2(yv[2], yv[3]); *(v2u*)(yp + dv) = w; }
    __syncthreads();
}
__device__ __forceinline__ void phase_p4(Frame& F) { for (int p = F.vcu; p < BATCH * RH * NCH / 2; p += F.G) ret_pair(F, p); }
constexpr int WR_PITCH = DM + 4;
__device__ __forceinline__ void phase_p6(Frame& F) {
    LAS float* wr = (LAS float*)F.lds;
    for (int idx = F.tid; idx < DM * NE; idx += NWAVES * 64) wr[(idx & 15) * WR_PITCH + (idx >> 4)] = F.w_router[idx];
    __syncthreads();
    const int gw = F.vcu * NWAVES + F.wave, NGW = F.G * NWAVES, lane = F.lane;
    constexpr int RB = 2;
    for (int m0 = gw; m0 < MTOK; m0 += RB * NGW) {
        v4u mw[RB][2]; f32x4 xv[RB][4];
#pragma unroll
        for (int q = 0; q < RB; ++q) { const int mm = m0 + q * NGW; const size_t m = mm < MTOK ? mm : m0;
#pragma unroll
            for (int j = 0; j < 2; ++j) { mw[q][j] = *(const v4u*)(F.MIXB + m * DM + 8 * lane + 512 * j);
                xv[q][2 * j] = *(const f32x4*)(F.x + m * DM + 8 * lane + 512 * j); xv[q][2 * j + 1] = *(const f32x4*)(F.x + m * DM + 8 * lane + 512 * j + 4); } }
#pragma unroll
        for (int q = 0; q < RB; ++q) { const int m = m0 + q * NGW; if (m >= MTOK) break;
            const int b = m / SEQ, spos = m % SEQ; const float* mod = F.MOD + b * 6 * DM;
            f32x4 mv[4];
#pragma unroll
            for (int j = 0; j < 2; ++j) { const v4u w = mw[q][j]; mv[2 * j] = (f32x4){bflo(w.x), bfhi(w.x), bflo(w.y), bfhi(w.y)}; mv[2 * j + 1] = (f32x4){bflo(w.z), bfhi(w.z), bflo(w.w), bfhi(w.w)}; }
            float s = 0.f;
#pragma unroll
            for (int t = 0; t < 4; ++t) s += (mv[t].x * mv[t].x + mv[t].y * mv[t].y) + (mv[t].z * mv[t].z + mv[t].w * mv[t].w);
            const float r1 = 1.f / sqrtf(wave_sum(s) * (1.f / DM) + RMS_EPS);
            float s2 = 0.f;
#pragma unroll
            for (int t = 0; t < 4; ++t) { const int c = 8 * lane + 512 * (t >> 1) + 4 * (t & 1);
                const f32x4 g = *(const f32x4*)(F.g_post_mix + c), gm = *(const f32x4*)(mod + 2 * DM + c);
                const f32x4 x1 = xv[q][t] + gm * (mv[t] * r1 * g); xv[q][t] = x1; *(f32x4*)(F.out + (size_t)m * DM + c) = x1;
                s2 += (x1.x * x1.x + x1.y * x1.y) + (x1.z * x1.z + x1.w * x1.w); }
            const float r2 = 1.f / sqrtf(wave_sum(s2) * (1.f / DM) + RMS_EPS);
            float lg[NE];
#pragma unroll
            for (int e = 0; e < NE; ++e) lg[e] = 0.f;
#pragma unroll
            for (int j = 0; j < 2; ++j) { f32x4 h[2];
#pragma unroll
                for (int u = 0; u < 2; ++u) { const int c = 8 * lane + 512 * j + 4 * u;
                    const f32x4 g = *(const f32x4*)(F.g_pre_ffn + c), sc = *(const f32x4*)(mod + 4 * DM + c), sh = *(const f32x4*)(mod + 3 * DM + c);
                    h[u] = xv[q][2 * j + u] * r2 * g * (sc + 1.f) + sh; }
                v4u w; w.x = pk2(h[0].x, h[0].y); w.y = pk2(h[0].z, h[0].w); w.z = pk2(h[1].x, h[1].y); w.w = pk2(h[1].z, h[1].w);
                *(v4u*)(F.XN + (size_t)m * DM + 8 * lane + 512 * j) = w;
#pragma unroll
                for (int e = 0; e < NE; ++e) { const LAS float* wp = wr + e * WR_PITCH + 8 * lane + 512 * j; const f32x4 w0 = *(const LAS f32x4*)wp, w1 = *(const LAS f32x4*)(wp + 4);
                    lg[e] += ((h[0].x * w0.x + h[0].y * w0.y) + (h[0].z * w0.z + h[0].w * w0.w)) + ((h[1].x * w1.x + h[1].y * w1.y) + (h[1].z * w1.z + h[1].w * w1.w)); }
                asm volatile("" ::: "memory"); }
            float mxl = -3.0e38f;
#pragma unroll
            for (int e = 0; e < NE; ++e) { lg[e] = wave_sum(lg[e]); mxl = fmaxf(mxl, lg[e]); }
            float den = 0.f;
#pragma unroll
            for (int e = 0; e < NE; ++e) { lg[e] = __expf(lg[e] - mxl); den += lg[e]; }
            const float invd = 1.f / den; float mine = 0.f;
#pragma unroll
            for (int e = 0; e < NE; ++e) mine = (lane == e) ? lg[e] * invd : mine;
            if (lane < NE) F.AFF[((size_t)b * NE + lane) * SEQ + spos] = mine; }
    }
}
__device__ __forceinline__ int block_excl_scan(int v, LAS int* wsum, int tid, int lane, int wave, int& total) {
    int inc = v;
#pragma unroll
    for (int o = 1; o < 64; o <<= 1) { const int t = __shfl_up(inc, o); if (lane >= o) inc += t; }
    __syncthreads();
    if (lane == 63) wsum[wave] = inc;
    __syncthreads();
    int base = 0, tot = 0;
#pragma unroll
    for (int w = 0; w < NWAVES; ++w) { const int t = wsum[w]; if (w < wave) base += t; tot += t; }
    total = tot; (void)tid;
    return base + inc - v;
}
__device__ __forceinline__ void phase_p7(Frame& F) {
    if (F.vcu >= BATCH * NE) return;
    const int be = F.vcu, b = be / NE, e = be % NE, tid = F.tid;
    LAS int* hist = (LAS int*)F.lds; LAS int* wsum = hist + 256; LAS int* bc = hist + 272;
    const float* a = F.AFF + (size_t)be * SEQ;
    unsigned v[16];
#pragma unroll
    for (int q = 0; q < 4; ++q) { const v4u t = *(const v4u*)(a + tid * 16 + q * 4); v[4 * q] = t.x; v[4 * q + 1] = t.y; v[4 * q + 2] = t.z; v[4 * q + 3] = t.w; }
    unsigned prefix = 0u; int kk = CAP;
#pragma unroll 1
    for (int pass = 0; pass < 4; ++pass) {
        const int shift = 24 - 8 * pass; const unsigned hmask = (pass == 0) ? 0u : (0xffffffffu << (shift + 8));
        if (tid < 256) hist[tid] = 0;
        __syncthreads();
#pragma unroll
        for (int q = 0; q < 16; ++q) { if (((v[q] ^ prefix) & hmask) == 0u) __hip_atomic_fetch_add(&hist[(v[q] >> shift) & 255u], 1, __ATOMIC_RELAXED, __HIP_MEMORY_SCOPE_WORKGROUP); }
        __syncthreads();
        {
            const int hc = (tid < 256) ? hist[255 - tid] : 0; int tot_;
            const int excl = block_excl_scan(hc, wsum, tid, F.lane, F.wave, tot_);
            if (tid < 256 && excl < kk && kk <= excl + hc) { bc[0] = 255 - tid; bc[1] = kk - excl; }
        }
        __syncthreads();
        prefix |= (unsigned)bc[0] << shift; kk = bc[1];
        __syncthreads();
    }
    int ceq = 0;
#pragma unroll
    for (int q = 0; q < 16; ++q) ceq += (v[q] == prefix) ? 1 : 0;
    int tot; int eqbase = block_excl_scan(ceq, wsum, tid, F.lane, F.wave, tot);
    unsigned selmask = 0u; int csel = 0;
#pragma unroll
    for (int q = 0; q < 16; ++q) { bool s = v[q] > prefix; if (v[q] == prefix) { s = eqbase < kk; ++eqbase; } if (s) { selmask |= 1u << q; ++csel; } }
    __syncthreads();
    int slot = block_excl_scan(csel, wsum, tid, F.lane, F.wave, tot);
    const int rowbase = (e * BATCH + b) * CAP;
#pragma unroll
    for (int q = 0; q < 16; ++q) { const int tok = b * SEQ + tid * 16 + q; int so = -1;
        if (selmask & (1u << q)) { const int row = rowbase + (slot < CAP ? slot : CAP - 1); so = row; F.TOK[row] = tok; F.GATEV[row] = __uint_as_float(v[q]); ++slot; }
        F.SLOTOF[(size_t)tok * NE + e] = so; }
}
__device__ __forceinline__ void phase_p7b(Frame& F) {
    const int gw = F.vcu * NWAVES + F.wave, NGW = F.G * NWAVES;
    for (int r = gw; r < NSLOT; r += NGW) { const int t = F.TOK[r];
        const v4u* src = (const v4u*)(F.XN + (size_t)t * DM) + F.lane; v4u* dst = (v4u*)(F.XE + (size_t)r * DM) + F.lane;
        const v4u a = src[0], c = src[64]; dst[0] = a; dst[64] = c; }
}
__device__ __forceinline__ void phase_p10(Frame& F) {
    const int gw = F.vcu * NWAVES + F.wave, NGW = F.G * NWAVES, lane = F.lane;
    constexpr int RB = 2;
    for (int m0 = gw; m0 < MTOK; m0 += RB * NGW) {
        float acc[RB][16]; int myslot[RB]; f32x4 x1[RB][4];
#pragma unroll
        for (int q = 0; q < RB; ++q) { const int mm = m0 + q * NGW; const size_t m = mm < MTOK ? mm : m0;
            myslot[q] = (lane < NE) ? F.SLOTOF[m * NE + lane] : -1;
#pragma unroll
            for (int t = 0; t < 4; ++t) x1[q][t] = *(const f32x4*)(F.out + m * DM + 8 * lane + 512 * (t >> 1) + 4 * (t & 1));
#pragma unroll
            for (int k = 0; k < 16; ++k) acc[q][k] = 0.f; }
#pragma unroll 1
        for (int e = 0; e < NE; ++e) {
#pragma unroll
            for (int q = 0; q < RB; ++q) { const int r = __builtin_amdgcn_readlane(myslot[q], e);
                if (r >= 0) { const float g = F.GATEV[r]; const v4u* yr = (const v4u*)(F.YE + (size_t)r * DM) + lane;
#pragma unroll
                    for (int j = 0; j < 2; ++j) { const v4u w = yr[64 * j];
                        acc[q][8 * j + 0] += g * bflo(w.x); acc[q][8 * j + 1] += g * bfhi(w.x); acc[q][8 * j + 2] += g * bflo(w.y); acc[q][8 * j + 3] += g * bfhi(w.y);
                        acc[q][8 * j + 4] += g * bflo(w.z); acc[q][8 * j + 5] += g * bfhi(w.z); acc[q][8 * j + 6] += g * bflo(w.w); acc[q][8 * j + 7] += g * bfhi(w.w); } } } }
#pragma unroll
        for (int q = 0; q < RB; ++q) { const int m = m0 + q * NGW; if (m >= MTOK) break;
            const float* mod = F.MOD + (m / SEQ) * 6 * DM;
            float s = 0.f;
#pragma unroll
            for (int k = 0; k < 16; ++k) s += acc[q][k] * acc[q][k];
            const float rr = 1.f / sqrtf(wave_sum(s) * (1.f / DM) + RMS_EPS);
            float* orow = F.out + (size_t)m * DM;
#pragma unroll
            for (int t = 0; t < 4; ++t) { const int c = 8 * lane + 512 * (t >> 1) + 4 * (t & 1);
                const f32x4 g = *(const f32x4*)(F.g_post_ffn + c), gf = *(const f32x4*)(mod + 5 * DM + c);
                f32x4 a; a.x = acc[q][4 * t]; a.y = acc[q][4 * t + 1]; a.z = acc[q][4 * t + 2]; a.w = acc[q][4 * t + 3];
                *(f32x4*)(orow + c) = x1[q][t] + gf * (a * rr * g); } }
    }
}
struct Args { const float* in[16]; float* out; unsigned char* ws; int ph_lo, ph_hi; };
__global__ void __launch_bounds__(NWAVES * 64, 2) mk_fwd(Args args) {
    extern __shared__ __attribute__((aligned(16))) unsigned char lds[];
    Frame F;
    F.lds = (LAS unsigned char*)lds;
    F.MISC = (volatile LAS unsigned*)(F.lds + MISC_OFF);
    F.tid = threadIdx.x; F.lane = F.tid & 63; F.wave = __builtin_amdgcn_readfirstlane(F.tid >> 6);
    F.G = gridDim.x; { const int bx = blockIdx.x; F.vcu = (F.G % 8 == 0) ? (bx % 8) * (F.G / 8) + bx / 8 : bx; }
    unsigned char* ws = args.ws;
    F.ctl = (gu32*)(ws + WS_CTL);
    F.x = args.in[0]; F.c = args.in[1]; F.w_ada = args.in[2]; F.b_ada = args.in[3]; F.g_pre_mix = args.in[4]; F.g_post_mix = args.in[5]; F.g_pre_ffn = args.in[6]; F.g_post_ffn = args.in[7];
    F.w_in = args.in[8]; F.dec_f = args.in[9]; F.dec_b = args.in[10]; F.w_out = args.in[11]; F.w_router = args.in[12]; F.w_gate = args.in[13]; F.w_up = args.in[14]; F.w_down = args.in[15];
    F.out = args.out;
    F.MOD = (float*)(ws + WS_MOD); F.AFF = (float*)(ws + WS_AFF); F.GATEV = (float*)(ws + WS_GATEV); F.LSE = (float*)(ws + WS_LSE); F.KV = (float*)(ws + WS_KV); F.MIXED = (float*)(ws + WS_MIXED);
    F.TOK = (int*)(ws + WS_TOK); F.SLOTOF = (int*)(ws + WS_SLOTOF);
    F.WIN = (bf16*)(ws + WS_WIN); F.WOUT = (bf16*)(ws + WS_WOUT); F.WGU = (bf16*)(ws + WS_WGU); F.WDN = (bf16*)(ws + WS_WDN); F.XN = (bf16*)(ws + WS_XN); F.PROJ = (bf16*)(ws + WS_PROJ);
    F.PREV = (bf16*)(ws + WS_PREV); F.ATTO = (bf16*)(ws + WS_ATTO); F.Y = (bf16*)(ws + WS_Y); F.XE = (bf16*)(ws + WS_XE); F.HH = (bf16*)(ws + WS_HH); F.YE = (bf16*)(ws + WS_YE); F.MIXB = (bf16*)(ws + WS_MIXED);
    for (int u = F.tid; u < (LDS_BYTES - LDSCTL_OFF) / 4; u += NWAVES * 64) ((LAS unsigned*)(F.lds + LDSCTL_OFF))[u] = 0u;
    __syncthreads();
    const int lo = args.ph_lo, hi = args.ph_hi;
    XcdBarrier bar; bar.bar = (unsigned*)(F.ctl + CW_BAR); bar.x = 0; bar.st = nullptr;
    if (hi - lo > 1) bar = xcd_barrier_post((unsigned*)(F.ctl + CW_BAR), F.MISC + 8);
#ifndef PHASE_MASK
#define PHASE_MASK 0xffff
#endif
#define IN(k) (((PHASE_MASK >> (k)) & 1) && lo <= (k) && (k) < hi)
#ifndef REP_MASK
#define REP_MASK 0
#endif
#define NREP(k) ((((REP_MASK) >> (k)) & 1) ? 2 : 1)
#define SEAM(k) do { if (IN(k) && IN((k) + 1)) xcd_barrier(bar); } while (0)
    if (IN(0)) for (int rep_ = 0; rep_ < NREP(0); ++rep_) { phase_p0a(F); } SEAM(0);
    if (IN(1)) for (int rep_ = 0; rep_ < NREP(1); ++rep_) { phase_p0b(F); } SEAM(1);
    if (IN(2)) for (int rep_ = 0; rep_ < NREP(2); ++rep_) {
        pg8::Gemm g{F.XN, F.WIN, MTOK, NPROJ, DM}; pg8::StaticOrder S; S.init(MTOK, NPROJ, F.G, (int)blockIdx.x);
        pg8::EpiBf16S E{F.PROJ, NPROJ, 0xffff, 0.125f, 0.125f * LOG2E, 1};
        pg8::gemm_phase<pg8::EpiBf16S, pg8::StaticOrder, true, true>(F.lds, g, S, E);
    } SEAM(2);
    if (IN(3)) for (int rep_ = 0; rep_ < NREP(3); ++rep_) { phase_p2(F); } SEAM(3);
    if (IN(4)) for (int rep_ = 0; rep_ < NREP(4); ++rep_) { phase_p3(F); } SEAM(4);
    if (IN(5)) for (int rep_ = 0; rep_ < NREP(5); ++rep_) { phase_p4(F); } SEAM(5);
    if (IN(6)) for (int rep_ = 0; rep_ < NREP(6); ++rep_) {
        pg8::Gemm g{F.Y, F.WOUT, MTOK, DM, DM}; pg8::StaticOrder S; S.init(MTOK, DM, F.G, (int)blockIdx.x);
        pg8::EpiBf16S E{F.MIXB, DM, 0xffff, 1.f, 1.f, 0};
        pg8::gemm_phase<pg8::EpiBf16S, pg8::StaticOrder, true, true>(F.lds, g, S, E);
    } SEAM(6);
    if (IN(7)) for (int rep_ = 0; rep_ < NREP(7); ++rep_) { phase_p6(F); } SEAM(7);
    if (IN(8)) for (int rep_ = 0; rep_ < NREP(8); ++rep_) { phase_p7(F); } if (IN(8) && IN(10)) xcd_barrier(bar);
    if (IN(10)) for (int rep_ = 0; rep_ < NREP(10); ++rep_) {
        pg8::Gemm g{F.XN, F.WGU, NSLOT, NE * 2 * FF, DM}; pg8::MoeOrder S{16, F.G, F.vcu};
        pg8::EpiSwiGLU E{F.HH, FF};
        pg8::gemm_phase<pg8::EpiSwiGLU, pg8::MoeOrder, true, true, true>(F.lds, g, S, E, F.TOK, (LAS int*)(F.lds + MISC_OFF + 256));
    } SEAM(10);
    if (IN(11)) for (int rep_ = 0; rep_ < NREP(11); ++rep_) {
        pg8::Gemm g{F.HH, F.WDN, NSLOT, NE * DM, FF}; pg8::MoeOrder S{4, F.G, F.vcu};
        pg8::EpiBf16S E{F.YE, DM, 3, 1.f, 1.f, 0};
        pg8::gemm_phase<pg8::EpiBf16S, pg8::MoeOrder, true, true>(F.lds, g, S, E);
    } SEAM(11);
    if (IN(12)) for (int rep_ = 0; rep_ < NREP(12); ++rep_) { phase_p10(F); }
#undef IN
#undef SEAM
}

extern "C" void kernel_launch(void* const* d_in, const int* in_sizes, int n_in, void* d_out, int out_size, void* d_ws, size_t ws_size, hipStream_t stream) {
    static int grid = 0;
    if (grid == 0) {
        if (n_in != 16 || in_sizes[0] != MTOK * DM || out_size != MTOK * DM || ws_size < WS_END) { fprintf(stderr, "kernel_launch: unexpected shapes: n_in %d in0 %d out %d ws %zu (need %zu)\n", n_in, n_in > 0 ? in_sizes[0] : -1, out_size, ws_size, (size_t)WS_END); grid = -1; return; }
        int dev = 0, cus = 0;
        if (hipGetDevice(&dev) != hipSuccess || hipDeviceGetAttribute(&cus, hipDeviceAttributeMultiprocessorCount, dev) != hipSuccess) { grid = -1; return; }
        if (hipFuncSetAttribute((const void*)mk_fwd, hipFuncAttributeMaxDynamicSharedMemorySize, LDS_BYTES) != hipSuccess) { fprintf(stderr, "kernel_launch: hipFuncSetAttribute failed\n"); grid = -1; return; }
        int per_cu = 0;
        if (hipOccupancyMaxActiveBlocksPerMultiprocessor(&per_cu, (const void*)mk_fwd, NWAVES * 64, LDS_BYTES) != hipSuccess || per_cu < 1) fprintf(stderr, "kernel_launch: occupancy query says %d blocks per CU\n", per_cu);
        (void)hipGetLastError();
        grid = cus;
    }
    if (grid < 0) return;
    (void)hipMemsetAsync((char*)d_ws + WS_CTL, 0, CTL_ZERO_BYTES, stream);
    Args a{};
    for (int i = 0; i < 16; ++i) a.in[i] = (const float*)d_in[i];
    a.out = (float*)d_out; a.ws = (unsigned char*)d_ws;
#if MK_ONE_LAUNCH
    a.ph_lo = 0; a.ph_hi = NPHASE;
    hipLaunchKernelGGL(mk_fwd, dim3(grid), dim3(NWAVES * 64), LDS_BYTES, stream, a);
#else
    for (int p = 0; p < NPHASE; ++p) { a.ph_lo = p; a.ph_hi = p + 1; hipLaunchKernelGGL(mk_fwd, dim3(grid), dim3(NWAVES * 64), LDS_BYTES, stream, a); }
#endif
}
```

```cpp
#include <hip/hip_runtime.h>
#include <cstdio>
#include <cstdint>
namespace pg8 {
#define PG8_LAS __attribute__((address_space(3)))
typedef unsigned short bf16_t;
typedef short bf16x8 __attribute__((ext_vector_type(8)));
typedef float f32x4 __attribute__((ext_vector_type(4)));
typedef unsigned u32x4 __attribute__((ext_vector_type(4)));
constexpr int BM = 256, BK = 64, HALF = 128, HTB = HALF * BK * 2  , STAGE_BYTES = 8 * HTB, NXCD = 8, WGM = 8;

__host__ __device__ __forceinline__ int lds_byte(int r, int c) { const int st = (r >> 4) * 2 + (c >> 5), rr = r & 15, cc = c & 31, ob = rr * 64 + cc * 2; return st * 1024 + (ob ^ (((ob >> 9) & 1) << 5)); }
__host__ __device__ __forceinline__ void stage_rc(int b, int& R, int& C) { const int st = b / 1024, sb = b % 1024, swz = sb ^ (((sb >> 9) & 1) << 5); R = (st >> 1) * 16 + swz / 64; C = (st & 1) * 32 + (swz % 64) / 2; }
__host__ __device__ __forceinline__ int perm32(int rho) { const int n = rho >> 4, i = rho & 15; return 8 * (i >> 2) + 4 * n + (i & 3); }

struct Unit { int pm, pn; };
struct Gemm { const bf16_t* A; const bf16_t* Bt; int M, N, K; };

struct StaticOrder {
    int nM, nN, nwg, G, c;
    __host__ __device__ void init(int M, int N, int G_, int c_) { nM = M / BM; nN = N / BM; nwg = nM * nN; G = G_; c = c_; }
    __host__ __device__ bool next(int i, Unit& u) const {
        const long L = (long)i * G + c; if (L >= nwg) return false;
        int wgid = (int)L; { const int q = nwg / NXCD, r = nwg % NXCD, xcd = wgid % NXCD, off = wgid / NXCD; wgid = (xcd < r ? xcd * (q + 1) : r * (q + 1) + (xcd - r) * q) + off; }
        const int nig = WGM * nN, gid = wgid / nig, fm = gid * WGM, gsz = (nM - fm) < WGM ? (nM - fm) : WGM;
        u.pm = fm + ((wgid % nig) % gsz); u.pn = (wgid % nig) / gsz; return true;
    }
    __device__ __forceinline__ void a_ready(const Unit&) const {}
    __device__ __forceinline__ void done(const Unit&) const {}
};

__device__ __forceinline__ unsigned cvt_pk_bf16(float lo, float hi) { unsigned r; asm volatile("v_cvt_pk_bf16_f32 %0, %1, %2" : "=v"(r) : "v"(lo), "v"(hi)); return r; }
typedef float f32x2 __attribute__((ext_vector_type(2)));
typedef unsigned u32x2 __attribute__((ext_vector_type(2)));
typedef int i32x4 __attribute__((ext_vector_type(4)));
typedef int i32x8 __attribute__((ext_vector_type(8)));
__device__ __forceinline__ i32x8 pg8_cat(bf16x8 lo, bf16x8 hi) { const i32x4 a = __builtin_bit_cast(i32x4, lo), b = __builtin_bit_cast(i32x4, hi); return __builtin_shufflevector(a, b, 0, 1, 2, 3, 4, 5, 6, 7); }
__device__ __forceinline__ unsigned cvt4_fp8(float a, float b, float c, float d) { unsigned w = 0u; w = __builtin_amdgcn_cvt_pk_fp8_f32(a, b, w, false); w = __builtin_amdgcn_cvt_pk_fp8_f32(c, d, w, true); return w; }
constexpr float LOG2E_F = 1.4426950408889634f;
struct EpiF32 {
    static constexpr bool PERM = false, AFTER_DRAIN = false;
    float* C; int ldc;
    __device__ __forceinline__ void operator()(const f32x4 (&acc)[2][2][4][2], const Unit& u, int wr, int wc, int fr, int fq) const {
        const int row0 = u.pm * BM + wr * 64 + fr, col0 = u.pn * BM + wc * 32 + 4 * fq;
#pragma unroll
        for (int ai = 0; ai < 2; ++ai)
#pragma unroll
            for (int m = 0; m < 4; ++m) { float* rowp = C + (size_t)(row0 + ai * HALF + m * 16) * ldc + col0;
#pragma unroll
                for (int bj = 0; bj < 2; ++bj)
#pragma unroll
                    for (int n = 0; n < 2; ++n) *(f32x4*)(rowp + bj * HALF + n * 16) = acc[ai][bj][m][n]; }
    }
};
struct EpiBf16S {
    static constexpr bool PERM = true, AFTER_DRAIN = false;
    bf16_t* O; int ldc; int pn_mask; float s_rk, s_aq; int proj;
    __device__ __forceinline__ void operator()(const f32x4 (&acc)[2][2][4][2], const Unit& u, int wr, int wc, int fr, int fq) const {
        const int pn = u.pn & pn_mask;
        const int row0 = u.pm * BM + wr * 64 + fr, col0 = pn * BM + wc * 32 + 8 * fq;
        float sc = 1.f; if (proj) sc = (pn == 1) ? s_rk : ((pn == 6 || pn == 7) ? s_aq : 1.f);
#pragma unroll
        for (int ai = 0; ai < 2; ++ai)
#pragma unroll
            for (int m = 0; m < 4; ++m) { bf16_t* rowp = O + (size_t)(row0 + ai * HALF + m * 16) * ldc + col0;
#pragma unroll
                for (int bj = 0; bj < 2; ++bj) { const f32x4 v0 = acc[ai][bj][m][0] * sc, v1 = acc[ai][bj][m][1] * sc;
                    u32x4 w; w.x = cvt_pk_bf16(v0[0], v0[1]); w.y = cvt_pk_bf16(v0[2], v0[3]); w.z = cvt_pk_bf16(v1[0], v1[1]); w.w = cvt_pk_bf16(v1[2], v1[3]);
                    *(u32x4*)(rowp + bj * HALF) = w; } }
    }
};
struct EpiSwiGLU {
    static constexpr bool PERM = true, AFTER_DRAIN = false;
    bf16_t* O; int ldc;
    __device__ __forceinline__ float act(float g, float up) const { return g * up * __builtin_amdgcn_rcpf(1.f + __builtin_amdgcn_exp2f(-g * LOG2E_F)); }
    __device__ __forceinline__ void operator()(const f32x4 (&acc)[2][2][4][2], const Unit& u, int wr, int wc, int fr, int fq) const {
        const int row0 = u.pm * BM + wr * 64 + fr, col0 = (u.pn & 15) * HALF + wc * 32 + 8 * fq;
#pragma unroll
        for (int ai = 0; ai < 2; ++ai)
#pragma unroll
            for (int m = 0; m < 4; ++m) { bf16_t* rowp = O + (size_t)(row0 + ai * HALF + m * 16) * ldc + col0;
                const f32x4 g0 = acc[ai][0][m][0], g1 = acc[ai][0][m][1], u0 = acc[ai][1][m][0], u1 = acc[ai][1][m][1];
                u32x4 w; w.x = cvt_pk_bf16(act(g0[0], u0[0]), act(g0[1], u0[1])); w.y = cvt_pk_bf16(act(g0[2], u0[2]), act(g0[3], u0[3]));
                w.z = cvt_pk_bf16(act(g1[0], u1[0]), act(g1[1], u1[1])); w.w = cvt_pk_bf16(act(g1[2], u1[2]), act(g1[3], u1[3]));
                *(u32x4*)rowp = w; }
    }
};
struct EpiSwiGLU8 {
    static constexpr bool PERM = true, AFTER_DRAIN = false;
    unsigned char* O; int ldc;
    __device__ __forceinline__ float act(float g, float up) const { return g * up * __builtin_amdgcn_rcpf(1.f + __builtin_amdgcn_exp2f(-g * LOG2E_F)); }
    __device__ __forceinline__ void operator()(const f32x4 (&acc)[2][2][4][2], const Unit& u, int wr, int wc, int fr, int fq) const {
        const int row0 = u.pm * BM + wr * 64 + fr, col0 = (u.pn & 15) * HALF + wc * 32 + 8 * fq;
#pragma unroll
        for (int ai = 0; ai < 2; ++ai)
#pragma unroll
            for (int m = 0; m < 4; ++m) { unsigned char* rowp = O + (size_t)(row0 + ai * HALF + m * 16) * ldc + col0;
                const f32x4 g0 = acc[ai][0][m][0], g1 = acc[ai][0][m][1], u0 = acc[ai][1][m][0], u1 = acc[ai][1][m][1];
                u32x2 w; w.x = cvt4_fp8(act(g0[0], u0[0]), act(g0[1], u0[1]), act(g0[2], u0[2]), act(g0[3], u0[3]));
                w.y = cvt4_fp8(act(g1[0], u1[0]), act(g1[1], u1[1]), act(g1[2], u1[2]), act(g1[3], u1[3]));
                *(u32x2*)rowp = w; }
    }
};
struct MoeOrder {
    int ntile, G, vcu;
    __device__ __forceinline__ bool next(int i, Unit& u) const {
        const int total = 16 * 8 * ntile; int L;
        if ((G & 7) == 0) { const int g8 = G >> 3, x = vcu / g8, c = vcu % g8, share = total >> 3, l = i * g8 + c; if (l >= share) return false; L = x * share + l; }
        else { L = i * G + vcu; if (L >= total) return false; }
        const int e = L / (8 * ntile), rem = L % (8 * ntile);
        u.pm = e * 8 + (rem & 7); u.pn = e * ntile + (rem >> 3); return true;
    }
    __device__ __forceinline__ void a_ready(const Unit&) const {}
    __device__ __forceinline__ void done(const Unit&) const {}
};
template <class Epi, class Sched, bool ALIGN_EPI = false, bool SP2 = false, bool GATHER = false, bool FP8 = false>
__device__ __forceinline__ void gemm_phase(PG8_LAS unsigned char* lds, const Gemm g, const Sched& S, const Epi& E, const int* rowmap = nullptr, PG8_LAS int* ldsrow = nullptr, int scale_w = 0x7f7f7f7f, int scale_x = 0x7f7f7f7f) {
    const int tid = threadIdx.x, wid = __builtin_amdgcn_readfirstlane(tid >> 6), lane = tid & 63, wr = wid >> 2, wc = wid & 3, fr = lane & 15, fq = lane >> 4;
    const int K = g.K, nt = K / BK;
    unsigned voffA[2], voffB[2];
#pragma unroll
    for (int i = 0; i < 2; ++i) { int R, C; stage_rc(tid * 16 + i * 8192, R, C); const int Rb = Epi::PERM ? ((R & ~31) + perm32(R & 31)) : R;
        voffA[i] = (unsigned)(R * K + C) * 2u; voffB[i] = (unsigned)(Rb * K + C) * 2u; }
    unsigned gC[2][2] = {{0u, 0u}, {0u, 0u}}, gN[2][2] = {{0u, 0u}, {0u, 0u}}; int gR[2] = {0, 0}; unsigned gCb[2] = {0u, 0u};
    if constexpr (GATHER) {
#pragma unroll
        for (int i = 0; i < 2; ++i) { int R, C; stage_rc(tid * 16 + i * 8192, R, C); gR[i] = R; gCb[i] = (unsigned)C * 2u; }
        Unit uu;
        for (int ui_ = 0; ui_ < 8; ++ui_) { if (!S.next(ui_, uu)) break; if (tid < 256) ldsrow[ui_ * 256 + tid] = rowmap[uu.pm * BM + tid]; }
        __syncthreads();
#pragma unroll
        for (int h = 0; h < 2; ++h)
#pragma unroll
            for (int i = 0; i < 2; ++i) gC[h][i] = (unsigned)ldsrow[h * HALF + gR[i]] * (unsigned)(K * 2) + gCb[i];
    }
    const size_t kstep = (size_t)(BK * 2);
    const size_t hstep = (size_t)HALF * K * 2;
    const size_t tstep = 2 * hstep;
    const unsigned ldsw = (unsigned)wid * 1024u;
    const int aoff = lds_byte(wr * 64 + fr, FP8 ? fq * 16 : fq * 8), boff = lds_byte(wc * 32 + fr, FP8 ? fq * 16 : fq * 8);
    constexpr int KINC = FP8 ? 16 : 1024;
#define PG8_SA(b, h) (((b) * 2 + (h)) * HTB)
#define PG8_SB(b, h) ((4 + (b) * 2 + (h)) * HTB)
#define PG8_STAGE(bufoff, gbase, voff) do { _Pragma("unroll") for (int _i = 0; _i < 2; ++_i) \
        __builtin_amdgcn_global_load_lds((const unsigned*)((const char*)(gbase) + (voff)[_i]), (PG8_LAS unsigned*)(lds + (bufoff) + ldsw + _i * 8192), 16, 0, 0); } while (0)
#define PG8_STAGE_A(bufoff, isnext, half, koff) do { \
        if constexpr (GATHER) { _Pragma("unroll") for (int _i = 0; _i < 2; ++_i) { const unsigned vo_ = (isnext) ? gN[half][_i] : gC[half][_i]; \
            __builtin_amdgcn_global_load_lds((const unsigned*)((const char*)g.A + (koff) + vo_), (PG8_LAS unsigned*)(lds + (bufoff) + ldsw + _i * 8192), 16, 0, 0); } } \
        else { const char* b_ = ((isnext) ? nA : cA) + (half) * hstep + (koff); PG8_STAGE(bufoff, b_, voffA); } } while (0)
#define PG8_LD16(p) (*(const PG8_LAS i32x4*)(p))
#define PG8_LDA(dst, b, h) do { if constexpr (FP8) { _Pragma("unroll") for (int m = 0; m < 4; ++m) { const PG8_LAS unsigned char* p_ = lds + PG8_SA(b, h) + aoff + m * 2048; dst##8[m] = __builtin_shufflevector(PG8_LD16(p_), PG8_LD16(p_ + 16), 0, 1, 2, 3, 4, 5, 6, 7); } } \
        else { _Pragma("unroll") for (int m = 0; m < 4; ++m) _Pragma("unroll") for (int k = 0; k < 2; ++k) dst[m][k] = *(const PG8_LAS bf16x8*)(lds + PG8_SA(b, h) + aoff + m * 2048 + k * 1024); } } while (0)
#define PG8_LDB(dst, b, h) do { if constexpr (FP8) { _Pragma("unroll") for (int n = 0; n < 2; ++n) { const PG8_LAS unsigned char* p_ = lds + PG8_SB(b, h) + boff + n * 2048; dst##8[n] = __builtin_shufflevector(PG8_LD16(p_), PG8_LD16(p_ + 16), 0, 1, 2, 3, 4, 5, 6, 7); } } \
        else { _Pragma("unroll") for (int n = 0; n < 2; ++n) _Pragma("unroll") for (int k = 0; k < 2; ++k) dst[n][k] = *(const PG8_LAS bf16x8*)(lds + PG8_SB(b, h) + boff + n * 2048 + k * 1024); } } while (0)
#define PG8_MMA8(A_, At8_, Bt8_) asm volatile( \
        "v_mfma_scale_f32_16x16x128_f8f6f4 %0, %12, %8, %0, %14, %15 op_sel_hi:[0,0,0]\n\t" \
        "v_mfma_scale_f32_16x16x128_f8f6f4 %1, %13, %8, %1, %14, %15 op_sel_hi:[0,0,0]\n\t" \
        "v_mfma_scale_f32_16x16x128_f8f6f4 %2, %12, %9, %2, %14, %15 op_sel_hi:[0,0,0]\n\t" \
        "v_mfma_scale_f32_16x16x128_f8f6f4 %3, %13, %9, %3, %14, %15 op_sel_hi:[0,0,0]\n\t" \
        "v_mfma_scale_f32_16x16x128_f8f6f4 %4, %12, %10, %4, %14, %15 op_sel_hi:[0,0,0]\n\t" \
        "v_mfma_scale_f32_16x16x128_f8f6f4 %5, %13, %10, %5, %14, %15 op_sel_hi:[0,0,0]\n\t" \
        "v_mfma_scale_f32_16x16x128_f8f6f4 %6, %12, %11, %6, %14, %15 op_sel_hi:[0,0,0]\n\t" \
        "v_mfma_scale_f32_16x16x128_f8f6f4 %7, %13, %11, %7, %14, %15 op_sel_hi:[0,0,0]\n\t" \
        "s_nop 3" \
        : "+v"(A_[0][0]), "+v"(A_[0][1]), "+v"(A_[1][0]), "+v"(A_[1][1]), "+v"(A_[2][0]), "+v"(A_[2][1]), "+v"(A_[3][0]), "+v"(A_[3][1]) \
        : "v"(At8_[0]), "v"(At8_[1]), "v"(At8_[2]), "v"(At8_[3]), "v"(Bt8_[0]), "v"(Bt8_[1]), "v"(scale_w), "v"(scale_x))
#define PG8_MMA(ai, bj, At, Bt) do { __builtin_amdgcn_s_setprio(1); \
        if constexpr (FP8) { PG8_MMA8(acc[ai][bj], At##8, Bt##8); } \
        else { _Pragma("unroll") for (int m = 0; m < 4; ++m) _Pragma("unroll") for (int n = 0; n < 2; ++n) _Pragma("unroll") for (int k = 0; k < 2; ++k) \
            acc[ai][bj][m][n] = __builtin_amdgcn_mfma_f32_16x16x32_bf16(Bt[n][k], At[m][k], acc[ai][bj][m][n], 0, 0, 0); } \
        __builtin_amdgcn_s_setprio(0); } while (0)
#define PG8_WAIT_V(n) asm volatile("s_waitcnt vmcnt(" #n ")" ::: "memory")
#define PG8_WAIT_L(n) asm volatile("s_waitcnt lgkmcnt(" #n ")" ::: "memory")
#define PG8_BAR __builtin_amdgcn_s_barrier()
#define PG8_SCHED __builtin_amdgcn_sched_barrier(0)
    Unit cur, nxt; int ui = 0;
    if (!S.next(0, cur)) return;
    f32x4 acc[2][2][4][2];
#pragma unroll
    for (int a = 0; a < 2; ++a)
#pragma unroll
        for (int b = 0; b < 2; ++b)
#pragma unroll
            for (int m = 0; m < 4; ++m)
#pragma unroll
                for (int n = 0; n < 2; ++n) acc[a][b][m][n] = (f32x4){0.f, 0.f, 0.f, 0.f};
    bf16x8 At[4][2], B0[2][2], B1[2][2]; i32x8 At8[4], B08[2], B18[2]; (void)At; (void)B0; (void)B1; (void)At8; (void)B08; (void)B18;
    const char* cA = (const char*)g.A + (size_t)cur.pm * tstep; const char* cB = (const char*)g.Bt + (size_t)cur.pn * tstep;
    S.a_ready(cur);
    const char* nA = cA; (void)nA;
    if constexpr (SP2) {
        PG8_STAGE(PG8_SB(0, 0), cB, voffB); PG8_STAGE(PG8_SB(0, 1), cB + hstep, voffB); PG8_STAGE_A(PG8_SA(0, 0), false, 0, (size_t)0); PG8_STAGE_A(PG8_SA(0, 1), false, 1, (size_t)0);
        if (wr == 1) PG8_BAR;
        PG8_WAIT_V(2); PG8_BAR;
        PG8_STAGE(PG8_SB(1, 0), cB + kstep, voffB); PG8_STAGE_A(PG8_SA(1, 0), false, 0, kstep); PG8_STAGE(PG8_SB(1, 1), cB + hstep + kstep, voffB);
        PG8_WAIT_V(6); PG8_BAR;
    } else {
        PG8_STAGE(PG8_SB(0, 0), cB, voffB); PG8_STAGE_A(PG8_SA(0, 0), false, 0, (size_t)0); PG8_STAGE(PG8_SB(0, 1), cB + hstep, voffB); PG8_STAGE_A(PG8_SA(0, 1), false, 1, (size_t)0);
        if (wr == 1) PG8_BAR;
        PG8_WAIT_V(4); PG8_BAR;
        PG8_STAGE(PG8_SB(1, 0), cB + kstep, voffB); PG8_STAGE_A(PG8_SA(1, 0), false, 0, kstep); PG8_STAGE(PG8_SB(1, 1), cB + hstep + kstep, voffB);
        PG8_WAIT_V(6); PG8_BAR;
    }
    for (;;) {
        const bool has_next = S.next(ui + 1, nxt);
        if constexpr (GATHER) {
#pragma unroll
            for (int h = 0; h < 2; ++h)
#pragma unroll
                for (int i = 0; i < 2; ++i) gN[h][i] = has_next ? (unsigned)ldsrow[(ui + 1) * 256 + h * HALF + gR[i]] * (unsigned)(K * 2) + gCb[i] : gC[h][i];
        }
        const char* nA = has_next ? (const char*)g.A + (size_t)nxt.pm * tstep : cA; const char* nB = has_next ? (const char*)g.Bt + (size_t)nxt.pn * tstep : cB;
        for (int t = 0; t < nt; t += 2) {
            const bool last = (t == nt - 2);
            const size_t k1 = (size_t)(t + 1) * kstep, k2 = last ? (size_t)0 : (size_t)(t + 2) * kstep, k3 = k2 + kstep;
            const char* a1 = cA + (size_t)(t + 1) * kstep;
            const char* a2 = last ? nA : cA + (size_t)(t + 2) * kstep; const char* b2 = last ? nB : cB + (size_t)(t + 2) * kstep;
            const char* a3 = a2 + kstep; const char* b3 = b2 + kstep;
            if (last && has_next) S.a_ready(nxt);
            if constexpr (SP2) {
            PG8_LDB(B0, 0, 0); PG8_LDB(B1, 0, 1); PG8_SCHED; PG8_LDA(At, 0, 0); PG8_STAGE_A(PG8_SA(1, 1), false, 1, k1);
            PG8_WAIT_V(8); PG8_WAIT_L(0); PG8_BAR; PG8_MMA(0, 0, At, B0); PG8_MMA(0, 1, At, B1); PG8_BAR; PG8_SCHED;
            PG8_LDA(At, 0, 1); PG8_STAGE(PG8_SB(0, 0), b2, voffB); PG8_STAGE(PG8_SB(0, 1), b2 + hstep, voffB); PG8_STAGE_A(PG8_SA(0, 0), last, 0, k2);
            PG8_WAIT_V(8); PG8_WAIT_L(0); PG8_BAR; PG8_MMA(1, 0, At, B0); PG8_MMA(1, 1, At, B1); PG8_BAR; PG8_SCHED;
            PG8_LDB(B0, 1, 0); PG8_LDB(B1, 1, 1); PG8_SCHED; PG8_LDA(At, 1, 0); PG8_STAGE_A(PG8_SA(0, 1), last, 1, k2);
            PG8_WAIT_V(8); PG8_WAIT_L(0); PG8_BAR; PG8_MMA(0, 0, At, B0); PG8_MMA(0, 1, At, B1); PG8_BAR; PG8_SCHED;
            PG8_LDA(At, 1, 1); PG8_STAGE(PG8_SB(1, 0), b3, voffB); PG8_STAGE(PG8_SB(1, 1), b3 + hstep, voffB); PG8_STAGE_A(PG8_SA(1, 0), last, 0, k3);
            PG8_WAIT_V(8); PG8_WAIT_L(0); PG8_BAR; PG8_MMA(1, 0, At, B0); PG8_MMA(1, 1, At, B1); PG8_BAR; PG8_SCHED;
            } else {
            PG8_LDB(B0, 0, 0); PG8_SCHED; PG8_LDA(At, 0, 0); PG8_STAGE_A(PG8_SA(1, 1), false, 1, k1);
            PG8_WAIT_L(8); PG8_BAR; PG8_WAIT_L(0); PG8_MMA(0, 0, At, B0); PG8_BAR; PG8_SCHED;
            PG8_LDB(B1, 0, 1); PG8_STAGE(PG8_SB(0, 0), b2, voffB);
            PG8_BAR; PG8_WAIT_L(0); PG8_MMA(0, 1, At, B1); PG8_BAR;
            PG8_LDA(At, 0, 1); PG8_STAGE_A(PG8_SA(0, 0), last, 0, k2);
            PG8_BAR; PG8_WAIT_L(0); PG8_MMA(1, 0, At, B0); PG8_BAR; PG8_SCHED;
            PG8_STAGE(PG8_SB(0, 1), b2 + hstep, voffB);
            PG8_WAIT_V(6); PG8_BAR; PG8_MMA(1, 1, At, B1); PG8_BAR;
            PG8_LDB(B0, 1, 0); PG8_SCHED; PG8_LDA(At, 1, 0); PG8_STAGE_A(PG8_SA(0, 1), last, 1, k2);
            PG8_WAIT_L(8); PG8_BAR; PG8_WAIT_L(0); PG8_MMA(0, 0, At, B0); PG8_BAR; PG8_SCHED;
            PG8_LDB(B1, 1, 1); PG8_STAGE(PG8_SB(1, 0), b3, voffB);
            PG8_BAR; PG8_WAIT_L(0); PG8_MMA(0, 1, At, B1); PG8_BAR;
            PG8_LDA(At, 1, 1); PG8_STAGE_A(PG8_SA(1, 0), last, 0, k3);
            PG8_BAR; PG8_WAIT_L(0); PG8_MMA(1, 0, At, B0); PG8_BAR; PG8_SCHED;
            PG8_STAGE(PG8_SB(1, 1), b3 + hstep, voffB);
            PG8_WAIT_V(6); PG8_BAR; PG8_MMA(1, 1, At, B1); PG8_BAR;
            }
        }
        if constexpr (ALIGN_EPI) { if (wr == 0) PG8_BAR; }
        if constexpr (!Epi::AFTER_DRAIN) { E(acc, cur, wr, wc, fr, fq); S.done(cur); }
        if (!has_next) break;
#pragma unroll
        for (int a = 0; a < 2; ++a)
#pragma unroll
            for (int b = 0; b < 2; ++b)
#pragma unroll
                for (int m = 0; m < 4; ++m)
#pragma unroll
                    for (int n = 0; n < 2; ++n) acc[a][b][m][n] = (f32x4){0.f, 0.f, 0.f, 0.f};
        cur = nxt; cA = nA; cB = nB; ++ui;
        if constexpr (GATHER) { gC[0][0] = gN[0][0]; gC[0][1] = gN[0][1]; gC[1][0] = gN[1][0]; gC[1][1] = gN[1][1]; }
        if constexpr (ALIGN_EPI) { if (wr == 1) PG8_BAR; }
    }
    PG8_WAIT_V(0);
    if constexpr (!ALIGN_EPI) { if (wr == 0) PG8_BAR; }
    PG8_BAR;
    if constexpr (Epi::AFTER_DRAIN) { E.fused(acc, cur, wr, wc, fr, fq, lds, wid, lane); S.done(cur); }
#undef PG8_SA
#undef PG8_SB
#undef PG8_STAGE
#undef PG8_STAGE_A
#undef PG8_LDA
#undef PG8_LD16
#undef PG8_LDB
#undef PG8_MMA
#undef PG8_MMA8
#undef PG8_WAIT_V
#undef PG8_WAIT_L
#undef PG8_BAR
#undef PG8_SCHED
}
}
constexpr int BATCH = 2, SEQ = 8192, DM = 1024, MTOK = BATCH * SEQ;
constexpr int RH = 4, RQK = 64, RV = 128, CHK = 128, NCH = SEQ / CHK;
constexpr int AH = 8, AD = 64;
constexpr int NE = 16, CAP = 1024, FF = 2048, NSLOT = NE * BATCH * CAP;
constexpr int NPROJ = 3072;
constexpr int C_RQ = 0, C_RK = 256, C_RV = 512, C_RG = 1024, C_AQ = 1536, C_AK = 2048, C_AV = 2560;
constexpr float RMS_EPS = 1e-6f, GN_EPS = 1e-5f;
constexpr float LOG2E = 1.4426950408889634f;
constexpr int NWAVES = 8;
#ifndef MK_ONE_LAUNCH
#define MK_ONE_LAUNCH 1
#endif
constexpr int NPHASE = 13;
constexpr size_t MiB = 1u << 20;
constexpr size_t WS_CTL = 0, CTL_ZERO_BYTES = 1 * MiB;
constexpr size_t WS_MOD = 1 * MiB;
constexpr size_t WS_AFF = 2 * MiB;
constexpr size_t WS_TOK = 3 * MiB;
constexpr size_t WS_GATEV = 3 * MiB + 128 * 1024;
constexpr size_t WS_SLOTOF = 3 * MiB + 256 * 1024;
constexpr size_t WS_LSE = 5 * MiB;
constexpr size_t WS_WIN = 8 * MiB;
constexpr size_t WS_WOUT = 14 * MiB;
constexpr size_t WS_WGU = 16 * MiB;
constexpr size_t WS_WDN = 144 * MiB;
constexpr size_t WS_XN = 208 * MiB;
constexpr size_t WS_R = 240 * MiB;
constexpr size_t WS_PROJ = WS_R;
constexpr size_t WS_KV = WS_R + 96 * MiB;
constexpr size_t WS_PREV = WS_R + 128 * MiB;
constexpr size_t WS_ATTO = WS_R + 144 * MiB;
constexpr size_t WS_Y = WS_R + 192 * MiB;
constexpr size_t WS_MIXED = WS_R;
constexpr size_t WS_XE = WS_R + 64 * MiB;
constexpr size_t WS_HH = WS_R + 128 * MiB;
constexpr size_t WS_YE = WS_R;
constexpr size_t WS_END = WS_R + 256 * MiB;
constexpr int CW_BAR = 4096;
constexpr int RING_BYTES = 131072;
constexpr int LDSCTL_OFF = RING_BYTES, MISC_OFF = LDSCTL_OFF + 320;
constexpr int LDS_BYTES = 147456;

#define GAS __attribute__((address_space(1)))
#define LAS __attribute__((address_space(3)))
typedef unsigned short bf16;
typedef unsigned v4u __attribute__((ext_vector_type(4)));
typedef unsigned v2u __attribute__((ext_vector_type(2)));
typedef float f32x4 __attribute__((ext_vector_type(4)));
typedef float f32x16 __attribute__((ext_vector_type(16)));
typedef short bf16x8 __attribute__((ext_vector_type(8)));
typedef short s16x4 __attribute__((ext_vector_type(4)));
typedef GAS unsigned gu32;
#define RLX_AGENT __ATOMIC_RELAXED, __HIP_MEMORY_SCOPE_AGENT
#define LDS_WAIT() asm volatile("s_waitcnt lgkmcnt(0)" ::: "memory")
typedef float f32x2_t __attribute__((ext_vector_type(2))); typedef __bf16 bf16x2_t __attribute__((ext_vector_type(2)));
__device__ __forceinline__ unsigned pk2(float lo, float hi) { f32x2_t v = {lo, hi}; bf16x2_t b = __builtin_convertvector(v, bf16x2_t); return __builtin_bit_cast(unsigned, b); }
__device__ __forceinline__ float bflo(unsigned w) { return __uint_as_float(w << 16); }
__device__ __forceinline__ float bfhi(unsigned w) { return __uint_as_float(w & 0xffff0000u); }
__device__ __forceinline__ float ex2(float x) { return __builtin_amdgcn_exp2f(x); }
__device__ __forceinline__ int crow(int r, int hi) { return (r & 3) + 8 * (r >> 2) + 4 * hi; }
__device__ __forceinline__ s16x4 vtr(const LAS unsigned char* p) { typedef short v4i16_t __attribute__((ext_vector_type(4))); return __builtin_bit_cast(s16x4, __builtin_amdgcn_ds_read_tr16_b64_v4i16((LAS v4i16_t*)p)); }
__device__ __forceinline__ bf16x8 cat8(s16x4 a, s16x4 b) { return (bf16x8){a[0], a[1], a[2], a[3], b[0], b[1], b[2], b[3]}; }
__device__ __forceinline__ float wave_sum(float v) {
#pragma unroll
    for (int o = 1; o < 64; o <<= 1) v += __shfl_xor(v, o);
    return v;
}
#define XB_TMO      128
#define XB_XCNT(j)  (256  + 64 * (j))
#define XB_XSUB(j)  (1280 + 64 * (j))
#define XB_XGEN(j)  (2304 + 64 * (j))
#define XB_TOP      3328
#define XB_TOPGEN   3392
#define XCD_BAR_WORDS 3456
#define XB_SPIN_CAP (1u << 18)

__device__ __forceinline__ unsigned xb_ld(unsigned* p)              { return __hip_atomic_load(p, __ATOMIC_RELAXED, __HIP_MEMORY_SCOPE_AGENT); }
__device__ __forceinline__ unsigned xb_add(unsigned* p, unsigned v) { return __hip_atomic_fetch_add(p, v, __ATOMIC_RELAXED, __HIP_MEMORY_SCOPE_AGENT); }
__device__ __forceinline__ unsigned xb_xcc_id() { return (unsigned)__builtin_amdgcn_s_getreg((3 << 11) | 20) & 0xFu; }
#define XB_SPIN(cond, bar) do { unsigned _sp = 0; while (cond) { __builtin_amdgcn_s_sleep(1); \
    if ((++_sp & 255u) == 0u) { if (xb_ld(&(bar)[XB_TMO])) break; if (_sp > XB_SPIN_CAP) { atomicAdd(&(bar)[XB_TMO], 1u); break; } } } } while (0)

struct XcdBarrier {
    unsigned* bar; unsigned x;
    volatile LAS unsigned* st;
};

__device__ __forceinline__ XcdBarrier xcd_barrier_post(unsigned* bar, volatile LAS unsigned* st) {
    XcdBarrier b; b.bar = bar; b.x = xb_xcc_id(); b.st = st;
    if (threadIdx.x == 0) (void)xb_add(&bar[XB_XCNT(b.x)], 1u);
    return b;
}
__device__ __forceinline__ void xcd_barrier_complete(unsigned* bar, unsigned x, unsigned& nloc, unsigned& nx) {
    const unsigned G = gridDim.x * gridDim.y * gridDim.z;
    unsigned sum, cnt, mine, sp = 0u;
    for (;;) {
        sum = 0u; cnt = 0u; mine = 0u;
#pragma unroll
        for (unsigned j = 0; j < 16; ++j) { const unsigned c = xb_ld(&bar[XB_XCNT(j)]); sum += c; cnt += (c > 0u) ? 1u : 0u; mine = (j == x) ? c : mine; }
        if (sum == G) break;
        __builtin_amdgcn_s_sleep(1);
        if ((++sp & 255u) == 0u) { if (xb_ld(&bar[XB_TMO])) break; if (sp > XB_SPIN_CAP) { atomicAdd(&bar[XB_TMO], 1u); break; } }
    }
    nloc = mine > 0u ? mine : 1u; nx = cnt > 0u ? cnt : 1u;
}

__device__ __forceinline__ void xcd_barrier(const XcdBarrier& b) {
    asm volatile("s_waitcnt vmcnt(0)" ::: "memory");
    __syncthreads();
    if (threadIdx.x == 0) {
        unsigned* bar = b.bar;
        __builtin_amdgcn_s_waitcnt(0);
        unsigned nloc = b.st[0], nx = b.st[1];
        if (nloc == 0u) { xcd_barrier_complete(bar, b.x, nloc, nx); b.st[0] = nloc; b.st[1] = nx; }
        const unsigned old = xb_add(&bar[XB_XSUB(b.x)], 1u);
        const unsigned gen = old / nloc;
        if (old + 1u == (gen + 1u) * nloc) {
            __builtin_amdgcn_fence(__ATOMIC_RELEASE, "agent");
            asm volatile("s_waitcnt vmcnt(0)" ::: "memory");
            const unsigned og = xb_add(&bar[XB_TOP], 1u);
            const unsigned tg = og / nx;
            if (og + 1u == (tg + 1u) * nx) xb_add(&bar[XB_TOPGEN], 1u);
            else XB_SPIN(xb_ld(&bar[XB_TOPGEN]) == tg, bar);
            __builtin_amdgcn_fence(__ATOMIC_ACQUIRE, "agent");
            xb_add(&bar[XB_XGEN(b.x)], 1u);
            asm volatile("s_waitcnt vmcnt(0)" ::: "memory");
        } else {
            XB_SPIN(xb_ld(&bar[XB_XGEN(b.x)]) == gen, bar);
            __builtin_amdgcn_fence(__ATOMIC_ACQUIRE, "agent");
            asm volatile("s_waitcnt vmcnt(0)" ::: "memory");
        }
    }
    __syncthreads();
}
struct Frame {
    LAS unsigned char* lds;
    volatile LAS unsigned* MISC;
    gu32* ctl;
    int tid, lane, wave;
    int vcu, G;
    const float *x, *c, *w_ada, *b_ada, *g_pre_mix, *g_post_mix, *g_pre_ffn, *g_post_ffn, *w_in, *dec_f, *dec_b, *w_out, *w_router, *w_gate, *w_up, *w_down;
    float* out;
    float *MOD, *AFF, *GATEV, *LSE, *KV, *MIXED;
    int *TOK, *SLOTOF;
    bf16 *WIN, *WOUT, *WGU, *WDN, *XN, *PROJ, *PREV, *ATTO, *Y, *XE, *HH, *YE, *MIXB;
};

__device__ __forceinline__ void p0_transpose_item(const float* W, int K, int N, bf16* WT, int k0, int n0, int drow0, LAS float* scr, int lane) {
#pragma unroll 8
    for (int i = 0; i < 32; ++i) { const int kk = 2 * i + (lane >> 5); scr[kk * 33 + (lane & 31)] = W[(size_t)(k0 + kk) * N + n0 + (lane & 31)]; }
    LDS_WAIT(); asm volatile("" ::: "memory");
    const int c = lane & 7;
#pragma unroll
    for (int j = 0; j < 4; ++j) { const int n = (lane >> 3) + 8 * j; const LAS float* s = scr + (8 * c) * 33 + n;
        v4u o; o.x = pk2(s[0 * 33], s[1 * 33]); o.y = pk2(s[2 * 33], s[3 * 33]); o.z = pk2(s[4 * 33], s[5 * 33]); o.w = pk2(s[6 * 33], s[7 * 33]);
        *(GAS v4u*)(WT + (size_t)(drow0 + n) * K + k0 + 8 * c) = o; }
    LDS_WAIT(); asm volatile("" ::: "memory");
}
__device__ __forceinline__ void p0_transpose_item8(const float* W, int K, int N, unsigned char* WT, int k0, int n0, int drow0, LAS float* scr, int lane) {
#pragma unroll 8
    for (int i = 0; i < 32; ++i) { const int kk = 2 * i + (lane >> 5); scr[kk * 33 + (lane & 31)] = W[(size_t)(k0 + kk) * N + n0 + (lane & 31)]; }
    LDS_WAIT(); asm volatile("" ::: "memory");
    const int c = lane & 7;
#pragma unroll
    for (int j = 0; j < 4; ++j) { const int n = (lane >> 3) + 8 * j; const LAS float* s = scr + (8 * c) * 33 + n;
        v2u o; o.x = pg8::cvt4_fp8(s[0 * 33] * 32.f, s[1 * 33] * 32.f, s[2 * 33] * 32.f, s[3 * 33] * 32.f); o.y = pg8::cvt4_fp8(s[4 * 33] * 32.f, s[5 * 33] * 32.f, s[6 * 33] * 32.f, s[7 * 33] * 32.f);
        *(GAS v2u*)(WT + (size_t)(drow0 + n) * K + k0 + 8 * c) = o; }
    LDS_WAIT(); asm volatile("" ::: "memory");
}
__device__ __forceinline__ void phase_p0a(Frame& F) {
    LAS float* sc = (LAS float*)(F.lds + 98304);
    for (int i = F.tid; i < 2 * DM; i += NWAVES * 64) { const float v = F.c[i]; sc[i] = v / (1.f + __expf(-v)); }
    __syncthreads();
    { const int gwm = F.wave * F.G + F.vcu;
      for (int it = gwm; it < 6 * DM / 16; it += F.G * NWAVES) {
        const int col = it * 16 + (F.lane & 15), kq = F.lane >> 4; float a0 = 0.f, a1 = 0.f;
#pragma unroll 8
        for (int k = kq; k < DM; k += 4) { const float w = F.w_ada[(size_t)k * (6 * DM) + col]; a0 += sc[k] * w; a1 += sc[DM + k] * w; }
        a0 += __shfl_xor(a0, 16); a0 += __shfl_xor(a0, 32); a1 += __shfl_xor(a1, 16); a1 += __shfl_xor(a1, 32);
        if (kq == 0) { const float bb = F.b_ada[col]; F.MOD[col] = a0 + bb; F.MOD[6 * DM + col] = a1 + bb; }
      } }
    LAS float* scr = (LAS float*)(F.lds + F.wave * 12288);
    const int gw = F.vcu * NWAVES + F.wave, NGW = F.G * NWAVES;
    constexpr int I_IN = (DM / 64) * (NPROJ / 32), I_OUT = (DM / 64) * (DM / 32), I_G1 = (DM / 64) * (FF / 32), I_G = NE * I_G1, I_D1 = (FF / 64) * (DM / 32), I_D = NE * I_D1;
    constexpr int NITEMS = I_IN + I_OUT + 2 * I_G + I_D;
    for (int it = gw; it < NITEMS; it += NGW) {
        int r = it;
        if (r < I_IN) { const int nblk = NPROJ / 32, kb = r / nblk, nb = r % nblk; p0_transpose_item(F.w_in, DM, NPROJ, F.WIN, 64 * kb, 32 * nb, 32 * nb, scr, F.lane); continue; } r -= I_IN;
        if (r < I_OUT) { const int nblk = DM / 32, kb = r / nblk, nb = r % nblk; p0_transpose_item(F.w_out, DM, DM, F.WOUT, 64 * kb, 32 * nb, 32 * nb, scr, F.lane); continue; } r -= I_OUT;
        if (r < 2 * I_G) { const int half = r / I_G; r -= half * I_G; const int e = r / I_G1, q = r % I_G1, nblk = FF / 32, kb = q / nblk, nb = q % nblk, n0 = 32 * nb;
            const float* W = (half ? F.w_up : F.w_gate) + (size_t)e * DM * FF;
            p0_transpose_item8(W, DM, FF, (unsigned char*)F.WGU + (size_t)e * (2 * FF) * DM, 64 * kb, n0, (n0 >> 7) * 256 + half * 128 + (n0 & 127), scr, F.lane); continue; } r -= 2 * I_G;
        { const int e = r / I_D1, q = r % I_D1, nblk = DM / 32, kb = q / nblk, nb = q % nblk;
          p0_transpose_item8(F.w_down + (size_t)e * FF * DM, FF, DM, (unsigned char*)F.WDN + (size_t)e * DM * FF, 64 * kb, 32 * nb, 32 * nb, scr, F.lane); }
    }
}
__device__ __forceinline__ void phase_p0b(Frame& F) {
    const int gw = F.vcu * NWAVES + F.wave, NGW = F.G * NWAVES;
    constexpr int RB = 4;
    for (int m0 = gw; m0 < MTOK; m0 += RB * NGW) {
        f32x4 v[RB][4]; float s[RB];
#pragma unroll
        for (int q = 0; q < RB; ++q) { const int m = m0 + q * NGW; const GAS f32x4* xr = (const GAS f32x4*)(F.x + (size_t)(m < MTOK ? m : m0) * DM) + F.lane;
#pragma unroll
            for (int j = 0; j < 4; ++j) v[q][j] = xr[64 * j]; }
#pragma unroll
        for (int q = 0; q < RB; ++q) { float t = 0.f;
#pragma unroll
            for (int j = 0; j < 4; ++j) t += (v[q][j].x * v[q][j].x + v[q][j].y * v[q][j].y) + (v[q][j].z * v[q][j].z + v[q][j].w * v[q][j].w);
            s[q] = 1.f / sqrtf(wave_sum(t) * (1.f / DM) + RMS_EPS); }
#pragma unroll
        for (int q = 0; q < RB; ++q) { const int m = m0 + q * NGW; if (m >= MTOK) break;
            const float* mod = F.MOD + (m / SEQ) * 6 * DM; GAS v2u* o8 = (GAS v2u*)(F.XN + (size_t)m * DM) + F.lane;
#pragma unroll
            for (int j = 0; j < 4; ++j) { const int c = 4 * F.lane + 256 * j;
                const f32x4 g = *(const f32x4*)(F.g_pre_mix + c), sc = *(const f32x4*)(mod + DM + c), sh = *(const f32x4*)(mod + c);
                const f32x4 h = v[q][j] * s[q] * g * (sc + 1.f) + sh;
                v2u w; w.x = pk2(h.x, h.y); w.y = pk2(h.z, h.w); o8[64 * j] = w; } }
    }
}
__device__ __forceinline__ float lg2_sigmoid(float x) { return -log1pf(__expf(-x)) * LOG2E; }
struct AttnDesc { int b, h, cfg, r, qblk; };
__device__ __forceinline__ AttnDesc attn_decode(int u) {
    AttnDesc a; const int blk = u & 31; a.h = (u >> 5) & 7; a.b = (u >> 8) & 1; a.cfg = u >> 9;
    const int d = (a.cfg == 0) ? 1 : ((a.cfg == 1) ? 4 : 16), nq = (SEQ / d) / 256; a.r = blk / nq; a.qblk = blk % nq; return a;
}
constexpr int ATT_KOFF = 0, ATT_VOFF = 49152;
__device__ __forceinline__ void attn_prefetch(Frame& F, const AttnDesc& a, v4u (&kr)[6], v4u (&vr)[6]) {
    const int d = (a.cfg == 0) ? 1 : ((a.cfg == 1) ? 4 : 16), L = SEQ / d;
    const bf16* P = F.PROJ + (size_t)a.b * SEQ * NPROJ;
    const int wl0 = 256 * a.qblk - 64, ch = F.tid & 7;
#pragma unroll
    for (int p = 0; p < 6; ++p) {
        int l = wl0 + p * 64 + (F.tid >> 3); l = l < 0 ? 0 : (l > L - 1 ? L - 1 : l);
        const bf16* rp = P + (size_t)(l * d + a.r) * NPROJ + a.h * AD + ch * 8;
        kr[p] = *(const v4u*)(rp + C_AK); vr[p] = *(const v4u*)(rp + C_AV);
    }
}
__device__ __forceinline__ void attn_stage(Frame& F, const v4u (&kr)[6], const v4u (&vr)[6]) {
    const int ch = F.tid & 7;
#pragma unroll
    for (int p = 0; p < 6; ++p) { const int kidx = p * 64 + (F.tid >> 3);
        *(LAS v4u*)(F.lds + ATT_KOFF + kidx * 128 + ((ch ^ (kidx & 7)) << 4)) = kr[p];
        *(LAS v4u*)(F.lds + ATT_VOFF + (ch >> 2) * (384 * 64) + (kidx >> 3) * 512 + (kidx & 7) * 64 + (ch & 3) * 16) = vr[p]; }
}
__device__ __forceinline__ void attn_compute(Frame& F, const AttnDesc& a) {
    const int cfg = a.cfg, h = a.h, b = a.b, r = a.r, qblk = a.qblk;
    const int d = (cfg == 0) ? 1 : ((cfg == 1) ? 4 : 16), L = SEQ / d;
    const int wave = F.wave; int lane = F.lane; asm volatile("" : "+v"(lane));
    const int i = lane & 31, hi = lane >> 5;
    const bf16* P = F.PROJ + (size_t)b * SEQ * NPROJ;
    const int lw0 = 256 * qblk + 32 * wave - 64;
    const int ql = 256 * qblk + 32 * wave + i;
    bf16x8 qf[4];
    { const bf16* qp = P + (size_t)(ql * d + r) * NPROJ + C_AQ + h * AD + hi * 8;
#pragma unroll
      for (int s = 0; s < 4; ++s) qf[s] = *(const bf16x8*)(qp + 16 * s); }
    const float slope2 = ex2(-(float)(h + 1)) * (float)d * LOG2E;
    f32x16 acc[5];
    const int a0 = i + 64 - 4 * hi;
    const LAS unsigned char* Kl = F.lds + ATT_KOFF;
#pragma unroll
    for (int T = 0; T < 5; ++T) {
        const float cinit = (T < 2) ? -slope2 * (float)(a0 - 32 * T) : ((T > 2) ? slope2 * (float)(a0 - 32 * T) : 0.f);
        f32x16 c;
#pragma unroll
        for (int rr = 0; rr < 16; ++rr) c[rr] = cinit;
        const int key = 32 * wave + 32 * T + i;
#pragma unroll
        for (int s = 0; s < 4; ++s) { const bf16x8 kf = *(const LAS bf16x8*)(Kl + key * 128 + (((2 * s + hi) ^ (key & 7)) << 4));
            c = __builtin_amdgcn_mfma_f32_32x32x16_bf16(kf, qf[s], c, 0, 0, 0); }
        acc[T] = c;
    }
    if (lw0 < 0 || lw0 + 160 > L) {
#pragma unroll
        for (int T = 0; T < 5; ++T)
#pragma unroll
            for (int rr = 0; rr < 16; ++rr) { const int kl = lw0 + 32 * T + crow(rr, hi); if (kl < 0 || kl >= L) acc[T][rr] = -1.0e30f; }
    }
    const int th0 = i - 4 * hi; const float fa2 = (float)(a0 - 64);
    float mx = -3.0e38f;
#pragma unroll
    for (int rr = 0; rr < 16; ++rr) { const int c0 = (rr & 3) + 8 * (rr >> 2); const float sc0 = slope2 * (float)c0;
        float v0 = acc[0][rr] + sc0; v0 = (c0 >= th0) ? v0 : -1.0e30f;
        const float v1 = acc[1][rr] + sc0;
        const float v2 = acc[2][rr] - slope2 * fabsf(fa2 - (float)c0);
        const float v3 = acc[3][rr] - sc0;
        float v4 = acc[4][rr] - sc0; v4 = (c0 <= th0) ? v4 : -1.0e30f;
        acc[0][rr] = v0; acc[1][rr] = v1; acc[2][rr] = v2; acc[3][rr] = v3; acc[4][rr] = v4;
        mx = fmaxf(mx, fmaxf(fmaxf(v0, v1), fmaxf(fmaxf(v2, v3), v4))); }
    mx = fmaxf(mx, __shfl_xor(mx, 32));
    float lsum = 0.f;
#pragma unroll
    for (int T = 0; T < 5; ++T)
#pragma unroll
        for (int rr = 0; rr < 16; ++rr) { const float p = ex2(acc[T][rr] - mx); acc[T][rr] = p; lsum += p; }
    lsum += __shfl_xor(lsum, 32);
    f32x16 o[2]; o[0] = f32x16{}; o[1] = f32x16{};
    const LAS unsigned char* vb = F.lds + ATT_VOFF + ((lane >> 4) & 1) * 32 + (lane & 3) * 8 + (4 * hi + ((lane & 15) >> 2)) * 64;
#pragma unroll
    for (int T = 0; T < 5; ++T)
#pragma unroll
        for (int u = 0; u < 2; ++u) {
            v4u pw; pw.x = pk2(acc[T][8 * u + 0], acc[T][8 * u + 1]); pw.y = pk2(acc[T][8 * u + 2], acc[T][8 * u + 3]); pw.z = pk2(acc[T][8 * u + 4], acc[T][8 * u + 5]); pw.w = pk2(acc[T][8 * u + 6], acc[T][8 * u + 7]);
            const bf16x8 pb = __builtin_bit_cast(bf16x8, pw);
            const int kbase = 32 * wave + 32 * T + 16 * u;
#pragma unroll
            for (int dt = 0; dt < 2; ++dt) {
                const LAS unsigned char* aa = vb + dt * (384 * 64) + (kbase >> 3) * 512;
                const bf16x8 va = cat8(vtr(aa), vtr(aa + 512));
                o[dt] = __builtin_amdgcn_mfma_f32_32x32x16_bf16(va, pb, o[dt], 0, 0, 0);
            }
        }
    const float inv = 1.f / lsum;
    const size_t row = (size_t)b * SEQ + (size_t)(ql * d + r);
    bf16* op = F.ATTO + ((size_t)cfg * MTOK + row) * (AH * AD) + h * AD;
#pragma unroll
    for (int dt = 0; dt < 2; ++dt)
#pragma unroll
        for (int g = 0; g < 4; ++g) { v2u w; w.x = pk2(o[dt][4 * g] * inv, o[dt][4 * g + 1] * inv); w.y = pk2(o[dt][4 * g + 2] * inv, o[dt][4 * g + 3] * inv);
            *(v2u*)(op + 32 * dt + 8 * g + 4 * hi) = w; }
    if (hi == 0) F.LSE[((size_t)cfg * MTOK + row) * AH + h] = mx + __builtin_amdgcn_logf(lsum);
}
__device__ __forceinline__ void kv_unit(Frame& F, int b, int h, int n) {
    const int tid = F.tid, wave = F.wave; int lane = F.lane; asm volatile("" : "+v"(lane));
    const int hi = lane >> 5;
    const float lgf = lg2_sigmoid(F.dec_f[h]), lgb = lg2_sigmoid(F.dec_b[h]);
    const size_t row0 = (size_t)b * SEQ + (size_t)n * CHK;
    LAS unsigned char* Vl = F.lds;
    LAS unsigned char* Kl = F.lds + 32768;
#pragma unroll
    for (int p = 0; p < 4; ++p) { const int idx = p * 512 + tid, key = idx >> 4, ch = idx & 15;
        const v4u val = *(const v4u*)(F.PROJ + (row0 + key) * NPROJ + C_RV + h * RV + ch * 8);
        *(LAS v4u*)(Vl + (ch >> 2) * (128 * 64) + (key >> 3) * 512 + (key & 7) * 64 + (ch & 3) * 16) = val; }
#pragma unroll
    for (int p = 0; p < 2; ++p) { const int idx = p * 512 + tid, key = idx >> 3, ch = idx & 7;
        const v4u val = *(const v4u*)(F.PROJ + (row0 + key) * NPROJ + C_RK + h * RQK + ch * 8);
        const float sf = ex2(lgf * (float)(127 - key)), sb = ex2(lgb * (float)key);
        v4u wf, wb;
        wf.x = pk2(bflo(val.x) * sf, bfhi(val.x) * sf); wf.y = pk2(bflo(val.y) * sf, bfhi(val.y) * sf); wf.z = pk2(bflo(val.z) * sf, bfhi(val.z) * sf); wf.w = pk2(bflo(val.w) * sf, bfhi(val.w) * sf);
        wb.x = pk2(bflo(val.x) * sb, bfhi(val.x) * sb); wb.y = pk2(bflo(val.y) * sb, bfhi(val.y) * sb); wb.z = pk2(bflo(val.z) * sb, bfhi(val.z) * sb); wb.w = pk2(bflo(val.w) * sb, bfhi(val.w) * sb);
        const int off = (ch >> 2) * (128 * 64) + (key >> 3) * 512 + (key & 7) * 64 + (ch & 3) * 16;
        *(LAS v4u*)(Kl + off) = wf; *(LAS v4u*)(Kl + 16384 + off) = wb; }
    __syncthreads();
    const int dir = wave >> 2, dvt = wave & 3;
    const int lofs = ((lane >> 4) & 1) * 32 + (lane & 3) * 8 + (4 * hi + ((lane & 15) >> 2)) * 64;
    const LAS unsigned char* va = Vl + dvt * (128 * 64) + lofs;
    float* kvout = F.KV + ((size_t)(((b * RH + h) * 2 + dir) * NCH + n)) * (RV * RQK);
#pragma unroll
    for (int dkt = 0; dkt < 2; ++dkt) {
        const LAS unsigned char* ka = Kl + dir * 16384 + dkt * (128 * 64) + lofs;
        f32x16 a = {};
#pragma unroll
        for (int s = 0; s < 8; ++s) {
            const bf16x8 A = cat8(vtr(va + s * 1024), vtr(va + s * 1024 + 512));
            const bf16x8 B = cat8(vtr(ka + s * 1024), vtr(ka + s * 1024 + 512));
            a = __builtin_amdgcn_mfma_f32_32x32x16_bf16(A, B, a, 0, 0, 0);
        }
#pragma unroll
        for (int rr = 0; rr < 16; ++rr) kvout[(32 * dvt + crow(rr, hi)) * RQK + 32 * dkt + (lane & 31)] = a[rr];
    }
    __syncthreads();
}
__device__ __forceinline__ void phase_p2(Frame& F) {
    constexpr int NATT = BATCH * AH * 3 * (SEQ / 256);
    if (F.vcu < NATT) {
        v4u kr[6], vr[6];
        attn_prefetch(F, attn_decode(F.vcu), kr, vr);
        for (int u = F.vcu; u < NATT; u += F.G) {
            attn_stage(F, kr, vr);
            __syncthreads();
            if (u + F.G < NATT) attn_prefetch(F, attn_decode(u + F.G), kr, vr);
            attn_compute(F, attn_decode(u));
            __syncthreads();
        }
    }
    constexpr int NKV = BATCH * RH * NCH;
    for (int u = F.vcu; u < NKV; u += F.G) kv_unit(F, u >> 8, (u >> 6) & 3, u & 63);
}
__device__ __forceinline__ void phase_p3(Frame& F) {
    for (int g = F.vcu * (NWAVES * 64) + F.tid; g < BATCH * RH * 2 * (RV * RQK); g += F.G * NWAVES * 64) {
        const int bhd = g >> 13, e = g & 8191, dir = bhd & 1, h = (bhd >> 1) & 3;
        const float lam = ex2(128.f * lg2_sigmoid(dir ? F.dec_b[h] : F.dec_f[h]));
        const float* kv = F.KV + (size_t)bhd * NCH * 8192 + e; bf16* pv = F.PREV + (size_t)bhd * NCH * 8192 + e;
        float st = 0.f;
        for (int n0 = 0; n0 < NCH; n0 += 8) {
            float v[8];
#pragma unroll
            for (int k = 0; k < 8; ++k) { const int n = dir ? (NCH - 1 - (n0 + k)) : (n0 + k); v[k] = kv[(size_t)n * 8192]; }
#pragma unroll
            for (int k = 0; k < 8; ++k) { const int n = dir ? (NCH - 1 - (n0 + k)) : (n0 + k); pv[(size_t)n * 8192] = (bf16)(pk2(st, 0.f) & 0xffffu); st = lam * st + v[k]; }
        }
    }
    const int gw = F.vcu * NWAVES + F.wave, NGW = F.G * NWAVES;
    constexpr int RB = 4;
    for (int m0 = gw; m0 < MTOK; m0 += RB * NGW) {
        v4u a[RB][3]; float l[RB][3];
#pragma unroll
        for (int q = 0; q < RB; ++q) { const int mm = m0 + q * NGW; const size_t m = mm < MTOK ? mm : m0;
#pragma unroll
            for (int c = 0; c < 3; ++c) { a[q][c] = *(const v4u*)(F.ATTO + ((size_t)c * MTOK + m) * 512 + F.lane * 8); l[q][c] = F.LSE[((size_t)c * MTOK + m) * AH + (F.lane >> 3)]; } }
#pragma unroll
        for (int q = 0; q < RB; ++q) { const int m = m0 + q * NGW; if (m >= MTOK) break;
            const float mx = fmaxf(l[q][0], fmaxf(l[q][1], l[q][2])); float w0 = ex2(l[q][0] - mx), w1 = ex2(l[q][1] - mx), w2 = ex2(l[q][2] - mx); const float inv = 1.f / (w0 + w1 + w2); w0 *= inv; w1 *= inv; w2 *= inv;
            const v4u x = a[q][0], y = a[q][1], z = a[q][2]; v4u o;
            o.x = pk2(w0 * bflo(x.x) + w1 * bflo(y.x) + w2 * bflo(z.x), w0 * bfhi(x.x) + w1 * bfhi(y.x) + w2 * bfhi(z.x));
            o.y = pk2(w0 * bflo(x.y) + w1 * bflo(y.y) + w2 * bflo(z.y), w0 * bfhi(x.y) + w1 * bfhi(y.y) + w2 * bfhi(z.y));
            o.z = pk2(w0 * bflo(x.z) + w1 * bflo(y.z) + w2 * bflo(z.z), w0 * bfhi(x.z) + w1 * bfhi(y.z) + w2 * bfhi(z.z));
            o.w = pk2(w0 * bflo(x.w) + w1 * bflo(y.w) + w2 * bflo(z.w), w0 * bfhi(x.w) + w1 * bfhi(y.w) + w2 * bfhi(z.w));
            *(v4u*)(F.Y + (size_t)m * DM + 512 + F.lane * 8) = o; }
    }
}
__device__ __forceinline__ bf16x8 scale8(bf16x8 q, float s) {
    const v4u w = __builtin_bit_cast(v4u, q); v4u o;
    o.x = pk2(bflo(w.x) * s, bfhi(w.x) * s); o.y = pk2(bflo(w.y) * s, bfhi(w.y) * s); o.z = pk2(bflo(w.z) * s, bfhi(w.z) * s); o.w = pk2(bflo(w.w) * s, bfhi(w.w) * s);
    return __builtin_bit_cast(bf16x8, o);
}
__device__ __forceinline__ void ret_pair(Frame& F, int pair) {
    const int tid = F.tid, wave = F.wave; int lane = F.lane; asm volatile("" : "+v"(lane));
    const int i = lane & 31, hi = lane >> 5, grp = wave >> 2, w4 = wave & 3;
    const int cid = 2 * pair + grp, n = cid & 63, h = (cid >> 6) & 3, b = cid >> 8;
    const float lgf = lg2_sigmoid(F.dec_f[h]), lgb = lg2_sigmoid(F.dec_b[h]);
    const size_t row0 = (size_t)b * SEQ + (size_t)n * CHK;
    LAS unsigned char* Vl = F.lds + grp * 65536;
    LAS unsigned char* Pl = Vl + 32768;
    const int qi = 32 * w4 + i; const size_t qrow = row0 + qi;
    {
        const int t4 = tid & 255;
        v4u vreg[8], preg[8];
#pragma unroll
        for (int p = 0; p < 8; ++p) { const int idx = p * 256 + t4, key = idx >> 4, ch = idx & 15;
            vreg[p] = *(const v4u*)(F.PROJ + (row0 + key) * NPROJ + C_RV + h * RV + ch * 8); }
        const bf16* pf = F.PREV + ((size_t)(((b * RH + h) * 2 + 0) * NCH + n)) * (RV * RQK);
        const bf16* pb_ = F.PREV + ((size_t)(((b * RH + h) * 2 + 1) * NCH + n)) * (RV * RQK);
#pragma unroll
        for (int p = 0; p < 4; ++p) { const int idx = p * 256 + t4;
            preg[p] = *(const v4u*)(pf + (size_t)idx * 8); preg[4 + p] = *(const v4u*)(pb_ + (size_t)idx * 8); }
#pragma unroll
        for (int p = 0; p < 8; ++p) { const int idx = p * 256 + t4, key = idx >> 4, ch = idx & 15;
            *(LAS v4u*)(Vl + (ch >> 2) * (128 * 64) + (key >> 3) * 512 + (key & 7) * 64 + (ch & 3) * 16) = vreg[p]; }
#pragma unroll
        for (int p = 0; p < 4; ++p) { const int idx = p * 256 + t4, rw = idx >> 3, ch = idx & 7; const int off = rw * 128 + ((ch ^ (rw & 7)) << 4);
            *(LAS v4u*)(Pl + off) = preg[p]; *(LAS v4u*)(Pl + 16384 + off) = preg[4 + p]; }
    }
    bf16x8 qf[4];
    { const bf16* qp = F.PROJ + qrow * NPROJ + C_RQ + h * RQK + hi * 8;
#pragma unroll
      for (int s = 0; s < 4; ++s) qf[s] = *(const bf16x8*)(qp + 16 * s); }
    f32x16 acc[4];
    bf16x8 kf[2][4];
#define RET_LOADK(T, buf) do { const bf16* kp_ = F.PROJ + (row0 + 32 * (T) + i) * NPROJ + C_RK + h * RQK + hi * 8; \
        _Pragma("unroll") for (int s_ = 0; s_ < 4; ++s_) kf[buf][s_] = *(const bf16x8*)(kp_ + 16 * s_); } while (0)
    RET_LOADK(0, 0);
    v2u gw[4][4];
    { const bf16* gp = F.PROJ + qrow * NPROJ + C_RG + h * RV + 4 * hi;
#pragma unroll
      for (int dvt = 0; dvt < 4; ++dvt)
#pragma unroll
          for (int g = 0; g < 4; ++g) gw[dvt][g] = *(const v2u*)(gp + 32 * dvt + 8 * g); }
    __syncthreads();
#pragma unroll
    for (int T = 0; T < 4; ++T) {
        if (T + 1 < 4) RET_LOADK(T + 1, (T + 1) & 1);
        asm volatile("" ::: "memory");
        f32x16 a = {};
#pragma unroll
        for (int s = 0; s < 4; ++s) a = __builtin_amdgcn_mfma_f32_32x32x16_bf16(kf[T & 1][s], qf[s], a, 0, 0, 0);
        acc[T] = a;
    }
#undef RET_LOADK
#pragma unroll
    for (int T = 0; T < 4; ++T)
#pragma unroll
        for (int rr = 0; rr < 16; ++rr) { const int rel = qi - (32 * T + crow(rr, hi)); const float e = rel >= 0 ? lgf * (float)rel : -lgb * (float)rel; acc[T][rr] *= ex2(e); }
    f32x16 o[4]; o[0] = f32x16{}; o[1] = f32x16{}; o[2] = f32x16{}; o[3] = f32x16{};
    const LAS unsigned char* vb = Vl + ((lane >> 4) & 1) * 32 + (lane & 3) * 8 + (4 * hi + ((lane & 15) >> 2)) * 64;
#pragma unroll
    for (int T = 0; T < 4; ++T)
#pragma unroll
        for (int u = 0; u < 2; ++u) {
            v4u pw; pw.x = pk2(acc[T][8 * u + 0], acc[T][8 * u + 1]); pw.y = pk2(acc[T][8 * u + 2], acc[T][8 * u + 3]); pw.z = pk2(acc[T][8 * u + 4], acc[T][8 * u + 5]); pw.w = pk2(acc[T][8 * u + 6], acc[T][8 * u + 7]);
            const bf16x8 pb = __builtin_bit_cast(bf16x8, pw);
#pragma unroll
            for (int dvt = 0; dvt < 4; ++dvt) {
                const LAS unsigned char* a = vb + dvt * (128 * 64) + (4 * T + 2 * u) * 512;
                o[dvt] = __builtin_amdgcn_mfma_f32_32x32x16_bf16(cat8(vtr(a), vtr(a + 512)), pb, o[dvt], 0, 0, 0);
            }
            asm volatile("" ::: "memory");
        }
    {
        const float sf = ex2(lgf * (float)(qi + 1)), sb = ex2(lgb * (float)(CHK - qi));
#pragma unroll
        for (int s = 0; s < 4; ++s) {
            const bf16x8 qs_f = scale8(qf[s], sf), qs_b = scale8(qf[s], sb);
#pragma unroll
            for (int dvt = 0; dvt < 4; ++dvt) { const int rw = 32 * dvt + i; const int off = rw * 128 + (((2 * s + hi) ^ (rw & 7)) << 4);
                const bf16x8 af = *(const LAS bf16x8*)(Pl + off), ab = *(const LAS bf16x8*)(Pl + 16384 + off);
                o[dvt] = __builtin_amdgcn_mfma_f32_32x32x16_bf16(af, qs_f, o[dvt], 0, 0, 0);
                o[dvt] = __builtin_amdgcn_mfma_f32_32x32x16_bf16(ab, qs_b, o[dvt], 0, 0, 0);
            }
            asm volatile("" ::: "memory");
        }
    }
    float s1 = 0.f;
#pragma unroll
    for (int dvt = 0; dvt < 4; ++dvt)
#pragma unroll
        for (int rr = 0; rr < 16; ++rr) s1 += o[dvt][rr];
    s1 += __shfl_xor(s1, 32); const float mean = s1 * (1.f / RV);
    float s2 = 0.f;
#pragma unroll
    for (int dvt = 0; dvt < 4; ++dvt)
#pragma unroll
        for (int rr = 0; rr < 16; ++rr) { const float dlt = o[dvt][rr] - mean; s2 += dlt * dlt; }
    s2 += __shfl_xor(s2, 32); const float rstd = 1.f / sqrtf(s2 * (1.f / RV) + GN_EPS);
    bf16* yp = F.Y + qrow * DM + h * RV;
#pragma unroll
    for (int dvt = 0; dvt < 4; ++dvt)
#pragma unroll
        for (int g = 0; g < 4; ++g) { const int dv = 32 * dvt + 8 * g + 4 * hi; const v2u gwv = gw[dvt][g];
            float gv[4] = {bflo(gwv.x), bfhi(gwv.x), bflo(gwv.y), bfhi(gwv.y)}; float yv[4];
#pragma unroll
            for (int k = 0; k < 4; ++k) { const float sg = gv[k] * __builtin_amdgcn_rcpf(1.f + ex2(-gv[k] * LOG2E)); yv[k] = sg * (o[dvt][4 * g + k] - mean) * rstd; }
            v2u w; w.x = pk2(yv[0], yv[1]); w.y = pk2(yv[2], yv[3]); *(v2u*)(yp + dv) = w; }
    __syncthreads();
}
__device__ __forceinline__ void phase_p4(Frame& F) { for (int p = F.vcu; p < BATCH * RH * NCH / 2; p += F.G) ret_pair(F, p); }
constexpr int WR_PITCH = DM + 4;
__device__ __forceinline__ void phase_p6(Frame& F) {
    LAS float* wr = (LAS float*)F.lds;
    for (int idx = F.tid; idx < DM * NE; idx += NWAVES * 64) wr[(idx & 15) * WR_PITCH + (idx >> 4)] = F.w_router[idx];
    __syncthreads();
    const int gw = F.vcu * NWAVES + F.wave, NGW = F.G * NWAVES, lane = F.lane;
    constexpr int RB = 2;
    for (int m0 = gw; m0 < MTOK; m0 += RB * NGW) {
        v4u mw[RB][2]; f32x4 xv[RB][4];
#pragma unroll
        for (int q = 0; q < RB; ++q) { const int mm = m0 + q * NGW; const size_t m = mm < MTOK ? mm : m0;
#pragma unroll
            for (int j = 0; j < 2; ++j) { mw[q][j] = *(const v4u*)(F.MIXB + m * DM + 8 * lane + 512 * j);
                xv[q][2 * j] = *(const f32x4*)(F.x + m * DM + 8 * lane + 512 * j); xv[q][2 * j + 1] = *(const f32x4*)(F.x + m * DM + 8 * lane + 512 * j + 4); } }
#pragma unroll
        for (int q = 0; q < RB; ++q) { const int m = m0 + q * NGW; if (m >= MTOK) break;
            const int b = m / SEQ, spos = m % SEQ; const float* mod = F.MOD + b * 6 * DM;
            f32x4 mv[4];
#pragma unroll
            for (int j = 0; j < 2; ++j) { const v4u w = mw[q][j]; mv[2 * j] = (f32x4){bflo(w.x), bfhi(w.x), bflo(w.y), bfhi(w.y)}; mv[2 * j + 1] = (f32x4){bflo(w.z), bfhi(w.z), bflo(w.w), bfhi(w.w)}; }
            float s = 0.f;
#pragma unroll
            for (int t = 0; t < 4; ++t) s += (mv[t].x * mv[t].x + mv[t].y * mv[t].y) + (mv[t].z * mv[t].z + mv[t].w * mv[t].w);
            const float r1 = 1.f / sqrtf(wave_sum(s) * (1.f / DM) + RMS_EPS);
            float s2 = 0.f;
#pragma unroll
            for (int t = 0; t < 4; ++t) { const int c = 8 * lane + 512 * (t >> 1) + 4 * (t & 1);
                const f32x4 g = *(const f32x4*)(F.g_post_mix + c), gm = *(const f32x4*)(mod + 2 * DM + c);
                const f32x4 x1 = xv[q][t] + gm * (mv[t] * r1 * g); xv[q][t] = x1; *(f32x4*)(F.out + (size_t)m * DM + c) = x1;
                s2 += (x1.x * x1.x + x1.y * x1.y) + (x1.z * x1.z + x1.w * x1.w); }
            const float r2 = 1.f / sqrtf(wave_sum(s2) * (1.f / DM) + RMS_EPS);
            float lg[NE];
#pragma unroll
            for (int e = 0; e < NE; ++e) lg[e] = 0.f;
#pragma unroll
            for (int j = 0; j < 2; ++j) { f32x4 h[2];
#pragma unroll
                for (int u = 0; u < 2; ++u) { const int c = 8 * lane + 512 * j + 4 * u;
                    const f32x4 g = *(const f32x4*)(F.g_pre_ffn + c), sc = *(const f32x4*)(mod + 4 * DM + c), sh = *(const f32x4*)(mod + 3 * DM + c);
                    h[u] = xv[q][2 * j + u] * r2 * g * (sc + 1.f) + sh; }
                v2u w; w.x = pg8::cvt4_fp8(h[0].x, h[0].y, h[0].z, h[0].w); w.y = pg8::cvt4_fp8(h[1].x, h[1].y, h[1].z, h[1].w);
                *(v2u*)((unsigned char*)F.XN + (size_t)m * DM + 8 * lane + 512 * j) = w;
#pragma unroll
                for (int e = 0; e < NE; ++e) { const LAS float* wp = wr + e * WR_PITCH + 8 * lane + 512 * j; const f32x4 w0 = *(const LAS f32x4*)wp, w1 = *(const LAS f32x4*)(wp + 4);
                    lg[e] += ((h[0].x * w0.x + h[0].y * w0.y) + (h[0].z * w0.z + h[0].w * w0.w)) + ((h[1].x * w1.x + h[1].y * w1.y) + (h[1].z * w1.z + h[1].w * w1.w)); }
                asm volatile("" ::: "memory"); }
            float mxl = -3.0e38f;
#pragma unroll
            for (int e = 0; e < NE; ++e) { lg[e] = wave_sum(lg[e]); mxl = fmaxf(mxl, lg[e]); }
            float den = 0.f;
#pragma unroll
            for (int e = 0; e < NE; ++e) { lg[e] = __expf(lg[e] - mxl); den += lg[e]; }
            const float invd = 1.f / den; float mine = 0.f;
#pragma unroll
            for (int e = 0; e < NE; ++e) mine = (lane == e) ? lg[e] * invd : mine;
            if (lane < NE) F.AFF[((size_t)b * NE + lane) * SEQ + spos] = mine; }
    }
}
__device__ __forceinline__ int block_excl_scan(int v, LAS int* wsum, int tid, int lane, int wave, int& total) {
    int inc = v;
#pragma unroll
    for (int o = 1; o < 64; o <<= 1) { const int t = __shfl_up(inc, o); if (lane >= o) inc += t; }
    __syncthreads();
    if (lane == 63) wsum[wave] = inc;
    __syncthreads();
    int base = 0, tot = 0;
#pragma unroll
    for (int w = 0; w < NWAVES; ++w) { const int t = wsum[w]; if (w < wave) base += t; tot += t; }
    total = tot; (void)tid;
    return base + inc - v;
}
__device__ __forceinline__ void phase_p7(Frame& F) {
    if (F.vcu >= BATCH * NE) return;
    const int be = F.vcu, b = be / NE, e = be % NE, tid = F.tid;
    LAS int* hist = (LAS int*)F.lds; LAS int* wsum = hist + 256; LAS int* bc = hist + 272;
    const float* a = F.AFF + (size_t)be * SEQ;
    unsigned v[16];
#pragma unroll
    for (int q = 0; q < 4; ++q) { const v4u t = *(const v4u*)(a + tid * 16 + q * 4); v[4 * q] = t.x; v[4 * q + 1] = t.y; v[4 * q + 2] = t.z; v[4 * q + 3] = t.w; }
    unsigned prefix = 0u; int kk = CAP;
#pragma unroll 1
    for (int pass = 0; pass < 4; ++pass) {
        const int shift = 24 - 8 * pass; const unsigned hmask = (pass == 0) ? 0u : (0xffffffffu << (shift + 8));
        if (tid < 256) hist[tid] = 0;
        __syncthreads();
#pragma unroll
        for (int q = 0; q < 16; ++q) { if (((v[q] ^ prefix) & hmask) == 0u) __hip_atomic_fetch_add(&hist[(v[q] >> shift) & 255u], 1, __ATOMIC_RELAXED, __HIP_MEMORY_SCOPE_WORKGROUP); }
        __syncthreads();
        {
            const int hc = (tid < 256) ? hist[255 - tid] : 0; int tot_;
            const int excl = block_excl_scan(hc, wsum, tid, F.lane, F.wave, tot_);
            if (tid < 256 && excl < kk && kk <= excl + hc) { bc[0] = 255 - tid; bc[1] = kk - excl; }
        }
        __syncthreads();
        prefix |= (unsigned)bc[0] << shift; kk = bc[1];
        __syncthreads();
    }
    int ceq = 0;
#pragma unroll
    for (int q = 0; q < 16; ++q) ceq += (v[q] == prefix) ? 1 : 0;
    int tot; int eqbase = block_excl_scan(ceq, wsum, tid, F.lane, F.wave, tot);
    unsigned selmask = 0u; int csel = 0;
#pragma unroll
    for (int q = 0; q < 16; ++q) { bool s = v[q] > prefix; if (v[q] == prefix) { s = eqbase < kk; ++eqbase; } if (s) { selmask |= 1u << q; ++csel; } }
    __syncthreads();
    int slot = block_excl_scan(csel, wsum, tid, F.lane, F.wave, tot);
    const int rowbase = (e * BATCH + b) * CAP;
#pragma unroll
    for (int q = 0; q < 16; ++q) { const int tok = b * SEQ + tid * 16 + q; int so = -1;
        if (selmask & (1u << q)) { const int row = rowbase + (slot < CAP ? slot : CAP - 1); so = row; F.TOK[row] = tok; F.GATEV[row] = __uint_as_float(v[q]); ++slot; }
        F.SLOTOF[(size_t)tok * NE + e] = so; }
}
__device__ __forceinline__ void phase_p7b(Frame& F) {
    const int gw = F.vcu * NWAVES + F.wave, NGW = F.G * NWAVES;
    for (int r = gw; r < NSLOT; r += NGW) { const int t = F.TOK[r];
        const v4u* src = (const v4u*)(F.XN + (size_t)t * DM) + F.lane; v4u* dst = (v4u*)(F.XE + (size_t)r * DM) + F.lane;
        const v4u a = src[0], c = src[64]; dst[0] = a; dst[64] = c; }
}
__device__ __forceinline__ void phase_p10(Frame& F) {
    const int gw = F.vcu * NWAVES + F.wave, NGW = F.G * NWAVES, lane = F.lane;
    constexpr int RB = 2;
    for (int m0 = gw; m0 < MTOK; m0 += RB * NGW) {
        float acc[RB][16]; int myslot[RB]; f32x4 x1[RB][4];
#pragma unroll
        for (int q = 0; q < RB; ++q) { const int mm = m0 + q * NGW; const size_t m = mm < MTOK ? mm : m0;
            myslot[q] = (lane < NE) ? F.SLOTOF[m * NE + lane] : -1;
#pragma unroll
            for (int t = 0; t < 4; ++t) x1[q][t] = *(const f32x4*)(F.out + m * DM + 8 * lane + 512 * (t >> 1) + 4 * (t & 1));
#pragma unroll
            for (int k = 0; k < 16; ++k) acc[q][k] = 0.f; }
#pragma unroll 1
        for (int e = 0; e < NE; ++e) {
#pragma unroll
            for (int q = 0; q < RB; ++q) { const int r = __builtin_amdgcn_readlane(myslot[q], e);
                if (r >= 0) { const float g = F.GATEV[r]; const v4u* yr = (const v4u*)(F.YE + (size_t)r * DM) + lane;
#pragma unroll
                    for (int j = 0; j < 2; ++j) { const v4u w = yr[64 * j];
                        acc[q][8 * j + 0] += g * bflo(w.x); acc[q][8 * j + 1] += g * bfhi(w.x); acc[q][8 * j + 2] += g * bflo(w.y); acc[q][8 * j + 3] += g * bfhi(w.y);
                        acc[q][8 * j + 4] += g * bflo(w.z); acc[q][8 * j + 5] += g * bfhi(w.z); acc[q][8 * j + 6] += g * bflo(w.w); acc[q][8 * j + 7] += g * bfhi(w.w); } } } }
#pragma unroll
        for (int q = 0; q < RB; ++q) { const int m = m0 + q * NGW; if (m >= MTOK) break;
            const float* mod = F.MOD + (m / SEQ) * 6 * DM;
            float s = 0.f;
#pragma unroll
            for (int k = 0; k < 16; ++k) s += acc[q][k] * acc[q][k];
            const float rr = 1.f / sqrtf(wave_sum(s) * (1.f / DM) + RMS_EPS);
            float* orow = F.out + (size_t)m * DM;
#pragma unroll
            for (int t = 0; t < 4; ++t) { const int c = 8 * lane + 512 * (t >> 1) + 4 * (t & 1);
                const f32x4 g = *(const f32x4*)(F.g_post_ffn + c), gf = *(const f32x4*)(mod + 5 * DM + c);
                f32x4 a; a.x = acc[q][4 * t]; a.y = acc[q][4 * t + 1]; a.z = acc[q][4 * t + 2]; a.w = acc[q][4 * t + 3];
                *(f32x4*)(orow + c) = x1[q][t] + gf * (a * rr * g); } }
    }
}
struct Args { const float* in[16]; float* out; unsigned char* ws; int ph_lo, ph_hi; };
__global__ void __launch_bounds__(NWAVES * 64, 2) mk_fwd(Args args) {
    extern __shared__ __attribute__((aligned(16))) unsigned char lds[];
    Frame F;
    F.lds = (LAS unsigned char*)lds;
    F.MISC = (volatile LAS unsigned*)(F.lds + MISC_OFF);
    F.tid = threadIdx.x; F.lane = F.tid & 63; F.wave = __builtin_amdgcn_readfirstlane(F.tid >> 6);
    F.G = gridDim.x; { const int bx = blockIdx.x; F.vcu = (F.G % 8 == 0) ? (bx % 8) * (F.G / 8) + bx / 8 : bx; }
    unsigned char* ws = args.ws;
    F.ctl = (gu32*)(ws + WS_CTL);
    F.x = args.in[0]; F.c = args.in[1]; F.w_ada = args.in[2]; F.b_ada = args.in[3]; F.g_pre_mix = args.in[4]; F.g_post_mix = args.in[5]; F.g_pre_ffn = args.in[6]; F.g_post_ffn = args.in[7];
    F.w_in = args.in[8]; F.dec_f = args.in[9]; F.dec_b = args.in[10]; F.w_out = args.in[11]; F.w_router = args.in[12]; F.w_gate = args.in[13]; F.w_up = args.in[14]; F.w_down = args.in[15];
    F.out = args.out;
    F.MOD = (float*)(ws + WS_MOD); F.AFF = (float*)(ws + WS_AFF); F.GATEV = (float*)(ws + WS_GATEV); F.LSE = (float*)(ws + WS_LSE); F.KV = (float*)(ws + WS_KV); F.MIXED = (float*)(ws + WS_MIXED);
    F.TOK = (int*)(ws + WS_TOK); F.SLOTOF = (int*)(ws + WS_SLOTOF);
    F.WIN = (bf16*)(ws + WS_WIN); F.WOUT = (bf16*)(ws + WS_WOUT); F.WGU = (bf16*)(ws + WS_WGU); F.WDN = (bf16*)(ws + WS_WDN); F.XN = (bf16*)(ws + WS_XN); F.PROJ = (bf16*)(ws + WS_PROJ);
    F.PREV = (bf16*)(ws + WS_PREV); F.ATTO = (bf16*)(ws + WS_ATTO); F.Y = (bf16*)(ws + WS_Y); F.XE = (bf16*)(ws + WS_XE); F.HH = (bf16*)(ws + WS_HH); F.YE = (bf16*)(ws + WS_YE); F.MIXB = (bf16*)(ws + WS_MIXED);
    for (int u = F.tid; u < (LDS_BYTES - LDSCTL_OFF) / 4; u += NWAVES * 64) ((LAS unsigned*)(F.lds + LDSCTL_OFF))[u] = 0u;
    __syncthreads();
    const int lo = args.ph_lo, hi = args.ph_hi;
    XcdBarrier bar; bar.bar = (unsigned*)(F.ctl + CW_BAR); bar.x = 0; bar.st = nullptr;
    if (hi - lo > 1) bar = xcd_barrier_post((unsigned*)(F.ctl + CW_BAR), F.MISC + 8);
#ifndef PHASE_MASK
#define PHASE_MASK 0xffff
#endif
#define IN(k) (((PHASE_MASK >> (k)) & 1) && lo <= (k) && (k) < hi)
#ifndef REP_MASK
#define REP_MASK 0
#endif
#define NREP(k) ((((REP_MASK) >> (k)) & 1) ? 2 : 1)
#define SEAM(k) do { if (IN(k) && IN((k) + 1)) xcd_barrier(bar); } while (0)
    if (IN(0)) for (int rep_ = 0; rep_ < NREP(0); ++rep_) { phase_p0a(F); } SEAM(0);
    if (IN(1)) for (int rep_ = 0; rep_ < NREP(1); ++rep_) { phase_p0b(F); } SEAM(1);
    if (IN(2)) for (int rep_ = 0; rep_ < NREP(2); ++rep_) {
        pg8::Gemm g{F.XN, F.WIN, MTOK, NPROJ, DM}; pg8::StaticOrder S; S.init(MTOK, NPROJ, F.G, (int)blockIdx.x);
        pg8::EpiBf16S E{F.PROJ, NPROJ, 0xffff, 0.125f, 0.125f * LOG2E, 1};
        pg8::gemm_phase<pg8::EpiBf16S, pg8::StaticOrder, true, true>(F.lds, g, S, E);
    } SEAM(2);
    if (IN(3)) for (int rep_ = 0; rep_ < NREP(3); ++rep_) { phase_p2(F); } SEAM(3);
    if (IN(4)) for (int rep_ = 0; rep_ < NREP(4); ++rep_) { phase_p3(F); } SEAM(4);
    if (IN(5)) for (int rep_ = 0; rep_ < NREP(5); ++rep_) { phase_p4(F); } SEAM(5);
    if (IN(6)) for (int rep_ = 0; rep_ < NREP(6); ++rep_) {
        pg8::Gemm g{F.Y, F.WOUT, MTOK, DM, DM}; pg8::StaticOrder S; S.init(MTOK, DM, F.G, (int)blockIdx.x);
        pg8::EpiBf16S E{F.MIXB, DM, 0xffff, 1.f, 1.f, 0};
        pg8::gemm_phase<pg8::EpiBf16S, pg8::StaticOrder, true, true>(F.lds, g, S, E);
    } SEAM(6);
    if (IN(7)) for (int rep_ = 0; rep_ < NREP(7); ++rep_) { phase_p6(F); } SEAM(7);
    if (IN(8)) for (int rep_ = 0; rep_ < NREP(8); ++rep_) { phase_p7(F); } if (IN(8) && IN(10)) xcd_barrier(bar);
    if (IN(10)) for (int rep_ = 0; rep_ < NREP(10); ++rep_) {
        pg8::Gemm g{F.XN, F.WGU, NSLOT, NE * 2 * FF, DM / 2}; pg8::MoeOrder S{16, F.G, F.vcu};
        pg8::EpiSwiGLU8 E{(unsigned char*)F.HH, FF};
        pg8::gemm_phase<pg8::EpiSwiGLU8, pg8::MoeOrder, true, true, true, true>(F.lds, g, S, E, F.TOK, (LAS int*)(F.lds + MISC_OFF + 256), 0x7a7a7a7a, 0x7f7f7f7f);
    } SEAM(10);
    if (IN(11)) for (int rep_ = 0; rep_ < NREP(11); ++rep_) {
        pg8::Gemm g{F.HH, F.WDN, NSLOT, NE * DM, FF / 2}; pg8::MoeOrder S{4, F.G, F.vcu};
        pg8::EpiBf16S E{F.YE, DM, 3, 1.f, 1.f, 0};
        pg8::gemm_phase<pg8::EpiBf16S, pg8::MoeOrder, true, true, false, true>(F.lds, g, S, E, nullptr, nullptr, 0x7a7a7a7a, 0x7f7f7f7f);
    } SEAM(11);
    if (IN(12)) for (int rep_ = 0; rep_ < NREP(12); ++rep_) { phase_p10(F); }
#undef IN
#undef SEAM
}

extern "C" void kernel_launch(void* const* d_in, const int* in_sizes, int n_in, void* d_out, int out_size, void* d_ws, size_t ws_size, hipStream_t stream) {
    static int grid = 0;
    if (grid == 0) {
        if (n_in != 16 || in_sizes[0] != MTOK * DM || out_size != MTOK * DM || ws_size < WS_END) { fprintf(stderr, "kernel_launch: unexpected shapes: n_in %d in0 %d out %d ws %zu (need %zu)\n", n_in, n_in > 0 ? in_sizes[0] : -1, out_size, ws_size, (size_t)WS_END); grid = -1; return; }
        int dev = 0, cus = 0;
        if (hipGetDevice(&dev) != hipSuccess || hipDeviceGetAttribute(&cus, hipDeviceAttributeMultiprocessorCount, dev) != hipSuccess) { grid = -1; return; }
        if (hipFuncSetAttribute((const void*)mk_fwd, hipFuncAttributeMaxDynamicSharedMemorySize, LDS_BYTES) != hipSuccess) { fprintf(stderr, "kernel_launch: hipFuncSetAttribute failed\n"); grid = -1; return; }
        int per_cu = 0;
        if (hipOccupancyMaxActiveBlocksPerMultiprocessor(&per_cu, (const void*)mk_fwd, NWAVES * 64, LDS_BYTES) != hipSuccess || per_cu < 1) fprintf(stderr, "kernel_launch: occupancy query says %d blocks per CU\n", per_cu);
        (void)hipGetLastError();
        grid = cus;
    }
    if (grid < 0) return;
    (void)hipMemsetAsync((char*)d_ws + WS_CTL, 0, CTL_ZERO_BYTES, stream);
    Args a{};
    for (int i = 0; i < 16; ++i) a.in[i] = (const float*)d_in[i];
    a.out = (float*)d_out; a.ws = (unsigned char*)d_ws;
#if MK_ONE_LAUNCH
    a.ph_lo = 0; a.ph_hi = NPHASE;
    hipLaunchKernelGGL(mk_fwd, dim3(grid), dim3(NWAVES * 64), LDS_BYTES, stream, a);
#else
    for (int p = 0; p < NPHASE; ++p) { a.ph_lo = p; a.ph_hi = p + 1; hipLaunchKernelGGL(mk_fwd, dim3(grid), dim3(NWAVES * 64), LDS_BYTES, stream, a); }
#endif
}
```

```cpp
#include <hip/hip_runtime.h>
#include <cstdio>
#include <cstdint>
namespace pg8 {
#define PG8_LAS __attribute__((address_space(3)))
typedef unsigned short bf16_t;
typedef short bf16x8 __attribute__((ext_vector_type(8)));
typedef float f32x4 __attribute__((ext_vector_type(4)));
typedef unsigned u32x4 __attribute__((ext_vector_type(4)));
constexpr int BM = 256, BK = 64, HALF = 128, HTB = HALF * BK * 2  , STAGE_BYTES = 8 * HTB, NXCD = 8, WGM = 8;

__host__ __device__ __forceinline__ int lds_byte(int r, int c) { const int st = (r >> 4) * 2 + (c >> 5), rr = r & 15, cc = c & 31, ob = rr * 64 + cc * 2; return st * 1024 + (ob ^ (((ob >> 9) & 1) << 5)); }
__host__ __device__ __forceinline__ void stage_rc(int b, int& R, int& C) { const int st = b / 1024, sb = b % 1024, swz = sb ^ (((sb >> 9) & 1) << 5); R = (st >> 1) * 16 + swz / 64; C = (st & 1) * 32 + (swz % 64) / 2; }
__host__ __device__ __forceinline__ int perm32(int rho) { const int n = rho >> 4, i = rho & 15; return 8 * (i >> 2) + 4 * n + (i & 3); }

struct Unit { int pm, pn; };
struct Gemm { const bf16_t* A; const bf16_t* Bt; int M, N, K; int bblk_rows; };

struct StaticOrder {
    int nM, nN, nwg, G, c;
    __host__ __device__ void init(int M, int N, int G_, int c_) { nM = M / BM; nN = N / BM; nwg = nM * nN; G = G_; c = c_; }
    __host__ __device__ bool next(int i, Unit& u) const {
        const long L = (long)i * G + c; if (L >= nwg) return false;
        int wgid = (int)L; { const int q = nwg / NXCD, r = nwg % NXCD, xcd = wgid % NXCD, off = wgid / NXCD; wgid = (xcd < r ? xcd * (q + 1) : r * (q + 1) + (xcd - r) * q) + off; }
        const int nig = WGM * nN, gid = wgid / nig, fm = gid * WGM, gsz = (nM - fm) < WGM ? (nM - fm) : WGM;
        u.pm = fm + ((wgid % nig) % gsz); u.pn = (wgid % nig) / gsz; return true;
    }
    __device__ __forceinline__ void a_ready(const Unit&) const {}
    __device__ __forceinline__ void done(const Unit&) const {}
};

__device__ __forceinline__ unsigned cvt_pk_bf16(float lo, float hi) { unsigned r; asm volatile("v_cvt_pk_bf16_f32 %0, %1, %2" : "=v"(r) : "v"(lo), "v"(hi)); return r; }
typedef float f32x2 __attribute__((ext_vector_type(2)));
typedef unsigned u32x2 __attribute__((ext_vector_type(2)));
__device__ __forceinline__ void st16_wt(void* p, u32x4 v) { asm volatile("global_store_dwordx4 %0, %1, off sc1\n\ts_nop 1" :: "v"(p), "v"(v) : "memory"); }
typedef int i32x4 __attribute__((ext_vector_type(4)));
typedef int i32x8 __attribute__((ext_vector_type(8)));
__device__ __forceinline__ i32x8 pg8_cat(bf16x8 lo, bf16x8 hi) { const i32x4 a = __builtin_bit_cast(i32x4, lo), b = __builtin_bit_cast(i32x4, hi); return __builtin_shufflevector(a, b, 0, 1, 2, 3, 4, 5, 6, 7); }
__device__ __forceinline__ unsigned cvt4_fp8(float a, float b, float c, float d) { unsigned w = 0u; w = __builtin_amdgcn_cvt_pk_fp8_f32(a, b, w, false); w = __builtin_amdgcn_cvt_pk_fp8_f32(c, d, w, true); return w; }
constexpr float LOG2E_F = 1.4426950408889634f;
struct EpiF32 {
    static constexpr bool PERM = false, AFTER_DRAIN = false;
    float* C; int ldc;
    __device__ __forceinline__ void operator()(const f32x4 (&acc)[2][2][4][2], const Unit& u, int wr, int wc, int fr, int fq) const {
        const int row0 = u.pm * BM + wr * 64 + fr, col0 = u.pn * BM + wc * 32 + 4 * fq;
#pragma unroll
        for (int ai = 0; ai < 2; ++ai)
#pragma unroll
            for (int m = 0; m < 4; ++m) { float* rowp = C + (size_t)(row0 + ai * HALF + m * 16) * ldc + col0;
#pragma unroll
                for (int bj = 0; bj < 2; ++bj)
#pragma unroll
                    for (int n = 0; n < 2; ++n) *(f32x4*)(rowp + bj * HALF + n * 16) = acc[ai][bj][m][n]; }
    }
};
struct EpiBf16S {
    static constexpr bool PERM = true, AFTER_DRAIN = false;
    bf16_t* O; int ldc; int pn_mask; float s_rk, s_aq; int proj;
    __device__ __forceinline__ void operator()(const f32x4 (&acc)[2][2][4][2], const Unit& u, int wr, int wc, int fr, int fq) const {
        const int pn = u.pn & pn_mask;
        const int row0 = u.pm * BM + wr * 64 + fr, col0 = pn * BM + wc * 32 + 8 * fq;
        float sc = 1.f; if (proj) sc = (pn == 1) ? s_rk : ((pn == 6 || pn == 7) ? s_aq : 1.f);
#pragma unroll
        for (int ai = 0; ai < 2; ++ai)
#pragma unroll
            for (int m = 0; m < 4; ++m) { bf16_t* rowp = O + (size_t)(row0 + ai * HALF + m * 16) * ldc + col0;
#pragma unroll
                for (int bj = 0; bj < 2; ++bj) { const f32x4 v0 = acc[ai][bj][m][0] * sc, v1 = acc[ai][bj][m][1] * sc;
                    u32x4 w; w.x = cvt_pk_bf16(v0[0], v0[1]); w.y = cvt_pk_bf16(v0[2], v0[3]); w.z = cvt_pk_bf16(v1[0], v1[1]); w.w = cvt_pk_bf16(v1[2], v1[3]);
                    *(u32x4*)(rowp + bj * HALF) = w; } }
    }
};
struct EpiSwiGLU {
    static constexpr bool PERM = true, AFTER_DRAIN = false;
    bf16_t* O; int ldc;
    __device__ __forceinline__ float act(float g, float up) const { return g * up * __builtin_amdgcn_rcpf(1.f + __builtin_amdgcn_exp2f(-g * LOG2E_F)); }
    __device__ __forceinline__ void operator()(const f32x4 (&acc)[2][2][4][2], const Unit& u, int wr, int wc, int fr, int fq) const {
        const int row0 = u.pm * BM + wr * 64 + fr, col0 = (u.pn & 15) * HALF + wc * 32 + 8 * fq;
#pragma unroll
        for (int ai = 0; ai < 2; ++ai)
#pragma unroll
            for (int m = 0; m < 4; ++m) { bf16_t* rowp = O + (size_t)(row0 + ai * HALF + m * 16) * ldc + col0;
                const f32x4 g0 = acc[ai][0][m][0], g1 = acc[ai][0][m][1], u0 = acc[ai][1][m][0], u1 = acc[ai][1][m][1];
                u32x4 w; w.x = cvt_pk_bf16(act(g0[0], u0[0]), act(g0[1], u0[1])); w.y = cvt_pk_bf16(act(g0[2], u0[2]), act(g0[3], u0[3]));
                w.z = cvt_pk_bf16(act(g1[0], u1[0]), act(g1[1], u1[1])); w.w = cvt_pk_bf16(act(g1[2], u1[2]), act(g1[3], u1[3]));
                *(u32x4*)rowp = w; }
    }
};
struct EpiFp8 {
    static constexpr bool PERM = true, AFTER_DRAIN = false;
    unsigned char* O; int ldc; int pn_mask;
    __device__ __forceinline__ void operator()(const f32x4 (&acc)[2][2][4][2], const Unit& u, int wr, int wc, int fr, int fq) const {
        const int pn = u.pn & pn_mask; const int row0 = u.pm * BM + wr * 64 + fr, col0 = pn * BM + wc * 32 + 8 * fq;
#pragma unroll
        for (int ai = 0; ai < 2; ++ai)
#pragma unroll
            for (int m = 0; m < 4; ++m) { unsigned char* rowp = O + (size_t)(row0 + ai * HALF + m * 16) * ldc + col0;
#pragma unroll
                for (int bj = 0; bj < 2; ++bj) { const f32x4 v0 = acc[ai][bj][m][0], v1 = acc[ai][bj][m][1];
                    u32x2 w; w.x = cvt4_fp8(v0[0], v0[1], v0[2], v0[3]); w.y = cvt4_fp8(v1[0], v1[1], v1[2], v1[3]); *(u32x2*)(rowp + bj * HALF) = w; } }
    }
};
struct EpiSwiGLU8 {
    static constexpr bool PERM = true, AFTER_DRAIN = false;
    unsigned char* O; int ldc;
    __device__ __forceinline__ float act(float g, float up) const { return g * up * __builtin_amdgcn_rcpf(1.f + __builtin_amdgcn_exp2f(-g * LOG2E_F)); }
    __device__ __forceinline__ void operator()(const f32x4 (&acc)[2][2][4][2], const Unit& u, int wr, int wc, int fr, int fq) const {
        const int row0 = u.pm * BM + wr * 64 + fr, col0 = (u.pn & 15) * HALF + wc * 32 + 8 * fq;
#pragma unroll
        for (int ai = 0; ai < 2; ++ai)
#pragma unroll
            for (int m = 0; m < 4; ++m) { unsigned char* rowp = O + (size_t)(row0 + ai * HALF + m * 16) * ldc + col0;
                const f32x4 g0 = acc[ai][0][m][0], g1 = acc[ai][0][m][1], u0 = acc[ai][1][m][0], u1 = acc[ai][1][m][1];
                u32x2 w; w.x = cvt4_fp8(act(g0[0], u0[0]), act(g0[1], u0[1]), act(g0[2], u0[2]), act(g0[3], u0[3]));
                w.y = cvt4_fp8(act(g1[0], u1[0]), act(g1[1], u1[1]), act(g1[2], u1[2]), act(g1[3], u1[3]));
                *(u32x2*)rowp = w; }
    }
};
struct MoeOrder {
    int ntile, G, vcu;
    __device__ __forceinline__ bool next(int i, Unit& u) const {
        const int total = 16 * 8 * ntile; int L;
        if ((G & 7) == 0) { const int g8 = G >> 3, x = vcu / g8, c = vcu % g8, share = total >> 3, l = i * g8 + c; if (l >= share) return false; L = x * share + l; }
        else { L = i * G + vcu; if (L >= total) return false; }
        const int e = L / (8 * ntile), rem = L % (8 * ntile);
        u.pm = e * 8 + (rem & 7); u.pn = e * ntile + (rem >> 3); return true;
    }
    __device__ __forceinline__ void a_ready(const Unit&) const {}
    __device__ __forceinline__ void done(const Unit&) const {}
};
template <class Epi, class Sched, bool ALIGN_EPI = false, bool SP2 = false, bool GATHER = false, bool FP8 = false>
__device__ __forceinline__ void gemm_phase(PG8_LAS unsigned char* lds, const Gemm g, const Sched& S, const Epi& E, const int* rowmap = nullptr, PG8_LAS int* ldsrow = nullptr, int scale_w = 0x7f7f7f7f, int scale_x = 0x7f7f7f7f) {
    const int tid = threadIdx.x, wid = __builtin_amdgcn_readfirstlane(tid >> 6), lane = tid & 63, wr = wid >> 2, wc = wid & 3, fr = lane & 15, fq = lane >> 4;
    const int K = g.K, nt = K / BK;
    unsigned voffA[2], voffB[2];
#pragma unroll
    for (int i = 0; i < 2; ++i) { int R, C; stage_rc(tid * 16 + i * 8192, R, C); const int Rb = Epi::PERM ? ((R & ~31) + perm32(R & 31)) : R;
        voffA[i] = (unsigned)(R * K + C) * 2u; voffB[i] = g.bblk_rows ? (unsigned)((C >> 4) * (g.bblk_rows >> 7) * 4096 + Rb * 32 + ((C >> 3) & 1) * 16) : (unsigned)(Rb * K + C) * 2u; }
    unsigned gC[2][2] = {{0u, 0u}, {0u, 0u}}, gN[2][2] = {{0u, 0u}, {0u, 0u}}; int gR[2] = {0, 0}; unsigned gCb[2] = {0u, 0u};
    if constexpr (GATHER) {
#pragma unroll
        for (int i = 0; i < 2; ++i) { int R, C; stage_rc(tid * 16 + i * 8192, R, C); gR[i] = R; gCb[i] = (unsigned)C * 2u; }
        Unit uu;
        for (int ui_ = 0; ui_ < 8; ++ui_) { if (!S.next(ui_, uu)) break; if (tid < 256) ldsrow[ui_ * 256 + tid] = rowmap[uu.pm * BM + tid]; }
        __syncthreads();
#pragma unroll
        for (int h = 0; h < 2; ++h)
#pragma unroll
            for (int i = 0; i < 2; ++i) gC[h][i] = (unsigned)ldsrow[h * HALF + gR[i]] * (unsigned)(K * 2) + gCb[i];
    }
    const size_t kstep = (size_t)(BK * 2);
    const size_t hstep = (size_t)HALF * K * 2;
    const size_t tstep = 2 * hstep;
    const size_t kstepB = g.bblk_rows ? (size_t)g.bblk_rows * 128 : kstep, hstepB = g.bblk_rows ? (size_t)4096 : hstep;
    const int ntl_ = g.bblk_rows ? g.bblk_rows / BM : 1;
#define PG8_BBASE(pn_) (g.bblk_rows ? (const char*)g.Bt + (size_t)((pn_) / ntl_) * ((size_t)g.bblk_rows * K * 2) + (size_t)((pn_) % ntl_) * 8192 : (const char*)g.Bt + (size_t)(pn_) * tstep)
    const unsigned ldsw = (unsigned)wid * 1024u;
    const int aoff = lds_byte(wr * 64 + fr, fq * 8), boff = lds_byte(wc * 32 + fr, fq * 8);
    constexpr int KINC = 1024;
#define PG8_SA(b, h) (((b) * 2 + (h)) * HTB)
#define PG8_SB(b, h) ((4 + (b) * 2 + (h)) * HTB)
#define PG8_STAGE(bufoff, gbase, voff) do { _Pragma("unroll") for (int _i = 0; _i < 2; ++_i) \
        __builtin_amdgcn_global_load_lds((const unsigned*)((const char*)(gbase) + (voff)[_i]), (PG8_LAS unsigned*)(lds + (bufoff) + ldsw + _i * 8192), 16, 0, 0); } while (0)
#define PG8_STAGE_A(bufoff, isnext, half, koff) do { \
        if constexpr (GATHER) { _Pragma("unroll") for (int _i = 0; _i < 2; ++_i) { const unsigned vo_ = (isnext) ? gN[half][_i] : gC[half][_i]; \
            __builtin_amdgcn_global_load_lds((const unsigned*)((const char*)g.A + (koff) + vo_), (PG8_LAS unsigned*)(lds + (bufoff) + ldsw + _i * 8192), 16, 0, 0); } } \
        else { const char* b_ = ((isnext) ? nA : cA) + (half) * hstep + (koff); PG8_STAGE(bufoff, b_, voffA); } } while (0)
#define PG8_LD16(p) (*(const PG8_LAS i32x4*)(p))
#define PG8_LDA(dst, b, h) do { if constexpr (FP8) { _Pragma("unroll") for (int m = 0; m < 4; ++m) { const PG8_LAS unsigned char* p_ = lds + PG8_SA(b, h) + aoff + m * 2048; dst##8[m] = __builtin_shufflevector(PG8_LD16(p_), PG8_LD16(p_ + KINC), 0, 1, 2, 3, 4, 5, 6, 7); } } \
        else { _Pragma("unroll") for (int m = 0; m < 4; ++m) _Pragma("unroll") for (int k = 0; k < 2; ++k) dst[m][k] = *(const PG8_LAS bf16x8*)(lds + PG8_SA(b, h) + aoff + m * 2048 + k * 1024); } } while (0)
#define PG8_LDB(dst, b, h) do { if constexpr (FP8) { _Pragma("unroll") for (int n = 0; n < 2; ++n) { const PG8_LAS unsigned char* p_ = lds + PG8_SB(b, h) + boff + n * 2048; dst##8[n] = __builtin_shufflevector(PG8_LD16(p_), PG8_LD16(p_ + KINC), 0, 1, 2, 3, 4, 5, 6, 7); } } \
        else { _Pragma("unroll") for (int n = 0; n < 2; ++n) _Pragma("unroll") for (int k = 0; k < 2; ++k) dst[n][k] = *(const PG8_LAS bf16x8*)(lds + PG8_SB(b, h) + boff + n * 2048 + k * 1024); } } while (0)
#define PG8_MMA8(A_, At8_, Bt8_) asm volatile( \
        "v_mfma_scale_f32_16x16x128_f8f6f4 %0, %12, %8, %0, %14, %15 op_sel_hi:[0,0,0]\n\t" \
        "v_mfma_scale_f32_16x16x128_f8f6f4 %1, %13, %8, %1, %14, %15 op_sel_hi:[0,0,0]\n\t" \
        "v_mfma_scale_f32_16x16x128_f8f6f4 %2, %12, %9, %2, %14, %15 op_sel_hi:[0,0,0]\n\t" \
        "v_mfma_scale_f32_16x16x128_f8f6f4 %3, %13, %9, %3, %14, %15 op_sel_hi:[0,0,0]\n\t" \
        "v_mfma_scale_f32_16x16x128_f8f6f4 %4, %12, %10, %4, %14, %15 op_sel_hi:[0,0,0]\n\t" \
        "v_mfma_scale_f32_16x16x128_f8f6f4 %5, %13, %10, %5, %14, %15 op_sel_hi:[0,0,0]\n\t" \
        "v_mfma_scale_f32_16x16x128_f8f6f4 %6, %12, %11, %6, %14, %15 op_sel_hi:[0,0,0]\n\t" \
        "v_mfma_scale_f32_16x16x128_f8f6f4 %7, %13, %11, %7, %14, %15 op_sel_hi:[0,0,0]\n\t" \
        "s_nop 3" \
        : "+v"(A_[0][0]), "+v"(A_[0][1]), "+v"(A_[1][0]), "+v"(A_[1][1]), "+v"(A_[2][0]), "+v"(A_[2][1]), "+v"(A_[3][0]), "+v"(A_[3][1]) \
        : "v"(At8_[0]), "v"(At8_[1]), "v"(At8_[2]), "v"(At8_[3]), "v"(Bt8_[0]), "v"(Bt8_[1]), "v"(scale_w), "v"(scale_x))
#define PG8_MMA(ai, bj, At, Bt) do { __builtin_amdgcn_s_setprio(1); \
        if constexpr (FP8) { PG8_MMA8(acc[ai][bj], At##8, Bt##8); } \
        else { _Pragma("unroll") for (int m = 0; m < 4; ++m) _Pragma("unroll") for (int n = 0; n < 2; ++n) _Pragma("unroll") for (int k = 0; k < 2; ++k) \
            acc[ai][bj][m][n] = __builtin_amdgcn_mfma_f32_16x16x32_bf16(Bt[n][k], At[m][k], acc[ai][bj][m][n], 0, 0, 0); } \
        __builtin_amdgcn_s_setprio(0); } while (0)
#define PG8_WAIT_V(n) asm volatile("s_waitcnt vmcnt(" #n ")" ::: "memory")
#define PG8_WAIT_L(n) asm volatile("s_waitcnt lgkmcnt(" #n ")" ::: "memory")
#define PG8_BAR __builtin_amdgcn_s_barrier()
#define PG8_SCHED __builtin_amdgcn_sched_barrier(0)
    Unit cur, nxt; int ui = 0;
    if (!S.next(0, cur)) return;
    f32x4 acc[2][2][4][2];
#pragma unroll
    for (int a = 0; a < 2; ++a)
#pragma unroll
        for (int b = 0; b < 2; ++b)
#pragma unroll
            for (int m = 0; m < 4; ++m)
#pragma unroll
                for (int n = 0; n < 2; ++n) acc[a][b][m][n] = (f32x4){0.f, 0.f, 0.f, 0.f};
    bf16x8 At[4][2], B0[2][2], B1[2][2]; i32x8 At8[4], B08[2], B18[2]; (void)At; (void)B0; (void)B1; (void)At8; (void)B08; (void)B18;
    const char* cA = (const char*)g.A + (size_t)cur.pm * tstep; const char* cB = PG8_BBASE(cur.pn);
    S.a_ready(cur);
    const char* nA = cA; (void)nA;
    if constexpr (SP2) {
        PG8_STAGE(PG8_SB(0, 0), cB, voffB); PG8_STAGE(PG8_SB(0, 1), cB + hstepB, voffB); PG8_STAGE_A(PG8_SA(0, 0), false, 0, (size_t)0); PG8_STAGE_A(PG8_SA(0, 1), false, 1, (size_t)0);
        if (wr == 1) PG8_BAR;
        PG8_WAIT_V(2); PG8_BAR;
        PG8_STAGE(PG8_SB(1, 0), cB + kstepB, voffB); PG8_STAGE_A(PG8_SA(1, 0), false, 0, kstep); PG8_STAGE(PG8_SB(1, 1), cB + hstepB + kstepB, voffB);
        PG8_WAIT_V(6); PG8_BAR;
    } else {
        PG8_STAGE(PG8_SB(0, 0), cB, voffB); PG8_STAGE_A(PG8_SA(0, 0), false, 0, (size_t)0); PG8_STAGE(PG8_SB(0, 1), cB + hstepB, voffB); PG8_STAGE_A(PG8_SA(0, 1), false, 1, (size_t)0);
        if (wr == 1) PG8_BAR;
        PG8_WAIT_V(4); PG8_BAR;
        PG8_STAGE(PG8_SB(1, 0), cB + kstepB, voffB); PG8_STAGE_A(PG8_SA(1, 0), false, 0, kstep); PG8_STAGE(PG8_SB(1, 1), cB + hstepB + kstepB, voffB);
        PG8_WAIT_V(6); PG8_BAR;
    }
    for (;;) {
        const bool has_next = S.next(ui + 1, nxt);
        if constexpr (GATHER) {
#pragma unroll
            for (int h = 0; h < 2; ++h)
#pragma unroll
                for (int i = 0; i < 2; ++i) gN[h][i] = has_next ? (unsigned)ldsrow[(ui + 1) * 256 + h * HALF + gR[i]] * (unsigned)(K * 2) + gCb[i] : gC[h][i];
        }
        const char* nA = has_next ? (const char*)g.A + (size_t)nxt.pm * tstep : cA; const char* nB = has_next ? PG8_BBASE(nxt.pn) : cB;
        for (int t = 0; t < nt; t += 2) {
            const bool last = (t == nt - 2);
            const size_t k1 = (size_t)(t + 1) * kstep, k2 = last ? (size_t)0 : (size_t)(t + 2) * kstep, k3 = k2 + kstep;
            const char* a1 = cA + (size_t)(t + 1) * kstep;
            const char* a2 = last ? nA : cA + (size_t)(t + 2) * kstep; const char* b2 = last ? nB : cB + (size_t)(t + 2) * kstepB;
            const char* a3 = a2 + kstep; const char* b3 = b2 + kstepB;
            if (last && has_next) S.a_ready(nxt);
            if constexpr (SP2) {
            PG8_LDB(B0, 0, 0); PG8_LDB(B1, 0, 1); PG8_SCHED; PG8_LDA(At, 0, 0); PG8_STAGE_A(PG8_SA(1, 1), false, 1, k1);
            PG8_WAIT_V(8); PG8_WAIT_L(0); PG8_BAR; PG8_MMA(0, 0, At, B0); PG8_MMA(0, 1, At, B1); PG8_BAR; PG8_SCHED;
            PG8_LDA(At, 0, 1); PG8_STAGE(PG8_SB(0, 0), b2, voffB); PG8_STAGE(PG8_SB(0, 1), b2 + hstepB, voffB); PG8_STAGE_A(PG8_SA(0, 0), last, 0, k2);
            PG8_WAIT_V(8); PG8_WAIT_L(0); PG8_BAR; PG8_MMA(1, 0, At, B0); PG8_MMA(1, 1, At, B1); PG8_BAR; PG8_SCHED;
            PG8_LDB(B0, 1, 0); PG8_LDB(B1, 1, 1); PG8_SCHED; PG8_LDA(At, 1, 0); PG8_STAGE_A(PG8_SA(0, 1), last, 1, k2);
            PG8_WAIT_V(8); PG8_WAIT_L(0); PG8_BAR; PG8_MMA(0, 0, At, B0); PG8_MMA(0, 1, At, B1); PG8_BAR; PG8_SCHED;
            PG8_LDA(At, 1, 1); PG8_STAGE(PG8_SB(1, 0), b3, voffB); PG8_STAGE(PG8_SB(1, 1), b3 + hstepB, voffB); PG8_STAGE_A(PG8_SA(1, 0), last, 0, k3);
            PG8_WAIT_V(8); PG8_WAIT_L(0); PG8_BAR; PG8_MMA(1, 0, At, B0); PG8_MMA(1, 1, At, B1); PG8_BAR; PG8_SCHED;
            } else {
            PG8_LDB(B0, 0, 0); PG8_SCHED; PG8_LDA(At, 0, 0); PG8_STAGE_A(PG8_SA(1, 1), false, 1, k1);
            PG8_WAIT_L(8); PG8_BAR; PG8_WAIT_L(0); PG8_MMA(0, 0, At, B0); PG8_BAR; PG8_SCHED;
            PG8_LDB(B1, 0, 1); PG8_STAGE(PG8_SB(0, 0), b2, voffB);
            PG8_BAR; PG8_WAIT_L(0); PG8_MMA(0, 1, At, B1); PG8_BAR;
            PG8_LDA(At, 0, 1); PG8_STAGE_A(PG8_SA(0, 0), last, 0, k2);
            PG8_BAR; PG8_WAIT_L(0); PG8_MMA(1, 0, At, B0); PG8_BAR; PG8_SCHED;
            PG8_STAGE(PG8_SB(0, 1), b2 + hstepB, voffB);
            PG8_WAIT_V(6); PG8_BAR; PG8_MMA(1, 1, At, B1); PG8_BAR;
            PG8_LDB(B0, 1, 0); PG8_SCHED; PG8_LDA(At, 1, 0); PG8_STAGE_A(PG8_SA(0, 1), last, 1, k2);
            PG8_WAIT_L(8); PG8_BAR; PG8_WAIT_L(0); PG8_MMA(0, 0, At, B0); PG8_BAR; PG8_SCHED;
            PG8_LDB(B1, 1, 1); PG8_STAGE(PG8_SB(1, 0), b3, voffB);
            PG8_BAR; PG8_WAIT_L(0); PG8_MMA(0, 1, At, B1); PG8_BAR;
            PG8_LDA(At, 1, 1); PG8_STAGE_A(PG8_SA(1, 0), last, 0, k3);
            PG8_BAR; PG8_WAIT_L(0); PG8_MMA(1, 0, At, B0); PG8_BAR; PG8_SCHED;
            PG8_STAGE(PG8_SB(1, 1), b3 + hstepB, voffB);
            PG8_WAIT_V(6); PG8_BAR; PG8_MMA(1, 1, At, B1); PG8_BAR;
            }
        }
        if constexpr (ALIGN_EPI) { if (wr == 0) PG8_BAR; }
        if constexpr (!Epi::AFTER_DRAIN) { E(acc, cur, wr, wc, fr, fq); S.done(cur); }
        if (!has_next) break;
#pragma unroll
        for (int a = 0; a < 2; ++a)
#pragma unroll
            for (int b = 0; b < 2; ++b)
#pragma unroll
                for (int m = 0; m < 4; ++m)
#pragma unroll
                    for (int n = 0; n < 2; ++n) acc[a][b][m][n] = (f32x4){0.f, 0.f, 0.f, 0.f};
        cur = nxt; cA = nA; cB = nB; ++ui;
        if constexpr (GATHER) { gC[0][0] = gN[0][0]; gC[0][1] = gN[0][1]; gC[1][0] = gN[1][0]; gC[1][1] = gN[1][1]; }
        if constexpr (ALIGN_EPI) { if (wr == 1) PG8_BAR; }
    }
    PG8_WAIT_V(0);
    if constexpr (!ALIGN_EPI) { if (wr == 0) PG8_BAR; }
    PG8_BAR;
    if constexpr (Epi::AFTER_DRAIN) { E.fused(acc, cur, wr, wc, fr, fq, lds, wid, lane); S.done(cur); }
#undef PG8_SA
#undef PG8_SB
#undef PG8_STAGE
#undef PG8_BBASE
#undef PG8_STAGE_A
#undef PG8_LDA
#undef PG8_LD16
#undef PG8_LDB
#undef PG8_MMA
#undef PG8_MMA8
#undef PG8_WAIT_V
#undef PG8_WAIT_L
#undef PG8_BAR
#undef PG8_SCHED
}
}
constexpr int BATCH = 2, SEQ = 8192, DM = 1024, MTOK = BATCH * SEQ;
constexpr int RH = 4, RQK = 64, RV = 128, CHK = 128, NCH = SEQ / CHK;
constexpr int AH = 8, AD = 64;
constexpr int NE = 16, CAP = 1024, FF = 2048, NSLOT = NE * BATCH * CAP;
constexpr int NPROJ = 3072;
constexpr int C_RQ = 0, C_RK = 256, C_RV = 512, C_RG = 1024, C_AQ = 1536, C_AK = 2048, C_AV = 2560;
constexpr float RMS_EPS = 1e-6f, GN_EPS = 1e-5f;
constexpr float LOG2E = 1.4426950408889634f;
constexpr int NWAVES = 8;
#ifndef MK_ONE_LAUNCH
#define MK_ONE_LAUNCH 1
#endif
constexpr int NPHASE = 13;
constexpr size_t MiB = 1u << 20;
constexpr size_t WS_CTL = 0, CTL_ZERO_BYTES = 32768;
constexpr size_t WS_MOD = 1 * MiB;
constexpr size_t WS_AFF = 2 * MiB;
constexpr size_t WS_TOK = 3 * MiB;
constexpr size_t WS_GATEV = 3 * MiB + 128 * 1024;
constexpr size_t WS_SLOTOF = 3 * MiB + 256 * 1024;
constexpr size_t WS_LSE = 5 * MiB;
constexpr size_t WS_WIN = 8 * MiB;
constexpr size_t WS_WOUT = 14 * MiB;
constexpr size_t WS_WGU = 16 * MiB;
constexpr size_t WS_WDN = 144 * MiB;
constexpr size_t WS_XN = 208 * MiB;
constexpr size_t WS_R = 240 * MiB;
constexpr size_t WS_PROJ = WS_R;
constexpr size_t WS_KV = WS_R + 96 * MiB;
constexpr size_t WS_PREV = WS_R + 128 * MiB;
constexpr size_t WS_ATTO = WS_R + 144 * MiB;
constexpr size_t WS_Y = WS_R + 192 * MiB;
constexpr size_t WS_MIXED = WS_R;
constexpr size_t WS_XE = WS_R + 64 * MiB;
constexpr size_t WS_HH = WS_R + 128 * MiB;
constexpr size_t WS_YE = WS_R;
constexpr size_t WS_END = WS_R + 256 * MiB;
constexpr int CW_MODCNT = 1024, CW_KVCNT = 1088, CW_TMO2 = 1152, CW_Q0 = 1280;
constexpr int CW_BAR = 4096;
constexpr int RING_BYTES = 131072;
constexpr int LDSCTL_OFF = RING_BYTES, MISC_OFF = LDSCTL_OFF + 320;
constexpr int LDS_BYTES = 147456;

#define GAS __attribute__((address_space(1)))
#define LAS __attribute__((address_space(3)))
typedef unsigned short bf16;
typedef unsigned v4u __attribute__((ext_vector_type(4)));
typedef unsigned v2u __attribute__((ext_vector_type(2)));
typedef float f32x4 __attribute__((ext_vector_type(4)));
typedef float f32x16 __attribute__((ext_vector_type(16)));
typedef short bf16x8 __attribute__((ext_vector_type(8)));
typedef short s16x4 __attribute__((ext_vector_type(4)));
typedef GAS unsigned gu32;
#define RLX_AGENT __ATOMIC_RELAXED, __HIP_MEMORY_SCOPE_AGENT
#define LDS_WAIT() asm volatile("s_waitcnt lgkmcnt(0)" ::: "memory")
typedef float f32x2_t __attribute__((ext_vector_type(2))); typedef __bf16 bf16x2_t __attribute__((ext_vector_type(2)));
__device__ __forceinline__ unsigned pk2(float lo, float hi) { f32x2_t v = {lo, hi}; bf16x2_t b = __builtin_convertvector(v, bf16x2_t); return __builtin_bit_cast(unsigned, b); }
__device__ __forceinline__ float bflo(unsigned w) { return __uint_as_float(w << 16); }
__device__ __forceinline__ float bfhi(unsigned w) { return __uint_as_float(w & 0xffff0000u); }
__device__ __forceinline__ float ex2(float x) { return __builtin_amdgcn_exp2f(x); }
__device__ __forceinline__ int crow(int r, int hi) { return (r & 3) + 8 * (r >> 2) + 4 * hi; }
__device__ __forceinline__ s16x4 vtr(const LAS unsigned char* p) { typedef short v4i16_t __attribute__((ext_vector_type(4))); return __builtin_bit_cast(s16x4, __builtin_amdgcn_ds_read_tr16_b64_v4i16((LAS v4i16_t*)p)); }
__device__ __forceinline__ bf16x8 cat8(s16x4 a, s16x4 b) { return (bf16x8){a[0], a[1], a[2], a[3], b[0], b[1], b[2], b[3]}; }
__device__ __forceinline__ unsigned long long rt_now() { unsigned long long t; asm volatile("s_memrealtime %0\n\ts_waitcnt lgkmcnt(0)" : "=s"(t) :: "memory"); return t; }
__device__ __forceinline__ float wave_sum(float v) {
#pragma unroll
    for (int o = 1; o < 64; o <<= 1) v += __shfl_xor(v, o);
    return v;
}
#define XB_TMO      128
#define XB_XCNT(j)  (256  + 64 * (j))
#define XB_XSUB(j)  (1280 + 64 * (j))
#define XB_XGEN(j)  (2304 + 64 * (j))
#define XB_TOP      3328
#define XB_TOPGEN   3392
#define XCD_BAR_WORDS 3456
#define XB_SPIN_CAP (1u << 18)

__device__ __forceinline__ unsigned xb_ld(unsigned* p)              { return __hip_atomic_load(p, __ATOMIC_RELAXED, __HIP_MEMORY_SCOPE_AGENT); }
__device__ __forceinline__ unsigned xb_add(unsigned* p, unsigned v) { return __hip_atomic_fetch_add(p, v, __ATOMIC_RELAXED, __HIP_MEMORY_SCOPE_AGENT); }
__device__ __forceinline__ unsigned xb_xcc_id() { return (unsigned)__builtin_amdgcn_s_getreg((3 << 11) | 20) & 0xFu; }
#define XB_SPIN(cond, bar) do { unsigned _sp = 0; while (cond) { __builtin_amdgcn_s_sleep(1); \
    if ((++_sp & 255u) == 0u) { if (xb_ld(&(bar)[XB_TMO])) break; if (_sp > XB_SPIN_CAP) { atomicAdd(&(bar)[XB_TMO], 1u); break; } } } } while (0)

struct XcdBarrier {
    unsigned* bar; unsigned x;
    volatile LAS unsigned* st;
};

__device__ __forceinline__ XcdBarrier xcd_barrier_post(unsigned* bar, volatile LAS unsigned* st) {
    XcdBarrier b; b.bar = bar; b.x = xb_xcc_id(); b.st = st;
    if (threadIdx.x == 0) (void)xb_add(&bar[XB_XCNT(b.x)], 1u);
    return b;
}
__device__ __forceinline__ void xcd_barrier_complete(unsigned* bar, unsigned x, unsigned& nloc, unsigned& nx) {
    const unsigned G = gridDim.x * gridDim.y * gridDim.z;
    unsigned sum, cnt, mine, sp = 0u;
    for (;;) {
        sum = 0u; cnt = 0u; mine = 0u;
#pragma unroll
        for (unsigned j = 0; j < 16; ++j) { const unsigned c = xb_ld(&bar[XB_XCNT(j)]); sum += c; cnt += (c > 0u) ? 1u : 0u; mine = (j == x) ? c : mine; }
        if (sum == G) break;
        __builtin_amdgcn_s_sleep(1);
        if ((++sp & 255u) == 0u) { if (xb_ld(&bar[XB_TMO])) break; if (sp > XB_SPIN_CAP) { atomicAdd(&bar[XB_TMO], 1u); break; } }
    }
    nloc = mine > 0u ? mine : 1u; nx = cnt > 0u ? cnt : 1u;
}

__device__ __forceinline__ void xcd_barrier(const XcdBarrier& b) {
    asm volatile("s_waitcnt vmcnt(0)" ::: "memory");
    __syncthreads();
    if (threadIdx.x == 0) {
        unsigned* bar = b.bar;
        __builtin_amdgcn_s_waitcnt(0);
        unsigned nloc = b.st[0], nx = b.st[1];
        if (nloc == 0u) { xcd_barrier_complete(bar, b.x, nloc, nx); b.st[0] = nloc; b.st[1] = nx; }
        const unsigned old = xb_add(&bar[XB_XSUB(b.x)], 1u);
        const unsigned gen = old / nloc;
        if (old + 1u == (gen + 1u) * nloc) {
            __builtin_amdgcn_fence(__ATOMIC_RELEASE, "agent");
            asm volatile("s_waitcnt vmcnt(0)" ::: "memory");
            const unsigned og = xb_add(&bar[XB_TOP], 1u);
            const unsigned tg = og / nx;
            if (og + 1u == (tg + 1u) * nx) xb_add(&bar[XB_TOPGEN], 1u);
            else XB_SPIN(xb_ld(&bar[XB_TOPGEN]) == tg, bar);
            __builtin_amdgcn_fence(__ATOMIC_ACQUIRE, "agent");
            xb_add(&bar[XB_XGEN(b.x)], 1u);
            asm volatile("s_waitcnt vmcnt(0)" ::: "memory");
        } else {
            XB_SPIN(xb_ld(&bar[XB_XGEN(b.x)]) == gen, bar);
            __builtin_amdgcn_fence(__ATOMIC_ACQUIRE, "agent");
            asm volatile("s_waitcnt vmcnt(0)" ::: "memory");
        }
    }
    __syncthreads();
}
struct Frame {
    LAS unsigned char* lds;
    volatile LAS unsigned* MISC;
    gu32* ctl;
    int tid, lane, wave;
    int vcu, G;
    unsigned long long ts_a, ts_b;
    const float *x, *c, *w_ada, *b_ada, *g_pre_mix, *g_post_mix, *g_pre_ffn, *g_post_ffn, *w_in, *dec_f, *dec_b, *w_out, *w_router, *w_gate, *w_up, *w_down;
    float* out;
    float *MOD, *AFF, *GATEV, *LSE, *KV, *MIXED;
    int *TOK, *SLOTOF;
    bf16 *WIN, *WOUT, *WGU, *WDN, *XN, *PROJ, *PREV, *ATTO, *Y, *XE, *HH, *YE, *MIXB, *X1B;
};

struct ConvItem { const float* W; void* WT; int K, N, k0, n0, drow0, fp8, nrows; };
__device__ __forceinline__ void p0_load(const ConvItem& ci, f32x4 (&v)[16], int lane) {
    const int kr = lane >> 3, n4 = lane & 7;
#pragma unroll
    for (int i = 0; i < 16; ++i) v[i] = *(const f32x4*)(ci.W + (size_t)(ci.k0 + 8 * i + kr) * ci.N + ci.n0 + 4 * n4);
}
__device__ __forceinline__ void p0_finish(const ConvItem& ci, const f32x4 (&v)[16], LAS float* scr, int lane) {
    const int kr = lane >> 3, n4 = lane & 7;
#pragma unroll
    for (int i = 0; i < 16; ++i) { const int k = 8 * i + kr; *(LAS f32x4*)(scr + k * 32 + (((n4 + (k >> 4)) & 7) << 2)) = v[i]; }
    LDS_WAIT(); asm volatile("" ::: "memory");
    const int kq = lane & 7;
#pragma unroll 1
    for (int j = 0; j < 4; ++j) { const int n = (lane >> 3) + 8 * j; const LAS float* sp = scr + (16 * kq) * 32 + ((n + 4 * kq) & 31);
        float t[16];
#pragma unroll
        for (int u = 0; u < 16; ++u) t[u] = sp[u * 32];
        if (ci.fp8) { v4u o; o.x = pg8::cvt4_fp8(t[0] * 32.f, t[1] * 32.f, t[2] * 32.f, t[3] * 32.f); o.y = pg8::cvt4_fp8(t[4] * 32.f, t[5] * 32.f, t[6] * 32.f, t[7] * 32.f);
            o.z = pg8::cvt4_fp8(t[8] * 32.f, t[9] * 32.f, t[10] * 32.f, t[11] * 32.f); o.w = pg8::cvt4_fp8(t[12] * 32.f, t[13] * 32.f, t[14] * 32.f, t[15] * 32.f);
            *(GAS v4u*)((unsigned char*)ci.WT + ((size_t)(ci.k0 >> 7) * (ci.nrows >> 5) + (ci.drow0 >> 5)) * 4096 + (size_t)n * 128 + 16 * kq) = o; }
        else { v4u o0, o1; o0.x = pk2(t[0], t[1]); o0.y = pk2(t[2], t[3]); o0.z = pk2(t[4], t[5]); o0.w = pk2(t[6], t[7]); o1.x = pk2(t[8], t[9]); o1.y = pk2(t[10], t[11]); o1.z = pk2(t[12], t[13]); o1.w = pk2(t[14], t[15]);
            GAS v4u* dp = (GAS v4u*)((bf16*)ci.WT + (size_t)(ci.drow0 + n) * ci.K + ci.k0 + 16 * kq); dp[0] = o0; dp[1] = o1; } }
    LDS_WAIT(); asm volatile("" ::: "memory");
}
__device__ __forceinline__ void p8_load(const ConvItem& ci, f32x4 (&v)[16], int lane) {
#pragma unroll
    for (int i = 0; i < 16; ++i) v[i] = *(const f32x4*)(ci.W + (size_t)(ci.k0 + 2 * i + (lane >> 5)) * ci.N + ci.n0 + 4 * (lane & 31));
}
__device__ __forceinline__ void p8_finish(const ConvItem& ci, const f32x4 (&v)[16], LAS float* scr, int lane) {
#pragma unroll
    for (int i = 0; i < 16; ++i) { const int k = 2 * i + (lane >> 5); *(LAS f32x4*)(scr + k * 128 + ((4 * (lane & 31) + 16 * (k >> 4)) & 127)) = v[i]; }
    LDS_WAIT(); asm volatile("" ::: "memory");
    unsigned char* dst = (unsigned char*)ci.WT + ((size_t)(ci.k0 >> 5) * (ci.nrows >> 7) + (ci.drow0 >> 7)) * 4096;
#pragma unroll 1
    for (int j = 0; j < 4; ++j) { const int ch = 64 * j + lane, n = ch >> 1, kh = ch & 1; const LAS float* sp = scr + (16 * kh) * 128 + ((n + 16 * kh) & 127);
        float t[16];
#pragma unroll
        for (int u = 0; u < 16; ++u) t[u] = sp[u * 128];
        v4u o; o.x = pg8::cvt4_fp8(t[0] * 32.f, t[1] * 32.f, t[2] * 32.f, t[3] * 32.f); o.y = pg8::cvt4_fp8(t[4] * 32.f, t[5] * 32.f, t[6] * 32.f, t[7] * 32.f);
        o.z = pg8::cvt4_fp8(t[8] * 32.f, t[9] * 32.f, t[10] * 32.f, t[11] * 32.f); o.w = pg8::cvt4_fp8(t[12] * 32.f, t[13] * 32.f, t[14] * 32.f, t[15] * 32.f);
        *(GAS v4u*)(dst + (size_t)ch * 16) = o; }
    LDS_WAIT(); asm volatile("" ::: "memory");
}
constexpr int CI_IN = (DM / 128) * (NPROJ / 32), CI_OUT = (DM / 128) * (DM / 32), CI_G1 = (DM / 32) * (FF / 128), CI_G = NE * CI_G1, CI_D1 = (FF / 32) * (DM / 128), CI_D = NE * CI_D1;
constexpr int CI_N = CI_IN + CI_OUT + 2 * CI_G + CI_D;
#ifndef CI_DEFER
#define CI_DEFER 13312
#endif
#ifndef CI_DEFER2
#define CI_DEFER2 8192
#endif
constexpr int CI_P0 = CI_N - CI_DEFER - CI_DEFER2;
__device__ __forceinline__ ConvItem p0_decode(Frame& F, int it) {
    ConvItem ci; int r = it;
    if (r < CI_IN) { const int nblk = NPROJ / 32, kb = r / nblk, nb = r % nblk; ci = ConvItem{F.w_in, F.WIN, DM, NPROJ, 128 * kb, 32 * nb, 32 * nb, 0, 0}; return ci; } r -= CI_IN;
    if (r < CI_OUT) { const int nblk = DM / 32, kb = r / nblk, nb = r % nblk; ci = ConvItem{F.w_out, F.WOUT, DM, DM, 128 * kb, 32 * nb, 32 * nb, 0, 0}; return ci; } r -= CI_OUT;
    if (r < 2 * CI_G) { const int half = r / CI_G; r -= half * CI_G; const int e = r / CI_G1, q = r % CI_G1, nblk = FF / 128, kb = q / nblk, nb = q % nblk, n0 = 128 * nb;
        ci = ConvItem{(half ? F.w_up : F.w_gate) + (size_t)e * DM * FF, (unsigned char*)F.WGU + (size_t)e * (2 * FF) * DM, DM, FF, 32 * kb, n0, nb * 256 + half * 128, 1, 2 * FF}; return ci; } r -= 2 * CI_G;
    { const int e = r / CI_D1, q = r % CI_D1, nblk = DM / 128, kb = q / nblk, nb = q % nblk;
      ci = ConvItem{F.w_down + (size_t)e * FF * DM, (unsigned char*)F.WDN + (size_t)e * DM * FF, FF, DM, 32 * kb, 128 * nb, 128 * nb, 1, DM}; return ci; }
}
__device__ __forceinline__ void phase_p0a(Frame& F) {
#if defined(TIME_SUB)
    if (TIME_SUB == 1) F.ts_a = rt_now();
#endif
    int it, stride, itend;
    { const int nA = (F.G >= 6 * DM / 32) ? 6 * DM / 32 : F.G, nB = F.G - nA;
      const int wA = nA * NWAVES, wB = nB * NWAVES; const int split = (nB > 0) ? ((CI_P0 / (wA + wB)) * wA) : CI_P0;
      if (F.vcu < nA) { it = F.vcu * NWAVES + F.wave; stride = wA; itend = split; } else { it = split + (F.vcu - nA) * NWAVES + F.wave; stride = wB; itend = CI_P0; } }
#if defined(CONV_ON_64)
    if ((F.vcu & 3) == 0) { it = (F.vcu >> 2) * NWAVES + F.wave; stride = (F.G >> 2) * NWAVES; itend = CI_N; } else { it = 0; itend = 0; stride = 1; }
#endif
    f32x4 vA[16], vB[16]; ConvItem ca, cb;
    if (it < itend) { ca = p0_decode(F, it); if (ca.fp8) p8_load(ca, vA, F.lane); else p0_load(ca, vA, F.lane); }
    LAS float* sc = (LAS float*)F.lds;
    LAS float* red = sc + 2 * DM;
    if (F.vcu < 6 * DM / 32) {
        for (int i = F.tid; i < 2 * DM; i += NWAVES * 64) { const float v = F.c[i]; sc[i] = v / (1.f + __expf(-v)); }
        __syncthreads();
        const int col0 = 32 * F.vcu, kk = F.lane >> 3, c4 = F.lane & 7, kb = 128 * F.wave;
        f32x4 w[16];
#pragma unroll
        for (int i = 0; i < 16; ++i) w[i] = *(const f32x4*)(F.w_ada + (size_t)(kb + 8 * i + kk) * (6 * DM) + col0 + 4 * c4);
        f32x4 a0 = {0.f, 0.f, 0.f, 0.f}, a1 = {0.f, 0.f, 0.f, 0.f};
#pragma unroll
        for (int i = 0; i < 16; ++i) { const int k = kb + 8 * i + kk; a0 += w[i] * sc[k]; a1 += w[i] * sc[DM + k]; }
#pragma unroll
        for (int o = 8; o < 64; o <<= 1) {
            a0.x += __shfl_xor(a0.x, o); a0.y += __shfl_xor(a0.y, o); a0.z += __shfl_xor(a0.z, o); a0.w += __shfl_xor(a0.w, o);
            a1.x += __shfl_xor(a1.x, o); a1.y += __shfl_xor(a1.y, o); a1.z += __shfl_xor(a1.z, o); a1.w += __shfl_xor(a1.w, o); }
        if (kk == 0) { *(LAS f32x4*)(red + (F.wave * 2 + 0) * 32 + 4 * c4) = a0; *(LAS f32x4*)(red + (F.wave * 2 + 1) * 32 + 4 * c4) = a1; }
        __syncthreads();
        if (F.tid < 64) { const int b = F.tid >> 5, cc = F.tid & 31; float sum = 0.f;
#pragma unroll
            for (int wv = 0; wv < NWAVES; ++wv) sum += red[(wv * 2 + b) * 32 + cc];
            __hip_atomic_store(F.MOD + b * 6 * DM + col0 + cc, sum + F.b_ada[col0 + cc], RLX_AGENT);
            asm volatile("s_waitcnt vmcnt(0)" ::: "memory");
            if (F.tid == 0) __hip_atomic_fetch_add((unsigned*)(F.ctl + CW_MODCNT), 1u, RLX_AGENT); }
        __syncthreads();
    }
#if defined(TIME_SUB)
    if (TIME_SUB == 1) F.ts_b = rt_now();
    if (TIME_SUB == 2) F.ts_a = rt_now();
#endif
    LAS float* scr = (LAS float*)(F.lds + F.wave * 16384);
    while (it < itend) {
        int itn = it + stride;
        if (itn < itend) { cb = p0_decode(F, itn); if (cb.fp8) p8_load(cb, vB, F.lane); else p0_load(cb, vB, F.lane); }
        if (ca.fp8) p8_finish(ca, vA, scr, F.lane); else p0_finish(ca, vA, scr, F.lane);
        it = itn; if (it >= itend) break;
        itn = it + stride;
        if (itn < itend) { ca = p0_decode(F, itn); if (ca.fp8) p8_load(ca, vA, F.lane); else p0_load(ca, vA, F.lane); }
        if (cb.fp8) p8_finish(cb, vB, scr, F.lane); else p0_finish(cb, vB, scr, F.lane);
        it = itn;
    }
}
__device__ __forceinline__ void wait_counter(Frame& F, gu32* cnt, unsigned want) {
    if (F.tid == 0) {
        unsigned sp = 0;
        while (__hip_atomic_load(cnt, RLX_AGENT) < want) { __builtin_amdgcn_s_sleep(2);
            if (++sp > (1u << 22)) { __hip_atomic_store(F.ctl + CW_TMO2, 1u, RLX_AGENT); break; } }
        __builtin_amdgcn_fence(__ATOMIC_ACQUIRE, "agent");
        asm volatile("s_waitcnt vmcnt(0)" ::: "memory");
    }
    __syncthreads();
}
__device__ __forceinline__ void phase_p0b(Frame& F) {
    const int gw = F.vcu * NWAVES + F.wave, NGW = F.G * NWAVES;
    constexpr int RB = 8;
    for (int m0 = gw; m0 < MTOK; m0 += RB * NGW) {
        f32x4 v[RB][4]; float s[RB];
#pragma unroll
        for (int q = 0; q < RB; ++q) { const int m = m0 + q * NGW; const GAS f32x4* xr = (const GAS f32x4*)(F.x + (size_t)(m < MTOK ? m : m0) * DM) + F.lane;
#pragma unroll
            for (int j = 0; j < 4; ++j) v[q][j] = xr[64 * j]; }
#pragma unroll
        for (int q = 0; q < RB; ++q) { float t = 0.f;
#pragma unroll
            for (int j = 0; j < 4; ++j) t += (v[q][j].x * v[q][j].x + v[q][j].y * v[q][j].y) + (v[q][j].z * v[q][j].z + v[q][j].w * v[q][j].w);
            s[q] = 1.f / sqrtf(wave_sum(t) * (1.f / DM) + RMS_EPS); }
#pragma unroll
        for (int j = 0; j < 4; ++j) { const int c = 4 * F.lane + 256 * j;
            const f32x4 g = *(const f32x4*)(F.g_pre_mix + c);
            const f32x4 a0 = g * (*(const f32x4*)(F.MOD + DM + c) + 1.f), h0 = *(const f32x4*)(F.MOD + c);
            const f32x4 a1 = g * (*(const f32x4*)(F.MOD + 6 * DM + DM + c) + 1.f), h1 = *(const f32x4*)(F.MOD + 6 * DM + c);
#pragma unroll
            for (int q = 0; q < RB; ++q) { const int m = m0 + q * NGW; if (m < MTOK) { const bool b1 = m >= SEQ;
                const f32x4 h = v[q][j] * s[q] * (b1 ? a1 : a0) + (b1 ? h1 : h0);
                v2u w; w.x = pk2(h.x, h.y); w.y = pk2(h.z, h.w); *((GAS v2u*)(F.XN + (size_t)m * DM) + F.lane + 64 * j) = w; } } }
    }
}

__device__ __forceinline__ void phase_side_convert(Frame& F, int j, int nside, int ibeg, int iend) {
    LAS float* scr = (LAS float*)(F.lds + F.wave * 16384);
    int it = ibeg + j * NWAVES + F.wave; const int stride = nside * NWAVES, itend = iend;
    f32x4 vA[16], vB[16]; ConvItem ca, cb;
    if (it < itend) { ca = p0_decode(F, it); p8_load(ca, vA, F.lane); }
    while (it < itend) {
        int itn = it + stride;
        if (itn < itend) { cb = p0_decode(F, itn); p8_load(cb, vB, F.lane); }
        p8_finish(ca, vA, scr, F.lane);
        it = itn; if (it >= itend) break;
        itn = it + stride;
        if (itn < itend) { ca = p0_decode(F, itn); p8_load(ca, vA, F.lane); }
        p8_finish(cb, vB, scr, F.lane);
        it = itn;
    }
}
__device__ __forceinline__ float lg2_sigmoid(float x) { return -log1pf(__expf(-x)) * LOG2E; }
struct AttnDesc { int b, h, cfg, r, qblk; };
__device__ __forceinline__ AttnDesc attn_decode(int u) {
    AttnDesc a; const int blk = u & 31; a.h = (u >> 5) & 7; a.b = (u >> 8) & 1; a.cfg = u >> 9;
    const int d = (a.cfg == 0) ? 1 : ((a.cfg == 1) ? 4 : 16), nq = (SEQ / d) / 256; a.r = blk / nq; a.qblk = blk % nq; return a;
}
constexpr int ATT_KOFF = 0, ATT_VOFF = 49152;
__device__ __forceinline__ void attn_prefetch(Frame& F, const AttnDesc& a, v4u (&kr)[6], v4u (&vr)[6]) {
    const int d = (a.cfg == 0) ? 1 : ((a.cfg == 1) ? 4 : 16), L = SEQ / d;
    const bf16* P = F.PROJ + (size_t)a.b * SEQ * NPROJ;
    const int wl0 = 256 * a.qblk - 64, ch = F.tid & 7;
#pragma unroll
    for (int p = 0; p < 6; ++p) {
        int l = wl0 + p * 64 + (F.tid >> 3); l = l < 0 ? 0 : (l > L - 1 ? L - 1 : l);
        const bf16* rp = P + (unsigned)((l * d + a.r) * NPROJ + a.h * AD + ch * 8);
        kr[p] = *(const v4u*)(rp + C_AK); vr[p] = *(const v4u*)(rp + C_AV);
    }
}
__device__ __forceinline__ void attn_stage(Frame& F, const v4u (&kr)[6], const v4u (&vr)[6]) {
    const int ch = F.tid & 7;
#pragma unroll
    for (int p = 0; p < 6; ++p) { const int kidx = p * 64 + (F.tid >> 3);
        *(LAS v4u*)(F.lds + ATT_KOFF + kidx * 128 + ((ch ^ (kidx & 7)) << 4)) = kr[p];
        *(LAS v4u*)(F.lds + ATT_VOFF + (ch >> 2) * (384 * 64) + (kidx >> 3) * 512 + (kidx & 7) * 64 + (ch & 3) * 16) = vr[p]; }
}
__device__ __forceinline__ void attn_compute(Frame& F, const AttnDesc& a) {
    const int cfg = a.cfg, h = a.h, b = a.b, r = a.r, qblk = a.qblk;
    const int d = (cfg == 0) ? 1 : ((cfg == 1) ? 4 : 16), L = SEQ / d;
    const int wave = F.wave; int lane = F.lane; asm volatile("" : "+v"(lane));
    const int i = lane & 31, hi = lane >> 5;
    const bf16* P = F.PROJ + (size_t)b * SEQ * NPROJ;
    const int lw0 = 256 * qblk + 32 * wave - 64;
    const int ql = 256 * qblk + 32 * wave + i;
    bf16x8 qf[4];
    { const bf16* qp = P + (unsigned)((ql * d + r) * NPROJ + C_AQ + h * AD + hi * 8);
#pragma unroll
      for (int s = 0; s < 4; ++s) qf[s] = *(const bf16x8*)(qp + 16 * s); }
    const float slope2 = ex2(-(float)(h + 1)) * (float)d * LOG2E;
    f32x16 acc[5];
    const int a0 = i + 64 - 4 * hi;
    const LAS unsigned char* Kl = F.lds + ATT_KOFF;
#pragma unroll
    for (int T = 0; T < 5; ++T) {
        const float cinit = (T < 2) ? -slope2 * (float)(a0 - 32 * T) : ((T > 2) ? slope2 * (float)(a0 - 32 * T) : 0.f);
        f32x16 c;
#pragma unroll
        for (int rr = 0; rr < 16; ++rr) c[rr] = cinit;
        const int key = 32 * wave + 32 * T + i;
#pragma unroll
        for (int s = 0; s < 4; ++s) { const bf16x8 kf = *(const LAS bf16x8*)(Kl + key * 128 + (((2 * s + hi) ^ (key & 7)) << 4));
            c = __builtin_amdgcn_mfma_f32_32x32x16_bf16(kf, qf[s], c, 0, 0, 0); }
        acc[T] = c;
    }
    if (lw0 < 0 || lw0 + 160 > L) {
#pragma unroll
        for (int T = 0; T < 5; ++T)
#pragma unroll
            for (int rr = 0; rr < 16; ++rr) { const int kl = lw0 + 32 * T + crow(rr, hi); if (kl < 0 || kl >= L) acc[T][rr] = -1.0e30f; }
    }
    const int th0 = i - 4 * hi; const float fa2 = (float)(a0 - 64);
    float mx = -3.0e38f;
#pragma unroll
    for (int rr = 0; rr < 16; ++rr) { const int c0 = (rr & 3) + 8 * (rr >> 2); const float sc0 = slope2 * (float)c0;
        float v0 = acc[0][rr] + sc0; v0 = (c0 >= th0) ? v0 : -1.0e30f;
        const float v1 = acc[1][rr] + sc0;
        const float v2 = acc[2][rr] - slope2 * fabsf(fa2 - (float)c0);
        const float v3 = acc[3][rr] - sc0;
        float v4 = acc[4][rr] - sc0; v4 = (c0 <= th0) ? v4 : -1.0e30f;
        acc[0][rr] = v0; acc[1][rr] = v1; acc[2][rr] = v2; acc[3][rr] = v3; acc[4][rr] = v4;
        mx = fmaxf(mx, fmaxf(fmaxf(v0, v1), fmaxf(fmaxf(v2, v3), v4))); }
    mx = fmaxf(mx, __shfl_xor(mx, 32));
    float lsum = 0.f;
#pragma unroll
    for (int T = 0; T < 5; ++T)
#pragma unroll
        for (int rr = 0; rr < 16; ++rr) { const float p = ex2(acc[T][rr] - mx); acc[T][rr] = p; lsum += p; }
    lsum += __shfl_xor(lsum, 32);
    f32x16 o[2]; o[0] = f32x16{}; o[1] = f32x16{};
    const LAS unsigned char* vb = F.lds + ATT_VOFF + ((lane >> 4) & 1) * 32 + (lane & 3) * 8 + (4 * hi + ((lane & 15) >> 2)) * 64;
#pragma unroll
    for (int T = 0; T < 5; ++T)
#pragma unroll
        for (int u = 0; u < 2; ++u) {
            v4u pw; pw.x = pk2(acc[T][8 * u + 0], acc[T][8 * u + 1]); pw.y = pk2(acc[T][8 * u + 2], acc[T][8 * u + 3]); pw.z = pk2(acc[T][8 * u + 4], acc[T][8 * u + 5]); pw.w = pk2(acc[T][8 * u + 6], acc[T][8 * u + 7]);
            const bf16x8 pb = __builtin_bit_cast(bf16x8, pw);
            const int kbase = 32 * wave + 32 * T + 16 * u;
#pragma unroll
            for (int dt = 0; dt < 2; ++dt) {
                const LAS unsigned char* aa = vb + dt * (384 * 64) + (kbase >> 3) * 512;
                const bf16x8 va = cat8(vtr(aa), vtr(aa + 512));
                o[dt] = __builtin_amdgcn_mfma_f32_32x32x16_bf16(va, pb, o[dt], 0, 0, 0);
            }
        }
    const float inv = 1.f / lsum;
    const unsigned row = (unsigned)(b * SEQ + ql * d + r);
    bf16* op = F.ATTO + (size_t)cfg * MTOK * (AH * AD) + (unsigned)(row * (AH * AD) + h * AD);
#pragma unroll
    for (int dt = 0; dt < 2; ++dt)
#pragma unroll
        for (int g = 0; g < 4; ++g) { v2u w; w.x = pk2(o[dt][4 * g] * inv, o[dt][4 * g + 1] * inv); w.y = pk2(o[dt][4 * g + 2] * inv, o[dt][4 * g + 3] * inv);
            *(v2u*)(op + 32 * dt + 8 * g + 4 * hi) = w; }
    if (hi == 0) F.LSE[(size_t)cfg * MTOK * AH + (unsigned)(row * AH + h)] = mx + __builtin_amdgcn_logf(lsum);
}
__device__ __forceinline__ void kv_unit(Frame& F, int b, int h, int n) {
    const int tid = F.tid, wave = F.wave; int lane = F.lane; asm volatile("" : "+v"(lane));
    const int hi = lane >> 5;
    const float lgf = lg2_sigmoid(F.dec_f[h]), lgb = lg2_sigmoid(F.dec_b[h]);
    const size_t row0 = (size_t)b * SEQ + (size_t)n * CHK;
    LAS unsigned char* Vl = F.lds;
    LAS unsigned char* Kl = F.lds + 32768;
#pragma unroll
    for (int p = 0; p < 4; ++p) { const int idx = p * 512 + tid, key = idx >> 4, ch = idx & 15;
        const v4u val = *(const v4u*)(F.PROJ + (row0 + key) * NPROJ + C_RV + h * RV + ch * 8);
        *(LAS v4u*)(Vl + (ch >> 2) * (128 * 64) + (key >> 3) * 512 + (key & 7) * 64 + (ch & 3) * 16) = val; }
#pragma unroll
    for (int p = 0; p < 2; ++p) { const int idx = p * 512 + tid, key = idx >> 3, ch = idx & 7;
        const v4u val = *(const v4u*)(F.PROJ + (row0 + key) * NPROJ + C_RK + h * RQK + ch * 8);
        const float sf = ex2(lgf * (float)(127 - key)), sb = ex2(lgb * (float)key);
        v4u wf, wb;
        wf.x = pk2(bflo(val.x) * sf, bfhi(val.x) * sf); wf.y = pk2(bflo(val.y) * sf, bfhi(val.y) * sf); wf.z = pk2(bflo(val.z) * sf, bfhi(val.z) * sf); wf.w = pk2(bflo(val.w) * sf, bfhi(val.w) * sf);
        wb.x = pk2(bflo(val.x) * sb, bfhi(val.x) * sb); wb.y = pk2(bflo(val.y) * sb, bfhi(val.y) * sb); wb.z = pk2(bflo(val.z) * sb, bfhi(val.z) * sb); wb.w = pk2(bflo(val.w) * sb, bfhi(val.w) * sb);
        const int off = (ch >> 2) * (128 * 64) + (key >> 3) * 512 + (key & 7) * 64 + (ch & 3) * 16;
        *(LAS v4u*)(Kl + off) = wf; *(LAS v4u*)(Kl + 16384 + off) = wb; }
    __syncthreads();
    const int dir = wave >> 2, dvt = wave & 3;
    const int lofs = ((lane >> 4) & 1) * 32 + (lane & 3) * 8 + (4 * hi + ((lane & 15) >> 2)) * 64;
    const LAS unsigned char* va = Vl + dvt * (128 * 64) + lofs;
    bf16* kvout = (bf16*)F.KV + ((size_t)(((b * RH + h) * 2 + dir) * NCH + n)) * (RV * RQK);
#pragma unroll
    for (int dkt = 0; dkt < 2; ++dkt) {
        const LAS unsigned char* ka = Kl + dir * 16384 + dkt * (128 * 64) + lofs;
        f32x16 a = {};
#pragma unroll
        for (int s = 0; s < 8; ++s) {
            const bf16x8 A = cat8(vtr(va + s * 1024), vtr(va + s * 1024 + 512));
            const bf16x8 B = cat8(vtr(ka + s * 1024), vtr(ka + s * 1024 + 512));
            a = __builtin_amdgcn_mfma_f32_32x32x16_bf16(A, B, a, 0, 0, 0);
        }
#pragma unroll
        for (int rr = 0; rr < 16; ++rr) kvout[(32 * dvt + crow(rr, hi)) * RQK + 32 * dkt + (lane & 31)] = (bf16)(pk2(a[rr], 0.f) & 0xffffu);
    }
    __syncthreads();
}
__device__ __forceinline__ void phase_p2(Frame& F) {
    constexpr int NKV = BATCH * RH * NCH;
    for (int u = F.vcu; u < NKV; u += F.G) kv_unit(F, u >> 8, (u >> 6) & 3, u & 63);
    constexpr int NATT = BATCH * AH * 3 * (SEQ / 256);
    if (F.vcu < NATT) {
        v4u kr[6], vr[6];
        attn_prefetch(F, attn_decode(F.vcu), kr, vr);
        for (int u = F.vcu; u < NATT; u += F.G) {
            attn_stage(F, kr, vr);
            __syncthreads();
            if (u + F.G < NATT) attn_prefetch(F, attn_decode(u + F.G), kr, vr);
            attn_compute(F, attn_decode(u));
            __syncthreads();
        }
    }
}
__device__ __forceinline__ void phase_p3a(Frame& F) {
    for (int g = F.vcu * (NWAVES * 64) + F.tid; g < BATCH * RH * 2 * (RV * RQK); g += F.G * NWAVES * 64) {
        const int bhd = g >> 13, e = g & 8191, dir = bhd & 1, h = (bhd >> 1) & 3;
        const float lam = ex2(128.f * lg2_sigmoid(dir ? F.dec_b[h] : F.dec_f[h]));
        const bf16* kv = (const bf16*)F.KV + (size_t)bhd * NCH * 8192 + e; bf16* pv = F.PREV + (size_t)bhd * NCH * 8192 + e;
        float st = 0.f;
        for (int n0 = 0; n0 < NCH; n0 += 8) {
            float v[8];
#pragma unroll
            for (int k = 0; k < 8; ++k) { const int n = dir ? (NCH - 1 - (n0 + k)) : (n0 + k); v[k] = bflo((unsigned)kv[(size_t)n * 8192]); }
#pragma unroll
            for (int k = 0; k < 8; ++k) { const int n = dir ? (NCH - 1 - (n0 + k)) : (n0 + k); pv[(size_t)n * 8192] = (bf16)(pk2(st, 0.f) & 0xffffu); st = lam * st + v[k]; }
        }
    }
}
__device__ __forceinline__ void phase_p3b(Frame& F) {
    const int gw = F.vcu * NWAVES + F.wave, NGW = F.G * NWAVES;
    constexpr int RB = 4;
    for (int m0 = gw; m0 < MTOK; m0 += RB * NGW) {
        v4u a[RB][3]; float l[RB][3];
#pragma unroll
        for (int q = 0; q < RB; ++q) { const int mm = m0 + q * NGW; const size_t m = mm < MTOK ? mm : m0;
#pragma unroll
            for (int c = 0; c < 3; ++c) { a[q][c] = *(const v4u*)(F.ATTO + ((size_t)c * MTOK + m) * 512 + F.lane * 8); l[q][c] = F.LSE[((size_t)c * MTOK + m) * AH + (F.lane >> 3)]; } }
#pragma unroll
        for (int q = 0; q < RB; ++q) { const int m = m0 + q * NGW; if (m >= MTOK) break;
            const float mx = fmaxf(l[q][0], fmaxf(l[q][1], l[q][2])); float w0 = ex2(l[q][0] - mx), w1 = ex2(l[q][1] - mx), w2 = ex2(l[q][2] - mx); const float inv = 1.f / (w0 + w1 + w2); w0 *= inv; w1 *= inv; w2 *= inv;
            const v4u x = a[q][0], y = a[q][1], z = a[q][2]; v4u o;
            o.x = pk2(w0 * bflo(x.x) + w1 * bflo(y.x) + w2 * bflo(z.x), w0 * bfhi(x.x) + w1 * bfhi(y.x) + w2 * bfhi(z.x));
            o.y = pk2(w0 * bflo(x.y) + w1 * bflo(y.y) + w2 * bflo(z.y), w0 * bfhi(x.y) + w1 * bfhi(y.y) + w2 * bfhi(z.y));
            o.z = pk2(w0 * bflo(x.z) + w1 * bflo(y.z) + w2 * bflo(z.z), w0 * bfhi(x.z) + w1 * bfhi(y.z) + w2 * bfhi(z.z));
            o.w = pk2(w0 * bflo(x.w) + w1 * bflo(y.w) + w2 * bflo(z.w), w0 * bfhi(x.w) + w1 * bfhi(y.w) + w2 * bfhi(z.w));
            *(v4u*)(F.Y + (size_t)m * DM + 512 + F.lane * 8) = o; }
    }
}
__device__ __forceinline__ bf16x8 scale8(bf16x8 q, float s) {
    const v4u w = __builtin_bit_cast(v4u, q); v4u o;
    o.x = pk2(bflo(w.x) * s, bfhi(w.x) * s); o.y = pk2(bflo(w.y) * s, bfhi(w.y) * s); o.z = pk2(bflo(w.z) * s, bfhi(w.z) * s); o.w = pk2(bflo(w.w) * s, bfhi(w.w) * s);
    return __builtin_bit_cast(bf16x8, o);
}
__device__ __forceinline__ void ret_pair(Frame& F, int pair) {
    const int tid = F.tid, wave = F.wave; int lane = F.lane; asm volatile("" : "+v"(lane));
    const int i = lane & 31, hi = lane >> 5, grp = wave >> 2, w4 = wave & 3;
    const int cid = 2 * pair + grp, n = cid & 63, h = (cid >> 6) & 3, b = cid >> 8;
    const float lgf = lg2_sigmoid(F.dec_f[h]), lgb = lg2_sigmoid(F.dec_b[h]);
    const size_t row0 = (size_t)b * SEQ + (size_t)n * CHK;
    LAS unsigned char* Vl = F.lds + grp * 65536;
    LAS unsigned char* Pl = Vl + 32768;
    const int qi = 32 * w4 + i; const size_t qrow = row0 + qi;
    {
        const int t4 = tid & 255;
        v4u vreg[8], preg[8];
#pragma unroll
        for (int p = 0; p < 8; ++p) { const int idx = p * 256 + t4, key = idx >> 4, ch = idx & 15;
            vreg[p] = *(const v4u*)(F.PROJ + (row0 + key) * NPROJ + C_RV + h * RV + ch * 8); }
        const bf16* pf = F.PREV + ((size_t)(((b * RH + h) * 2 + 0) * NCH + n)) * (RV * RQK);
        const bf16* pb_ = F.PREV + ((size_t)(((b * RH + h) * 2 + 1) * NCH + n)) * (RV * RQK);
#pragma unroll
        for (int p = 0; p < 4; ++p) { const int idx = p * 256 + t4;
            preg[p] = *(const v4u*)(pf + (size_t)idx * 8); preg[4 + p] = *(const v4u*)(pb_ + (size_t)idx * 8); }
#pragma unroll
        for (int p = 0; p < 8; ++p) { const int idx = p * 256 + t4, key = idx >> 4, ch = idx & 15;
            *(LAS v4u*)(Vl + (ch >> 2) * (128 * 64) + (key >> 3) * 512 + (key & 7) * 64 + (ch & 3) * 16) = vreg[p]; }
#pragma unroll
        for (int p = 0; p < 4; ++p) { const int idx = p * 256 + t4, rw = idx >> 3, ch = idx & 7; const int off = rw * 128 + ((ch ^ (rw & 7)) << 4);
            *(LAS v4u*)(Pl + off) = preg[p]; *(LAS v4u*)(Pl + 16384 + off) = preg[4 + p]; }
    }
    bf16x8 qf[4];
    { const bf16* qp = F.PROJ + qrow * NPROJ + C_RQ + h * RQK + hi * 8;
#pragma unroll
      for (int s = 0; s < 4; ++s) qf[s] = *(const bf16x8*)(qp + 16 * s); }
    f32x16 acc[4];
    bf16x8 kf[2][4];
#define RET_LOADK(T, buf) do { const bf16* kp_ = F.PROJ + (row0 + 32 * (T) + i) * NPROJ + C_RK + h * RQK + hi * 8; \
        _Pragma("unroll") for (int s_ = 0; s_ < 4; ++s_) kf[buf][s_] = *(const bf16x8*)(kp_ + 16 * s_); } while (0)
    RET_LOADK(0, 0);
    v2u gw[4][4];
    { const bf16* gp = F.PROJ + qrow * NPROJ + C_RG + h * RV + 4 * hi;
#pragma unroll
      for (int dvt = 0; dvt < 4; ++dvt)
#pragma unroll
          for (int g = 0; g < 4; ++g) gw[dvt][g] = *(const v2u*)(gp + 32 * dvt + 8 * g); }
    __syncthreads();
#pragma unroll
    for (int T = 0; T < 4; ++T) {
        if (T + 1 < 4) RET_LOADK(T + 1, (T + 1) & 1);
        asm volatile("" ::: "memory");
        f32x16 a = {};
#pragma unroll
        for (int s = 0; s < 4; ++s) a = __builtin_amdgcn_mfma_f32_32x32x16_bf16(kf[T & 1][s], qf[s], a, 0, 0, 0);
        acc[T] = a;
    }
#undef RET_LOADK
#pragma unroll
    for (int T = 0; T < 4; ++T)
#pragma unroll
        for (int rr = 0; rr < 16; ++rr) { const int rel = qi - (32 * T + crow(rr, hi)); const float e = rel >= 0 ? lgf * (float)rel : -lgb * (float)rel; acc[T][rr] *= ex2(e); }
    f32x16 o[4]; o[0] = f32x16{}; o[1] = f32x16{}; o[2] = f32x16{}; o[3] = f32x16{};
    const LAS unsigned char* vb = Vl + ((lane >> 4) & 1) * 32 + (lane & 3) * 8 + (4 * hi + ((lane & 15) >> 2)) * 64;
#pragma unroll
    for (int T = 0; T < 4; ++T)
#pragma unroll
        for (int u = 0; u < 2; ++u) {
            v4u pw; pw.x = pk2(acc[T][8 * u + 0], acc[T][8 * u + 1]); pw.y = pk2(acc[T][8 * u + 2], acc[T][8 * u + 3]); pw.z = pk2(acc[T][8 * u + 4], acc[T][8 * u + 5]); pw.w = pk2(acc[T][8 * u + 6], acc[T][8 * u + 7]);
            const bf16x8 pb = __builtin_bit_cast(bf16x8, pw);
#pragma unroll
            for (int dvt = 0; dvt < 4; ++dvt) {
                const LAS unsigned char* a = vb + dvt * (128 * 64) + (4 * T + 2 * u) * 512;
                o[dvt] = __builtin_amdgcn_mfma_f32_32x32x16_bf16(cat8(vtr(a), vtr(a + 512)), pb, o[dvt], 0, 0, 0);
            }
            asm volatile("" ::: "memory");
        }
    {
        const float sf = ex2(lgf * (float)(qi + 1)), sb = ex2(lgb * (float)(CHK - qi));
#pragma unroll
        for (int s = 0; s < 4; ++s) {
            const bf16x8 qs_f = scale8(qf[s], sf), qs_b = scale8(qf[s], sb);
#pragma unroll
            for (int dvt = 0; dvt < 4; ++dvt) { const int rw = 32 * dvt + i; const int off = rw * 128 + (((2 * s + hi) ^ (rw & 7)) << 4);
                const bf16x8 af = *(const LAS bf16x8*)(Pl + off), ab = *(const LAS bf16x8*)(Pl + 16384 + off);
                o[dvt] = __builtin_amdgcn_mfma_f32_32x32x16_bf16(af, qs_f, o[dvt], 0, 0, 0);
                o[dvt] = __builtin_amdgcn_mfma_f32_32x32x16_bf16(ab, qs_b, o[dvt], 0, 0, 0);
            }
            asm volatile("" ::: "memory");
        }
    }
    float s1 = 0.f;
#pragma unroll
    for (int dvt = 0; dvt < 4; ++dvt)
#pragma unroll
        for (int rr = 0; rr < 16; ++rr) s1 += o[dvt][rr];
    s1 += __shfl_xor(s1, 32); const float mean = s1 * (1.f / RV);
    float s2 = 0.f;
#pragma unroll
    for (int dvt = 0; dvt < 4; ++dvt)
#pragma unroll
        for (int rr = 0; rr < 16; ++rr) { const float dlt = o[dvt][rr] - mean; s2 += dlt * dlt; }
    s2 += __shfl_xor(s2, 32); const float rstd = 1.f / sqrtf(s2 * (1.f / RV) + GN_EPS);
    bf16* yp = F.Y + qrow * DM + h * RV;
#pragma unroll
    for (int dvt = 0; dvt < 4; ++dvt)
#pragma unroll
        for (int g = 0; g < 4; ++g) { const int dv = 32 * dvt + 8 * g + 4 * hi; const v2u gwv = gw[dvt][g];
            float gv[4] = {bflo(gwv.x), bfhi(gwv.x), bflo(gwv.y), bfhi(gwv.y)}; float yv[4];
#pragma unroll
            for (int k = 0; k < 4; ++k) { const float sg = gv[k] * __builtin_amdgcn_rcpf(1.f + ex2(-gv[k] * LOG2E)); yv[k] = sg * (o[dvt][4 * g + k] - mean) * rstd; }
            v2u w; w.x = pk2(yv[0], yv[1]); w.y = pk2(yv[2], yv[3]); *(v2u*)(yp + dv) = w; }
    __syncthreads();
}
__device__ __forceinline__ void phase_p4(Frame& F) { for (int p = F.vcu; p < BATCH * RH * NCH / 2; p += F.G) ret_pair(F, p); }
constexpr int WR_PITCH = DM + 4;
__device__ __forceinline__ float fold16(const float (&p)[NE], int lane) {
    float a[8], b[4], c[2], d;
    { const bool hi = (lane & 32) != 0;
#pragma unroll
      for (int i = 0; i < 8; ++i) { const float send = hi ? p[i] : p[8 + i], keep = hi ? p[8 + i] : p[i]; a[i] = keep + __shfl_xor(send, 32); } }
    { const bool hi = (lane & 16) != 0;
#pragma unroll
      for (int i = 0; i < 4; ++i) { const float send = hi ? a[i] : a[4 + i], keep = hi ? a[4 + i] : a[i]; b[i] = keep + __shfl_xor(send, 16); } }
    { const bool hi = (lane & 8) != 0;
#pragma unroll
      for (int i = 0; i < 2; ++i) { const float send = hi ? b[i] : b[2 + i], keep = hi ? b[2 + i] : b[i]; c[i] = keep + __shfl_xor(send, 8); } }
    { const bool hi = (lane & 4) != 0; const float send = hi ? c[0] : c[1], keep = hi ? c[1] : c[0]; d = keep + __shfl_xor(send, 4); }
    d += __shfl_xor(d, 2); d += __shfl_xor(d, 1);
    return d;
}
__device__ __forceinline__ void phase_p6(Frame& F) {
    LAS float* wr = (LAS float*)F.lds;
    for (int idx = F.tid; idx < DM * NE; idx += NWAVES * 64) wr[(idx & 15) * WR_PITCH + (idx >> 4)] = F.w_router[idx];
    __syncthreads();
    const int gw = F.vcu * NWAVES + F.wave, NGW = F.G * NWAVES, lane = F.lane;
    constexpr int RB = 2;
    for (int m0 = gw; m0 < MTOK; m0 += RB * NGW) {
        v2u mw[RB][4]; f32x4 xv[RB][4];
#pragma unroll
        for (int q = 0; q < RB; ++q) { const int mm = m0 + q * NGW; const size_t m = mm < MTOK ? mm : m0;
#pragma unroll
            for (int j = 0; j < 4; ++j) { mw[q][j] = *(const v2u*)(F.MIXB + m * DM + 4 * lane + 256 * j); xv[q][j] = *(const f32x4*)(F.x + m * DM + 4 * lane + 256 * j); } }
#pragma unroll
        for (int q = 0; q < RB; ++q) { const int m = m0 + q * NGW; if (m >= MTOK) break;
            const int b = m / SEQ, spos = m % SEQ; const float* mod = F.MOD + b * 6 * DM;
            f32x4 mv[4]; float s = 0.f;
#pragma unroll
            for (int j = 0; j < 4; ++j) { const v2u w = mw[q][j]; mv[j] = (f32x4){bflo(w.x), bfhi(w.x), bflo(w.y), bfhi(w.y)}; s += (mv[j].x * mv[j].x + mv[j].y * mv[j].y) + (mv[j].z * mv[j].z + mv[j].w * mv[j].w); }
            const float r1 = 1.f / sqrtf(wave_sum(s) * (1.f / DM) + RMS_EPS);
            float s2 = 0.f;
#pragma unroll
            for (int j = 0; j < 4; ++j) { const int c = 4 * lane + 256 * j;
                const f32x4 g = *(const f32x4*)(F.g_post_mix + c), gm = *(const f32x4*)(mod + 2 * DM + c);
                const f32x4 x1 = xv[q][j] + gm * (mv[j] * r1 * g); xv[q][j] = x1; { v2u w; w.x = pk2(x1.x, x1.y); w.y = pk2(x1.z, x1.w); *(v2u*)(F.X1B + (size_t)m * DM + c) = w; }
                s2 += (x1.x * x1.x + x1.y * x1.y) + (x1.z * x1.z + x1.w * x1.w); }
            const float r2 = 1.f / sqrtf(wave_sum(s2) * (1.f / DM) + RMS_EPS);
            float lg[NE];
#pragma unroll
            for (int e = 0; e < NE; ++e) lg[e] = 0.f;
#pragma unroll
            for (int j = 0; j < 4; ++j) { const int c = 4 * lane + 256 * j;
                const f32x4 g = *(const f32x4*)(F.g_pre_ffn + c), sc = *(const f32x4*)(mod + 4 * DM + c), sh = *(const f32x4*)(mod + 3 * DM + c);
                const f32x4 h = xv[q][j] * r2 * g * (sc + 1.f) + sh;
                *(unsigned*)((unsigned char*)F.XN + (size_t)m * DM + c) = pg8::cvt4_fp8(h.x, h.y, h.z, h.w);
#pragma unroll
                for (int e = 0; e < NE; ++e) { const f32x4 wv = *(const LAS f32x4*)(wr + e * WR_PITCH + c); lg[e] += (h.x * wv.x + h.y * wv.y) + (h.z * wv.z + h.w * wv.w); }
                asm volatile("" ::: "memory"); }
            const float tot = fold16(lg, lane);
            float mxl = tot;
#pragma unroll
            for (int o = 4; o < 64; o <<= 1) mxl = fmaxf(mxl, __shfl_xor(mxl, o));
            const float ex = __expf(tot - mxl); float den = ex;
#pragma unroll
            for (int o = 4; o < 64; o <<= 1) den += __shfl_xor(den, o);
            const int eL = ((lane >> 5) & 1) * 8 + ((lane >> 4) & 1) * 4 + ((lane >> 3) & 1) * 2 + ((lane >> 2) & 1);
            if ((lane & 3) == 0) F.AFF[((size_t)b * NE + eL) * SEQ + spos] = ex / den; }
    }
}
__device__ __forceinline__ int block_excl_scan(int v, LAS int* wsum, int tid, int lane, int wave, int& total) {
    int inc = v;
#pragma unroll
    for (int o = 1; o < 64; o <<= 1) { const int t = __shfl_up(inc, o); if (lane >= o) inc += t; }
    __syncthreads();
    if (lane == 63) wsum[wave] = inc;
    __syncthreads();
    int base = 0, tot = 0;
#pragma unroll
    for (int w = 0; w < NWAVES; ++w) { const int t = wsum[w]; if (w < wave) base += t; tot += t; }
    total = tot; (void)tid;
    return base + inc - v;
}
__device__ __forceinline__ void topk_pair(Frame& F, int be, bool write_slotof) {
    const int b = be / NE, e = be % NE, tid = F.tid;
    LAS int* hist = (LAS int*)F.lds; LAS int* wsum = hist + 2048; LAS int* bc = hist + 2064;
    const float* a = F.AFF + (size_t)be * SEQ;
    unsigned v[16];
#pragma unroll
    for (int q = 0; q < 4; ++q) { const v4u t = *(const v4u*)(a + tid * 16 + q * 4); v[4 * q] = t.x; v[4 * q + 1] = t.y; v[4 * q + 2] = t.z; v[4 * q + 3] = t.w; }
    unsigned prefix = 0u; int kk = CAP;
#pragma unroll
    for (int pass = 0; pass < 3; ++pass) {
        constexpr int SH[3] = {21, 10, 0}, NB[3] = {2048, 2048, 1024};
        const int shift = SH[pass], nb = NB[pass], per = nb / 512; const unsigned hmask = (pass == 0) ? 0u : (0xffffffffu << SH[pass == 0 ? 0 : pass - 1]);
#pragma unroll
        for (int j = 0; j < 4; ++j) if (j < per) hist[tid * per + j] = 0;
        __syncthreads();
#pragma unroll
        for (int q = 0; q < 16; ++q) { if (((v[q] ^ prefix) & hmask) == 0u) __hip_atomic_fetch_add(&hist[(v[q] >> shift) & (unsigned)(nb - 1)], 1, __ATOMIC_RELAXED, __HIP_MEMORY_SCOPE_WORKGROUP); }
        __syncthreads();
        {
            int h[4]; int loc = 0;
#pragma unroll
            for (int j = 0; j < 4; ++j) { h[j] = (j < per) ? hist[nb - 1 - (tid * per + j)] : 0; loc += h[j]; }
            int tot_; int cum = block_excl_scan(loc, wsum, tid, F.lane, F.wave, tot_);
#pragma unroll
            for (int j = 0; j < 4; ++j) { if (j < per && cum < kk && kk <= cum + h[j]) { bc[0] = nb - 1 - (tid * per + j); bc[1] = kk - cum; } cum += h[j]; }
        }
        __syncthreads();
        prefix |= (unsigned)bc[0] << shift; kk = bc[1];
        __syncthreads();
    }
    int ceq = 0;
#pragma unroll
    for (int q = 0; q < 16; ++q) ceq += (v[q] == prefix) ? 1 : 0;
    int tot; int eqbase = block_excl_scan(ceq, wsum, tid, F.lane, F.wave, tot);
    unsigned selmask = 0u; int csel = 0;
#pragma unroll
    for (int q = 0; q < 16; ++q) { bool s = v[q] > prefix; if (v[q] == prefix) { s = eqbase < kk; ++eqbase; } if (s) { selmask |= 1u << q; ++csel; } }
    __syncthreads();
    int slot = block_excl_scan(csel, wsum, tid, F.lane, F.wave, tot);
    const int rowbase = (e * BATCH + b) * CAP;
#pragma unroll
    for (int q = 0; q < 16; ++q) { const int tok = b * SEQ + tid * 16 + q; int so = -1;
        if (selmask & (1u << q)) { const int row = rowbase + (slot < CAP ? slot : CAP - 1); so = row; F.TOK[row] = tok; F.GATEV[row] = __uint_as_float(v[q]); ++slot; }
        if (write_slotof) F.SLOTOF[(size_t)be * SEQ + tid * 16 + q] = so; }
    __syncthreads();
}
__device__ __forceinline__ void phase_p10(Frame& F) {
    const int gw = F.vcu * NWAVES + F.wave, NGW = F.G * NWAVES, lane = F.lane;
    constexpr int RB = 2;
    for (int m0 = gw; m0 < MTOK; m0 += RB * NGW) {
        f32x4 acc[RB][4]; int myslot[RB]; f32x4 x1[RB][4];
#pragma unroll
        for (int q = 0; q < RB; ++q) { const int mm = m0 + q * NGW; const size_t m = mm < MTOK ? mm : m0;
            myslot[q] = (lane < NE) ? F.SLOTOF[((m / SEQ) * NE + lane) * SEQ + (m % SEQ)] : -1;
#pragma unroll
            for (int j = 0; j < 4; ++j) { const v2u w = *(const v2u*)(F.X1B + m * DM + 4 * lane + 256 * j); x1[q][j] = (f32x4){bflo(w.x), bfhi(w.x), bflo(w.y), bfhi(w.y)}; acc[q][j] = (f32x4){0.f, 0.f, 0.f, 0.f}; } }
#pragma unroll 1
        for (int e = 0; e < NE; ++e) {
#pragma unroll
            for (int q = 0; q < RB; ++q) { const int r = __builtin_amdgcn_readlane(myslot[q], e);
                if (r >= 0) { const float g = F.GATEV[r]; const unsigned* yr = (const unsigned*)((const unsigned char*)F.YE + (size_t)r * DM) + lane;
#pragma unroll
                    for (int j = 0; j < 4; ++j) { const unsigned w = yr[64 * j];
                        const auto lo = __builtin_amdgcn_cvt_pk_f32_fp8(w, false), hi = __builtin_amdgcn_cvt_pk_f32_fp8(w, true);
                        acc[q][j] += (f32x4){lo[0], lo[1], hi[0], hi[1]} * g; } } } }
#pragma unroll
        for (int q = 0; q < RB; ++q) { const int m = m0 + q * NGW; if (m >= MTOK) break;
            const float* mod = F.MOD + (m / SEQ) * 6 * DM;
            float s = 0.f;
#pragma unroll
            for (int j = 0; j < 4; ++j) s += (acc[q][j].x * acc[q][j].x + acc[q][j].y * acc[q][j].y) + (acc[q][j].z * acc[q][j].z + acc[q][j].w * acc[q][j].w);
            const float rr = 1.f / sqrtf(wave_sum(s) * (1.f / DM) + RMS_EPS);
            float* orow = F.out + (size_t)m * DM;
#pragma unroll
            for (int j = 0; j < 4; ++j) { const int c = 4 * lane + 256 * j;
                const f32x4 g = *(const f32x4*)(F.g_post_ffn + c), gf = *(const f32x4*)(mod + 5 * DM + c);
                *(f32x4*)(orow + c) = x1[q][j] + gf * (acc[q][j] * rr * g); } }
    }
}
struct Args { const float* in[16]; float* out; unsigned char* ws; int ph_lo, ph_hi; };
__global__ void __launch_bounds__(NWAVES * 64, 2) mk_fwd(Args args) {
    extern __shared__ __attribute__((aligned(16))) unsigned char lds[];
    Frame F; F.ts_a = 0; F.ts_b = 0;
    F.lds = (LAS unsigned char*)lds;
    F.MISC = (volatile LAS unsigned*)(F.lds + MISC_OFF);
    F.tid = threadIdx.x; F.lane = F.tid & 63; F.wave = __builtin_amdgcn_readfirstlane(F.tid >> 6);
    F.G = gridDim.x; { const int bx = blockIdx.x; F.vcu = (F.G % 8 == 0) ? (bx % 8) * (F.G / 8) + bx / 8 : bx; }
    unsigned char* ws = args.ws;
    F.ctl = (gu32*)(ws + WS_CTL);
    F.x = args.in[0]; F.c = args.in[1]; F.w_ada = args.in[2]; F.b_ada = args.in[3]; F.g_pre_mix = args.in[4]; F.g_post_mix = args.in[5]; F.g_pre_ffn = args.in[6]; F.g_post_ffn = args.in[7];
    F.w_in = args.in[8]; F.dec_f = args.in[9]; F.dec_b = args.in[10]; F.w_out = args.in[11]; F.w_router = args.in[12]; F.w_gate = args.in[13]; F.w_up = args.in[14]; F.w_down = args.in[15];
    F.out = args.out;
    F.MOD = (float*)(ws + WS_MOD); F.AFF = (float*)(ws + WS_AFF); F.GATEV = (float*)(ws + WS_GATEV); F.LSE = (float*)(ws + WS_LSE); F.KV = (float*)(ws + WS_KV); F.MIXED = (float*)(ws + WS_MIXED);
    F.TOK = (int*)(ws + WS_TOK); F.SLOTOF = (int*)(ws + WS_SLOTOF);
    F.WIN = (bf16*)(ws + WS_WIN); F.WOUT = (bf16*)(ws + WS_WOUT); F.WGU = (bf16*)(ws + WS_WGU); F.WDN = (bf16*)(ws + WS_WDN); F.XN = (bf16*)(ws + WS_XN); F.PROJ = (bf16*)(ws + WS_PROJ);
    F.PREV = (bf16*)(ws + WS_PREV); F.ATTO = (bf16*)(ws + WS_ATTO); F.Y = (bf16*)(ws + WS_Y); F.XE = (bf16*)(ws + WS_XE); F.HH = (bf16*)(ws + WS_HH); F.YE = (bf16*)(ws + WS_YE); F.MIXB = (bf16*)(ws + WS_MIXED); F.X1B = (bf16*)(ws + WS_Y);
    for (int u = F.tid; u < (LDS_BYTES - LDSCTL_OFF) / 4; u += NWAVES * 64) ((LAS unsigned*)(F.lds + LDSCTL_OFF))[u] = 0u;
    __syncthreads();
    const int lo = args.ph_lo, hi = args.ph_hi;
    XcdBarrier bar; bar.bar = (unsigned*)(F.ctl + CW_BAR); bar.x = 0; bar.st = nullptr;
    if (hi - lo > 1) bar = xcd_barrier_post((unsigned*)(F.ctl + CW_BAR), F.MISC + 8);
#ifndef PHASE_MASK
#define PHASE_MASK 0xffff
#endif
#define IN(k) (((PHASE_MASK >> (k)) & 1) && lo <= (k) && (k) < hi)
#ifndef REP_MASK
#define REP_MASK 0
#endif
#define NREP(k) ((((REP_MASK) >> (k)) & 1) ? 2 : 1)
#ifndef TIME_PHASE
#define TIME_PHASE -1
#endif
#ifndef TIME_AMP
#define TIME_AMP 4
#endif
    unsigned long long t0_ = 0, t1_ = 0; int pos_ = 0;
#define TSTAMP() do { if (TIME_PHASE >= 0) { if (pos_ == TIME_PHASE) t0_ = rt_now(); if (pos_ == TIME_PHASE + 1) t1_ = rt_now(); } ++pos_; } while (0)
#define SEAM(k) do { if (IN(k) && IN((k) + 1)) xcd_barrier(bar); TSTAMP(); } while (0)
    TSTAMP();
    if (IN(0)) for (int rep_ = 0; rep_ < NREP(0); ++rep_) {
#if defined(TIME_SUB)
        const unsigned long long tks_ = rt_now();
#endif
        phase_p0a(F);
#if defined(TIME_SUB)
        if (TIME_SUB == 2) F.ts_b = rt_now(); if (TIME_SUB == 3) F.ts_a = rt_now();
        if (TIME_SUB == 4 && F.tid == 0) atomicMax((unsigned long long*)(F.ctl + 1216), rt_now() - tks_);
#endif
        wait_counter(F, F.ctl + CW_MODCNT, 6 * DM / 32); phase_p0b(F);
#if defined(TIME_SUB)
        if (TIME_SUB == 3) F.ts_b = rt_now();
        if (TIME_SUB == 5 && F.tid == 0) atomicMax((unsigned long long*)(F.ctl + 1216), rt_now() - tks_);
#endif
    } SEAM(0);
    if (IN(2)) for (int rep_ = 0; rep_ < NREP(2); ++rep_) {
        const int bx_ = (int)blockIdx.x, xcd_ = bx_ & 7, slot_ = bx_ >> 3; const bool split_ = (F.G & 31) == 0;
        if (split_ && (slot_ & 3) == 3) phase_side_convert(F, (slot_ >> 2) * 8 + xcd_, F.G >> 2, CI_P0, CI_P0 + CI_DEFER);
        else {
            if (!split_) { phase_side_convert(F, F.vcu, F.G, CI_P0, CI_N); __syncthreads(); }
            const int Gg = split_ ? (F.G >> 2) * 3 : F.G, cg = split_ ? (slot_ - (slot_ >> 2)) * 8 + xcd_ : bx_;
            pg8::Gemm g{F.XN, F.WIN, MTOK, NPROJ, DM, 0}; pg8::StaticOrder S; S.init(MTOK, NPROJ, Gg, cg);
            pg8::EpiBf16S E{F.PROJ, NPROJ, 0xffff, 0.125f, 0.125f * LOG2E, 1};
            pg8::gemm_phase<pg8::EpiBf16S, pg8::StaticOrder, true, true>(F.lds, g, S, E);
        }
    } SEAM(2);
    if (IN(3)) for (int rep_ = 0; rep_ < NREP(3); ++rep_) {
        const int bx_ = (int)blockIdx.x, xcd_ = bx_ & 7, slot_ = bx_ >> 3; const bool split_ = (F.G & 31) == 0;
        if (split_ && (slot_ & 3) == 3) phase_side_convert(F, (slot_ >> 2) * 8 + xcd_, F.G >> 2, CI_P0 + CI_DEFER, CI_N);
        else if (split_) { const int G0 = F.G, v0 = F.vcu; F.G = (G0 >> 2) * 3; F.vcu = xcd_ * (F.G >> 3) + (slot_ - (slot_ >> 2)); phase_p2(F); F.G = G0; F.vcu = v0; }
        else phase_p2(F);
    } SEAM(3);
    if (IN(4)) for (int rep_ = 0; rep_ < NREP(4); ++rep_) { phase_p3a(F); phase_p3b(F); } SEAM(4);
    if (IN(5)) for (int rep_ = 0; rep_ < NREP(5); ++rep_) { phase_p4(F); }
#ifdef PROBE_COPY_P4
    if (IN(5)) { asm volatile("" ::: "memory"); phase_p4(F); }
#endif
    SEAM(5);
    if (IN(6)) for (int rep_ = 0; rep_ < NREP(6); ++rep_) {
        pg8::Gemm g{F.Y, F.WOUT, MTOK, DM, DM, 0}; pg8::StaticOrder S; S.init(MTOK, DM, F.G, (int)blockIdx.x);
        pg8::EpiBf16S E{F.MIXB, DM, 0xffff, 1.f, 1.f, 0};
        pg8::gemm_phase<pg8::EpiBf16S, pg8::StaticOrder, true, true>(F.lds, g, S, E);
    } SEAM(6);
    if (IN(7)) for (int rep_ = 0; rep_ < NREP(7); ++rep_) { phase_p6(F); } SEAM(7);
    if (IN(10)) for (int rep_ = 0; rep_ < NREP(10); ++rep_) {
        pg8::Gemm g{F.XN, F.WGU, NSLOT, NE * 2 * FF, DM / 2, 2 * FF}; pg8::MoeOrder S{16, F.G, F.vcu};
        { pg8::Unit uu; int last = -1;
          for (int ui_ = 0; ui_ < 8; ++ui_) { if (!S.next(ui_, uu)) break; const int e_ = uu.pm >> 3, mt_ = uu.pm & 7, be_ = (mt_ >> 2) * NE + e_;
              if (be_ != last) { topk_pair(F, be_, (mt_ & 3) == 0 && (uu.pn & 15) == 0); last = be_; } }
          asm volatile("s_waitcnt vmcnt(0)" ::: "memory"); __syncthreads(); }
        pg8::EpiSwiGLU8 E{(unsigned char*)F.HH, FF};
        pg8::gemm_phase<pg8::EpiSwiGLU8, pg8::MoeOrder, true, true, true, true>(F.lds, g, S, E, F.TOK, (LAS int*)(F.lds + MISC_OFF + 256), 0x7a7a7a7a, 0x7f7f7f7f);
    } SEAM(10);
    if (IN(11)) for (int rep_ = 0; rep_ < NREP(11); ++rep_) {
        pg8::Gemm g{F.HH, F.WDN, NSLOT, NE * DM, FF / 2, DM}; pg8::MoeOrder S{4, F.G, F.vcu};
        pg8::EpiFp8 E{(unsigned char*)F.YE, DM, 3};
        pg8::gemm_phase<pg8::EpiFp8, pg8::MoeOrder, true, true, false, true>(F.lds, g, S, E, nullptr, nullptr, 0x7a7a7a7a, 0x7f7f7f7f);
    } SEAM(11);
    if (IN(12)) for (int rep_ = 0; rep_ < NREP(12); ++rep_) { phase_p10(F); }
    if (TIME_PHASE >= 0) {
        __syncthreads(); TSTAMP();
        if (blockIdx.x == 0 && F.tid == 0) {
#if defined(TIME_SUB)
            t0_ = F.ts_a; t1_ = F.ts_b;
            if (TIME_SUB >= 4) { t0_ = 0; t1_ = __hip_atomic_load((unsigned long long*)(F.ctl + 1216), __ATOMIC_RELAXED, __HIP_MEMORY_SCOPE_AGENT); }
#endif
            const unsigned long long target = rt_now() + (unsigned long long)TIME_AMP * (t1_ - t0_);
            while (rt_now() < target) __builtin_amdgcn_s_sleep(8); }
    }
#undef IN
#undef SEAM
}

extern "C" void kernel_launch(void* const* d_in, const int* in_sizes, int n_in, void* d_out, int out_size, void* d_ws, size_t ws_size, hipStream_t stream) {
    static int grid = 0;
    if (grid == 0) {
        if (n_in != 16 || in_sizes[0] != MTOK * DM || out_size != MTOK * DM || ws_size < WS_END) { fprintf(stderr, "kernel_launch: unexpected shapes: n_in %d in0 %d out %d ws %zu (need %zu)\n", n_in, n_in > 0 ? in_sizes[0] : -1, out_size, ws_size, (size_t)WS_END); grid = -1; return; }
        int dev = 0, cus = 0;
        if (hipGetDevice(&dev) != hipSuccess || hipDeviceGetAttribute(&cus, hipDeviceAttributeMultiprocessorCount, dev) != hipSuccess) { grid = -1; return; }
        if (hipFuncSetAttribute((const void*)mk_fwd, hipFuncAttributeMaxDynamicSharedMemorySize, LDS_BYTES) != hipSuccess) { fprintf(stderr, "kernel_launch: hipFuncSetAttribute failed\n"); grid = -1; return; }
        int per_cu = 0;
        if (hipOccupancyMaxActiveBlocksPerMultiprocessor(&per_cu, (const void*)mk_fwd, NWAVES * 64, LDS_BYTES) != hipSuccess || per_cu < 1) fprintf(stderr, "kernel_launch: occupancy query says %d blocks per CU\n", per_cu);
        (void)hipGetLastError();
        grid = cus;
    }
    if (grid < 0) return;
    (void)hipMemsetAsync((char*)d_ws + WS_CTL, 0, CTL_ZERO_BYTES, stream);
    Args a{};
    for (int i = 0; i < 16; ++i) a.in[i] = (const float*)d_in[i];
    a.out = (float*)d_out; a.ws = (unsigned char*)d_ws;
#if MK_ONE_LAUNCH
    a.ph_lo = 0; a.ph_hi = NPHASE;
    hipLaunchKernelGGL(mk_fwd, dim3(grid), dim3(NWAVES * 64), LDS_BYTES, stream, a);
#else
    for (int p = 0; p < NPHASE; ++p) { a.ph_lo = p; a.ph_hi = p + 1; hipLaunchKernelGGL(mk_fwd, dim3(grid), dim3(NWAVES * 64), LDS_BYTES, stream, a); }
#endif
}
```

```cpp
#include <hip/hip_runtime.h>
#include <cstdio>
#include <cstdint>
namespace pg8 {
#define PG8_LAS __attribute__((address_space(3)))
typedef unsigned short bf16_t;
typedef short bf16x8 __attribute__((ext_vector_type(8)));
typedef float f32x4 __attribute__((ext_vector_type(4)));
typedef unsigned u32x4 __attribute__((ext_vector_type(4)));
constexpr int BM = 256, BK = 64, HALF = 128, HTB = HALF * BK * 2  , STAGE_BYTES = 8 * HTB, NXCD = 8, WGM = 8;

__host__ __device__ __forceinline__ int lds_byte(int r, int c) { const int st = (r >> 4) * 2 + (c >> 5), rr = r & 15, cc = c & 31, ob = rr * 64 + cc * 2; return st * 1024 + (ob ^ (((ob >> 9) & 1) << 5)); }
__host__ __device__ __forceinline__ void stage_rc(int b, int& R, int& C) { const int st = b / 1024, sb = b % 1024, swz = sb ^ (((sb >> 9) & 1) << 5); R = (st >> 1) * 16 + swz / 64; C = (st & 1) * 32 + (swz % 64) / 2; }
__host__ __device__ __forceinline__ int perm32(int rho) { const int n = rho >> 4, i = rho & 15; return 8 * (i >> 2) + 4 * n + (i & 3); }

struct Unit { int pm, pn; };
struct Gemm { const bf16_t* A; const bf16_t* Bt; int M, N, K; int bblk_rows; };

struct StaticOrder {
    int nM, nN, nwg, G, c;
    __host__ __device__ void init(int M, int N, int G_, int c_) { nM = M / BM; nN = N / BM; nwg = nM * nN; G = G_; c = c_; }
    __host__ __device__ bool next(int i, Unit& u) const {
        const long L = (long)i * G + c; if (L >= nwg) return false;
        int wgid = (int)L; { const int q = nwg / NXCD, r = nwg % NXCD, xcd = wgid % NXCD, off = wgid / NXCD; wgid = (xcd < r ? xcd * (q + 1) : r * (q + 1) + (xcd - r) * q) + off; }
        const int nig = WGM * nN, gid = wgid / nig, fm = gid * WGM, gsz = (nM - fm) < WGM ? (nM - fm) : WGM;
        u.pm = fm + ((wgid % nig) % gsz); u.pn = (wgid % nig) / gsz; return true;
    }
    __device__ __forceinline__ void a_ready(const Unit&) const {}
    __device__ __forceinline__ void done(const Unit&) const {}
};

__device__ __forceinline__ unsigned cvt_pk_bf16(float lo, float hi) { unsigned r; asm volatile("v_cvt_pk_bf16_f32 %0, %1, %2" : "=v"(r) : "v"(lo), "v"(hi)); return r; }
typedef float f32x2 __attribute__((ext_vector_type(2)));
typedef unsigned u32x2 __attribute__((ext_vector_type(2)));
__device__ __forceinline__ void st16_wt(void* p, u32x4 v) { asm volatile("global_store_dwordx4 %0, %1, off sc1\n\ts_nop 1" :: "v"(p), "v"(v) : "memory"); }
typedef int i32x4 __attribute__((ext_vector_type(4)));
typedef int i32x8 __attribute__((ext_vector_type(8)));
__device__ __forceinline__ i32x8 pg8_cat(bf16x8 lo, bf16x8 hi) { const i32x4 a = __builtin_bit_cast(i32x4, lo), b = __builtin_bit_cast(i32x4, hi); return __builtin_shufflevector(a, b, 0, 1, 2, 3, 4, 5, 6, 7); }
__device__ __forceinline__ unsigned cvt4_fp8(float a, float b, float c, float d) { unsigned w = 0u; w = __builtin_amdgcn_cvt_pk_fp8_f32(a, b, w, false); w = __builtin_amdgcn_cvt_pk_fp8_f32(c, d, w, true); return w; }
constexpr float LOG2E_F = 1.4426950408889634f;
struct EpiF32 {
    static constexpr bool PERM = false, AFTER_DRAIN = false;
    float* C; int ldc;
    __device__ __forceinline__ void operator()(const f32x4 (&acc)[2][2][4][2], const Unit& u, int wr, int wc, int fr, int fq) const {
        const int row0 = u.pm * BM + wr * 64 + fr, col0 = u.pn * BM + wc * 32 + 4 * fq;
#pragma unroll
        for (int ai = 0; ai < 2; ++ai)
#pragma unroll
            for (int m = 0; m < 4; ++m) { float* rowp = C + (size_t)(row0 + ai * HALF + m * 16) * ldc + col0;
#pragma unroll
                for (int bj = 0; bj < 2; ++bj)
#pragma unroll
                    for (int n = 0; n < 2; ++n) *(f32x4*)(rowp + bj * HALF + n * 16) = acc[ai][bj][m][n]; }
    }
};
struct EpiBf16S {
    static constexpr bool PERM = true, AFTER_DRAIN = false;
    bf16_t* O; int ldc; int pn_mask; float s_rk, s_aq; int proj;
    __device__ __forceinline__ void operator()(const f32x4 (&acc)[2][2][4][2], const Unit& u, int wr, int wc, int fr, int fq) const {
        const int pn = u.pn & pn_mask;
        const int row0 = u.pm * BM + wr * 64 + fr, col0 = pn * BM + wc * 32 + 8 * fq;
#pragma unroll
        for (int ai = 0; ai < 2; ++ai)
#pragma unroll
            for (int m = 0; m < 4; ++m) { bf16_t* rowp = O + (size_t)(row0 + ai * HALF + m * 16) * ldc + col0;
#pragma unroll
                for (int bj = 0; bj < 2; ++bj) { const f32x4 v0 = acc[ai][bj][m][0], v1 = acc[ai][bj][m][1];
                    u32x4 w; w.x = cvt_pk_bf16(v0[0], v0[1]); w.y = cvt_pk_bf16(v0[2], v0[3]); w.z = cvt_pk_bf16(v1[0], v1[1]); w.w = cvt_pk_bf16(v1[2], v1[3]);
                    *(u32x4*)(rowp + bj * HALF) = w; } }
    }
};
struct EpiSwiGLU {
    static constexpr bool PERM = true, AFTER_DRAIN = false;
    bf16_t* O; int ldc;
    __device__ __forceinline__ float act(float g, float up) const { return g * up * __builtin_amdgcn_rcpf(1.f + __builtin_amdgcn_exp2f(-g * LOG2E_F)); }
    __device__ __forceinline__ void operator()(const f32x4 (&acc)[2][2][4][2], const Unit& u, int wr, int wc, int fr, int fq) const {
        const int row0 = u.pm * BM + wr * 64 + fr, col0 = (u.pn & 15) * HALF + wc * 32 + 8 * fq;
#pragma unroll
        for (int ai = 0; ai < 2; ++ai)
#pragma unroll
            for (int m = 0; m < 4; ++m) { bf16_t* rowp = O + (size_t)(row0 + ai * HALF + m * 16) * ldc + col0;
                const f32x4 g0 = acc[ai][0][m][0], g1 = acc[ai][0][m][1], u0 = acc[ai][1][m][0], u1 = acc[ai][1][m][1];
                u32x4 w; w.x = cvt_pk_bf16(act(g0[0], u0[0]), act(g0[1], u0[1])); w.y = cvt_pk_bf16(act(g0[2], u0[2]), act(g0[3], u0[3]));
                w.z = cvt_pk_bf16(act(g1[0], u1[0]), act(g1[1], u1[1])); w.w = cvt_pk_bf16(act(g1[2], u1[2]), act(g1[3], u1[3]));
                *(u32x4*)rowp = w; }
    }
};
struct EpiFp8 {
    static constexpr bool PERM = true, AFTER_DRAIN = false;
    unsigned char* O; int ldc; int pn_mask;
    __device__ __forceinline__ void operator()(const f32x4 (&acc)[2][2][4][2], const Unit& u, int wr, int wc, int fr, int fq) const {
        const int pn = u.pn & pn_mask; const int row0 = u.pm * BM + wr * 64 + fr, col0 = pn * BM + wc * 32 + 8 * fq;
#pragma unroll
        for (int ai = 0; ai < 2; ++ai)
#pragma unroll
            for (int m = 0; m < 4; ++m) { unsigned char* rowp = O + (size_t)(row0 + ai * HALF + m * 16) * ldc + col0;
#pragma unroll
                for (int bj = 0; bj < 2; ++bj) { const f32x4 v0 = acc[ai][bj][m][0], v1 = acc[ai][bj][m][1];
                    u32x2 w; w.x = cvt4_fp8(v0[0], v0[1], v0[2], v0[3]); w.y = cvt4_fp8(v1[0], v1[1], v1[2], v1[3]); *(u32x2*)(rowp + bj * HALF) = w; } }
    }
};
struct EpiSwiGLU8 {
    static constexpr bool PERM = true, AFTER_DRAIN = false;
    unsigned char* O; int ldc;
    __device__ __forceinline__ float act(float g, float up) const { return g * up * __builtin_amdgcn_rcpf(1.f + __builtin_amdgcn_exp2f(g)); }
    __device__ __forceinline__ void operator()(const f32x4 (&acc)[2][2][4][2], const Unit& u, int wr, int wc, int fr, int fq) const {
        const int row0 = u.pm * BM + wr * 64 + fr, col0 = (u.pn & 15) * HALF + wc * 32 + 8 * fq;
#pragma unroll
        for (int ai = 0; ai < 2; ++ai)
#pragma unroll
            for (int m = 0; m < 4; ++m) { unsigned char* rowp = O + (size_t)(row0 + ai * HALF + m * 16) * ldc + col0;
                const f32x4 g0 = acc[ai][0][m][0], g1 = acc[ai][0][m][1], u0 = acc[ai][1][m][0], u1 = acc[ai][1][m][1];
                u32x2 w; w.x = cvt4_fp8(act(g0[0], u0[0]), act(g0[1], u0[1]), act(g0[2], u0[2]), act(g0[3], u0[3]));
                w.y = cvt4_fp8(act(g1[0], u1[0]), act(g1[1], u1[1]), act(g1[2], u1[2]), act(g1[3], u1[3]));
                *(u32x2*)rowp = w; }
    }
};
struct MoeOrder {
    int ntile, G, vcu;
    __device__ __forceinline__ bool next(int i, Unit& u) const {
        const int total = 16 * 8 * ntile; int L;
        if ((G & 7) == 0) { const int g8 = G >> 3, x = vcu / g8, c = vcu % g8, share = total >> 3, l = i * g8 + c; if (l >= share) return false; L = x * share + l; }
        else { L = i * G + vcu; if (L >= total) return false; }
        const int e = L / (8 * ntile), rem = L % (8 * ntile);
        u.pm = e * 8 + (rem & 7); u.pn = e * ntile + (rem >> 3); return true;
    }
    __device__ __forceinline__ void a_ready(const Unit&) const {}
    __device__ __forceinline__ void done(const Unit&) const {}
};
template <bool B_> struct BoolTag { static constexpr bool value = B_; };
template <class Epi, class Sched, bool ALIGN_EPI = false, bool SP2 = false, bool GATHER = false, bool FP8 = false>
__device__ __forceinline__ void gemm_phase(PG8_LAS unsigned char* lds, const Gemm g, const Sched& S, const Epi& E, const int* rowmap = nullptr, PG8_LAS int* ldsrow = nullptr, int scale_w = 0x7f7f7f7f, int scale_x = 0x7f7f7f7f, const PG8_LAS int* lrows = nullptr) {
    const int tid = threadIdx.x, wid = __builtin_amdgcn_readfirstlane(tid >> 6), lane = tid & 63, wr = wid >> 2, wc = wid & 3, fr = lane & 15, fq = lane >> 4;
    const int K = g.K, nt = K / BK;
    unsigned voffA[2], voffB[2];
#pragma unroll
    for (int i = 0; i < 2; ++i) { int R, C; stage_rc(tid * 16 + i * 8192, R, C); const int Rb = Epi::PERM ? ((R & ~31) + perm32(R & 31)) : R;
        voffA[i] = (unsigned)(R * K + C) * 2u; voffB[i] = g.bblk_rows ? (unsigned)((C >> 4) * (g.bblk_rows >> 7) * 4096 + Rb * 32 + ((C >> 3) & 1) * 16) : (unsigned)(Rb * K + C) * 2u; }
    unsigned gC[2][2] = {{0u, 0u}, {0u, 0u}}, gN[2][2] = {{0u, 0u}, {0u, 0u}}; int gR[2] = {0, 0}; unsigned gCb[2] = {0u, 0u};
    if constexpr (GATHER) {
#pragma unroll
        for (int i = 0; i < 2; ++i) { int R, C; stage_rc(tid * 16 + i * 8192, R, C); gR[i] = R; gCb[i] = (unsigned)C * 2u; }
        Unit uu;
        int e0_ = -1;
        for (int ui_ = 0; ui_ < 8; ++ui_) { if (!S.next(ui_, uu)) break; if (e0_ < 0) e0_ = uu.pm >> 3;
            if (tid < 256) ldsrow[ui_ * 256 + tid] = lrows ? lrows[((uu.pm >> 3) != e0_ ? 1024 : 0) + (uu.pm & 3) * 256 + tid] : rowmap[uu.pm * BM + tid]; }
        __syncthreads();
#pragma unroll
        for (int h = 0; h < 2; ++h)
#pragma unroll
            for (int i = 0; i < 2; ++i) gC[h][i] = (unsigned)ldsrow[h * HALF + gR[i]] * (unsigned)(K * 2) + gCb[i];
    }
    const size_t kstep = (size_t)(BK * 2);
    const size_t hstep = (size_t)HALF * K * 2;
    const size_t tstep = 2 * hstep;
    const size_t kstepB = g.bblk_rows ? (size_t)g.bblk_rows * 128 : kstep, hstepB = g.bblk_rows ? (size_t)4096 : hstep;
    const int ntl_ = g.bblk_rows ? g.bblk_rows / BM : 1;
#define PG8_BBASE(pn_) (g.bblk_rows ? (const char*)g.Bt + (size_t)((pn_) / ntl_) * ((size_t)g.bblk_rows * K * 2) + (size_t)((pn_) % ntl_) * 8192 : (const char*)g.Bt + (size_t)(pn_) * tstep)
    const unsigned ldsw = (unsigned)wid * 1024u;
    const int aoff = lds_byte(wr * 64 + fr, fq * 8), boff = lds_byte(wc * 32 + fr, fq * 8);
    constexpr int KINC = 1024;
#define PG8_SA(b, h) (((b) * 2 + (h)) * HTB)
#define PG8_SB(b, h) ((4 + (b) * 2 + (h)) * HTB)
#define PG8_STAGE(bufoff, gbase, voff) do { _Pragma("unroll") for (int _i = 0; _i < 2; ++_i) \
        __builtin_amdgcn_global_load_lds((const unsigned*)((const char*)(gbase) + (voff)[_i]), (PG8_LAS unsigned*)(lds + (bufoff) + ldsw + _i * 8192), 16, 0, 0); } while (0)
#define PG8_STAGE_A(bufoff, isnext, half, koff) do { \
        if constexpr (GATHER) { _Pragma("unroll") for (int _i = 0; _i < 2; ++_i) { const unsigned vo_ = (isnext) ? gN[half][_i] : gC[half][_i]; \
            __builtin_amdgcn_global_load_lds((const unsigned*)((const char*)g.A + (koff) + vo_), (PG8_LAS unsigned*)(lds + (bufoff) + ldsw + _i * 8192), 16, 0, 0); } } \
        else { const char* b_ = ((isnext) ? nA : cA) + (half) * hstep + (koff); PG8_STAGE(bufoff, b_, voffA); } } while (0)
#define PG8_LD16(p) (*(const PG8_LAS i32x4*)(p))
#define PG8_LDA(dst, b, h) do { if constexpr (FP8) { _Pragma("unroll") for (int m = 0; m < 4; ++m) { const PG8_LAS unsigned char* p_ = lds + PG8_SA(b, h) + aoff + m * 2048; dst##8[m] = __builtin_shufflevector(PG8_LD16(p_), PG8_LD16(p_ + KINC), 0, 1, 2, 3, 4, 5, 6, 7); } } \
        else { _Pragma("unroll") for (int m = 0; m < 4; ++m) _Pragma("unroll") for (int k = 0; k < 2; ++k) dst[m][k] = *(const PG8_LAS bf16x8*)(lds + PG8_SA(b, h) + aoff + m * 2048 + k * 1024); } } while (0)
#define PG8_LDB(dst, b, h) do { if constexpr (FP8) { _Pragma("unroll") for (int n = 0; n < 2; ++n) { const PG8_LAS unsigned char* p_ = lds + PG8_SB(b, h) + boff + n * 2048; dst##8[n] = __builtin_shufflevector(PG8_LD16(p_), PG8_LD16(p_ + KINC), 0, 1, 2, 3, 4, 5, 6, 7); } } \
        else { _Pragma("unroll") for (int n = 0; n < 2; ++n) _Pragma("unroll") for (int k = 0; k < 2; ++k) dst[n][k] = *(const PG8_LAS bf16x8*)(lds + PG8_SB(b, h) + boff + n * 2048 + k * 1024); } } while (0)
#define PG8_MMA8(A_, At8_, Bt8_) asm volatile( \
        "v_mfma_scale_f32_16x16x128_f8f6f4 %0, %12, %8, %0, %14, %15 op_sel_hi:[0,0,0]\n\t" \
        "v_mfma_scale_f32_16x16x128_f8f6f4 %1, %13, %8, %1, %14, %15 op_sel_hi:[0,0,0]\n\t" \
        "v_mfma_scale_f32_16x16x128_f8f6f4 %2, %12, %9, %2, %14, %15 op_sel_hi:[0,0,0]\n\t" \
        "v_mfma_scale_f32_16x16x128_f8f6f4 %3, %13, %9, %3, %14, %15 op_sel_hi:[0,0,0]\n\t" \
        "v_mfma_scale_f32_16x16x128_f8f6f4 %4, %12, %10, %4, %14, %15 op_sel_hi:[0,0,0]\n\t" \
        "v_mfma_scale_f32_16x16x128_f8f6f4 %5, %13, %10, %5, %14, %15 op_sel_hi:[0,0,0]\n\t" \
        "v_mfma_scale_f32_16x16x128_f8f6f4 %6, %12, %11, %6, %14, %15 op_sel_hi:[0,0,0]\n\t" \
        "v_mfma_scale_f32_16x16x128_f8f6f4 %7, %13, %11, %7, %14, %15 op_sel_hi:[0,0,0]\n\t" \
        "s_nop 3" \
        : "+v"(A_[0][0]), "+v"(A_[0][1]), "+v"(A_[1][0]), "+v"(A_[1][1]), "+v"(A_[2][0]), "+v"(A_[2][1]), "+v"(A_[3][0]), "+v"(A_[3][1]) \
        : "v"(At8_[0]), "v"(At8_[1]), "v"(At8_[2]), "v"(At8_[3]), "v"(Bt8_[0]), "v"(Bt8_[1]), "v"(scale_w), "v"(scale_x))
#define PG8_MMA8Z(A_, At8_, Bt8_) asm volatile( \
        "v_mfma_scale_f32_16x16x128_f8f6f4 %0, %12, %8, 0, %14, %15 op_sel_hi:[0,0,0]\n\t" \
        "v_mfma_scale_f32_16x16x128_f8f6f4 %1, %13, %8, 0, %14, %15 op_sel_hi:[0,0,0]\n\t" \
        "v_mfma_scale_f32_16x16x128_f8f6f4 %2, %12, %9, 0, %14, %15 op_sel_hi:[0,0,0]\n\t" \
        "v_mfma_scale_f32_16x16x128_f8f6f4 %3, %13, %9, 0, %14, %15 op_sel_hi:[0,0,0]\n\t" \
        "v_mfma_scale_f32_16x16x128_f8f6f4 %4, %12, %10, 0, %14, %15 op_sel_hi:[0,0,0]\n\t" \
        "v_mfma_scale_f32_16x16x128_f8f6f4 %5, %13, %10, 0, %14, %15 op_sel_hi:[0,0,0]\n\t" \
        "v_mfma_scale_f32_16x16x128_f8f6f4 %6, %12, %11, 0, %14, %15 op_sel_hi:[0,0,0]\n\t" \
        "v_mfma_scale_f32_16x16x128_f8f6f4 %7, %13, %11, 0, %14, %15 op_sel_hi:[0,0,0]\n\t" \
        "s_nop 3" \
        : "+v"(A_[0][0]), "+v"(A_[0][1]), "+v"(A_[1][0]), "+v"(A_[1][1]), "+v"(A_[2][0]), "+v"(A_[2][1]), "+v"(A_[3][0]), "+v"(A_[3][1]) \
        : "v"(At8_[0]), "v"(At8_[1]), "v"(At8_[2]), "v"(At8_[3]), "v"(Bt8_[0]), "v"(Bt8_[1]), "v"(scale_w), "v"(scale_x))
#define PG8_MMA16(A_, At_, Bt_) asm volatile( \
        "v_mfma_f32_16x16x32_bf16 %0, %16, %8, %0\n\t" \
        "v_mfma_f32_16x16x32_bf16 %1, %18, %8, %1\n\t" \
        "v_mfma_f32_16x16x32_bf16 %2, %16, %10, %2\n\t" \
        "v_mfma_f32_16x16x32_bf16 %3, %18, %10, %3\n\t" \
        "v_mfma_f32_16x16x32_bf16 %4, %16, %12, %4\n\t" \
        "v_mfma_f32_16x16x32_bf16 %5, %18, %12, %5\n\t" \
        "v_mfma_f32_16x16x32_bf16 %6, %16, %14, %6\n\t" \
        "v_mfma_f32_16x16x32_bf16 %7, %18, %14, %7\n\t" \
        "v_mfma_f32_16x16x32_bf16 %0, %17, %9, %0\n\t" \
        "v_mfma_f32_16x16x32_bf16 %1, %19, %9, %1\n\t" \
        "v_mfma_f32_16x16x32_bf16 %2, %17, %11, %2\n\t" \
        "v_mfma_f32_16x16x32_bf16 %3, %19, %11, %3\n\t" \
        "v_mfma_f32_16x16x32_bf16 %4, %17, %13, %4\n\t" \
        "v_mfma_f32_16x16x32_bf16 %5, %19, %13, %5\n\t" \
        "v_mfma_f32_16x16x32_bf16 %6, %17, %15, %6\n\t" \
        "v_mfma_f32_16x16x32_bf16 %7, %19, %15, %7\n\t" \
        "s_nop 3" \
        : "+v"(A_[0][0]), "+v"(A_[0][1]), "+v"(A_[1][0]), "+v"(A_[1][1]), "+v"(A_[2][0]), "+v"(A_[2][1]), "+v"(A_[3][0]), "+v"(A_[3][1]) \
        : "v"(At_[0][0]), "v"(At_[0][1]), "v"(At_[1][0]), "v"(At_[1][1]), "v"(At_[2][0]), "v"(At_[2][1]), "v"(At_[3][0]), "v"(At_[3][1]), "v"(Bt_[0][0]), "v"(Bt_[0][1]), "v"(Bt_[1][0]), "v"(Bt_[1][1]))
#define PG8_MMA16Z(A_, At_, Bt_) asm volatile( \
        "v_mfma_f32_16x16x32_bf16 %0, %16, %8, 0\n\t" \
        "v_mfma_f32_16x16x32_bf16 %1, %18, %8, 0\n\t" \
        "v_mfma_f32_16x16x32_bf16 %2, %16, %10, 0\n\t" \
        "v_mfma_f32_16x16x32_bf16 %3, %18, %10, 0\n\t" \
        "v_mfma_f32_16x16x32_bf16 %4, %16, %12, 0\n\t" \
        "v_mfma_f32_16x16x32_bf16 %5, %18, %12, 0\n\t" \
        "v_mfma_f32_16x16x32_bf16 %6, %16, %14, 0\n\t" \
        "v_mfma_f32_16x16x32_bf16 %7, %18, %14, 0\n\t" \
        "v_mfma_f32_16x16x32_bf16 %0, %17, %9, %0\n\t" \
        "v_mfma_f32_16x16x32_bf16 %1, %19, %9, %1\n\t" \
        "v_mfma_f32_16x16x32_bf16 %2, %17, %11, %2\n\t" \
        "v_mfma_f32_16x16x32_bf16 %3, %19, %11, %3\n\t" \
        "v_mfma_f32_16x16x32_bf16 %4, %17, %13, %4\n\t" \
        "v_mfma_f32_16x16x32_bf16 %5, %19, %13, %5\n\t" \
        "v_mfma_f32_16x16x32_bf16 %6, %17, %15, %6\n\t" \
        "v_mfma_f32_16x16x32_bf16 %7, %19, %15, %7\n\t" \
        "s_nop 3" \
        : "+v"(A_[0][0]), "+v"(A_[0][1]), "+v"(A_[1][0]), "+v"(A_[1][1]), "+v"(A_[2][0]), "+v"(A_[2][1]), "+v"(A_[3][0]), "+v"(A_[3][1]) \
        : "v"(At_[0][0]), "v"(At_[0][1]), "v"(At_[1][0]), "v"(At_[1][1]), "v"(At_[2][0]), "v"(At_[2][1]), "v"(At_[3][0]), "v"(At_[3][1]), "v"(Bt_[0][0]), "v"(Bt_[0][1]), "v"(Bt_[1][0]), "v"(Bt_[1][1]))
#define PG8_MMAZ(ZF, ai, bj, At, Bt) do { __builtin_amdgcn_s_setprio(1); \
        if constexpr (FP8) { if (ZF) { PG8_MMA8Z(acc[ai][bj], At##8, Bt##8); } else { PG8_MMA8(acc[ai][bj], At##8, Bt##8); } } \
        else { if (ZF) { PG8_MMA16Z(acc[ai][bj], At, Bt); } else { PG8_MMA16(acc[ai][bj], At, Bt); } } \
        __builtin_amdgcn_s_setprio(0); } while (0)
#define PG8_MMA(ai, bj, At, Bt) do { __builtin_amdgcn_s_setprio(1); \
        if constexpr (FP8) { PG8_MMA8(acc[ai][bj], At##8, Bt##8); } \
        else { PG8_MMA16(acc[ai][bj], At, Bt); } \
        __builtin_amdgcn_s_setprio(0); } while (0)
#define PG8_WAIT_V(n) asm volatile("s_waitcnt vmcnt(" #n ")" ::: "memory")
#define PG8_WAIT_L(n) asm volatile("s_waitcnt lgkmcnt(" #n ")" ::: "memory")
#define PG8_BAR __builtin_amdgcn_s_barrier()
#define PG8_SCHED __builtin_amdgcn_sched_barrier(0)
    Unit cur, nxt; int ui = 0;
    if (!S.next(0, cur)) return;
    f32x4 acc[2][2][4][2];
#define PG8_ACC_UNDEF() do { _Pragma("unroll") for (int a = 0; a < 2; ++a) _Pragma("unroll") for (int b = 0; b < 2; ++b) _Pragma("unroll") for (int m = 0; m < 4; ++m) _Pragma("unroll") for (int n = 0; n < 2; ++n) \
        asm volatile("" : "=v"(acc[a][b][m][n])); } while (0)
    if constexpr (SP2) PG8_ACC_UNDEF();
    if constexpr (!SP2) {
#pragma unroll
    for (int a = 0; a < 2; ++a)
#pragma unroll
        for (int b = 0; b < 2; ++b)
#pragma unroll
            for (int m = 0; m < 4; ++m)
#pragma unroll
                for (int n = 0; n < 2; ++n) acc[a][b][m][n] = (f32x4){0.f, 0.f, 0.f, 0.f};
    }
    bf16x8 At[4][2], B0[2][2], B1[2][2]; i32x8 At8[4], B08[2], B18[2]; (void)At; (void)B0; (void)B1; (void)At8; (void)B08; (void)B18;
    const char* cA = (const char*)g.A + (size_t)cur.pm * tstep; const char* cB = PG8_BBASE(cur.pn);
    S.a_ready(cur);
    const char* nA = cA; (void)nA;
    if constexpr (SP2) {
        PG8_STAGE(PG8_SB(0, 0), cB, voffB); PG8_STAGE(PG8_SB(0, 1), cB + hstepB, voffB); PG8_STAGE_A(PG8_SA(0, 0), false, 0, (size_t)0); PG8_STAGE_A(PG8_SA(0, 1), false, 1, (size_t)0);
        if (wr == 1) PG8_BAR;
        PG8_WAIT_V(2); PG8_BAR;
        PG8_STAGE(PG8_SB(1, 0), cB + kstepB, voffB); PG8_STAGE_A(PG8_SA(1, 0), false, 0, kstep); PG8_STAGE(PG8_SB(1, 1), cB + hstepB + kstepB, voffB);
        PG8_WAIT_V(6); PG8_BAR;
    } else {
        PG8_STAGE(PG8_SB(0, 0), cB, voffB); PG8_STAGE_A(PG8_SA(0, 0), false, 0, (size_t)0); PG8_STAGE(PG8_SB(0, 1), cB + hstepB, voffB); PG8_STAGE_A(PG8_SA(0, 1), false, 1, (size_t)0);
        if (wr == 1) PG8_BAR;
        PG8_WAIT_V(4); PG8_BAR;
        PG8_STAGE(PG8_SB(1, 0), cB + kstepB, voffB); PG8_STAGE_A(PG8_SA(1, 0), false, 0, kstep); PG8_STAGE(PG8_SB(1, 1), cB + hstepB + kstepB, voffB);
        PG8_WAIT_V(6); PG8_BAR;
    }
    for (;;) {
        const bool has_next = S.next(ui + 1, nxt);
        if constexpr (GATHER) {
#pragma unroll
            for (int h = 0; h < 2; ++h)
#pragma unroll
                for (int i = 0; i < 2; ++i) gN[h][i] = has_next ? (unsigned)ldsrow[(ui + 1) * 256 + h * HALF + gR[i]] * (unsigned)(K * 2) + gCb[i] : gC[h][i];
        }
        const char* nA = has_next ? (const char*)g.A + (size_t)nxt.pm * tstep : cA; const char* nB = has_next ? PG8_BBASE(nxt.pn) : cB;
        for (int t = 0; t < nt; t += 2) { const bool ZF = (t == 0);
            const bool last = (t == nt - 2);
            const size_t k1 = (size_t)(t + 1) * kstep, k2 = last ? (size_t)0 : (size_t)(t + 2) * kstep, k3 = k2 + kstep;
            const char* a1 = cA + (size_t)(t + 1) * kstep;
            const char* a2 = last ? nA : cA + (size_t)(t + 2) * kstep; const char* b2 = last ? nB : cB + (size_t)(t + 2) * kstepB;
            const char* a3 = a2 + kstep; const char* b3 = b2 + kstepB;
            if (last && has_next) S.a_ready(nxt);
            if constexpr (SP2) {
            PG8_LDB(B0, 0, 0); PG8_LDB(B1, 0, 1); PG8_SCHED; PG8_LDA(At, 0, 0); PG8_STAGE_A(PG8_SA(1, 1), false, 1, k1);
            PG8_WAIT_V(8); PG8_WAIT_L(0); PG8_BAR; PG8_MMAZ(ZF, 0, 0, At, B0); PG8_MMAZ(ZF, 0, 1, At, B1); PG8_BAR; PG8_SCHED;
            PG8_LDA(At, 0, 1); PG8_STAGE(PG8_SB(0, 0), b2, voffB); PG8_STAGE(PG8_SB(0, 1), b2 + hstepB, voffB); PG8_STAGE_A(PG8_SA(0, 0), last, 0, k2);
            PG8_WAIT_V(8); PG8_WAIT_L(0); PG8_BAR; PG8_MMAZ(ZF, 1, 0, At, B0); PG8_MMAZ(ZF, 1, 1, At, B1); PG8_BAR; PG8_SCHED;
            PG8_LDB(B0, 1, 0); PG8_LDB(B1, 1, 1); PG8_SCHED; PG8_LDA(At, 1, 0); PG8_STAGE_A(PG8_SA(0, 1), last, 1, k2);
            PG8_WAIT_V(8); PG8_WAIT_L(0); PG8_BAR; PG8_MMA(0, 0, At, B0); PG8_MMA(0, 1, At, B1); PG8_BAR; PG8_SCHED;
            PG8_LDA(At, 1, 1); PG8_STAGE(PG8_SB(1, 0), b3, voffB); PG8_STAGE(PG8_SB(1, 1), b3 + hstepB, voffB); PG8_STAGE_A(PG8_SA(1, 0), last, 0, k3);
            PG8_WAIT_V(8); PG8_WAIT_L(0); PG8_BAR; PG8_MMA(1, 0, At, B0); PG8_MMA(1, 1, At, B1); PG8_BAR; PG8_SCHED;
            } else {
            PG8_LDB(B0, 0, 0); PG8_SCHED; PG8_LDA(At, 0, 0); PG8_STAGE_A(PG8_SA(1, 1), false, 1, k1);
            PG8_WAIT_L(8); PG8_BAR; PG8_WAIT_L(0); PG8_MMA(0, 0, At, B0); PG8_BAR; PG8_SCHED;
            PG8_LDB(B1, 0, 1); PG8_STAGE(PG8_SB(0, 0), b2, voffB);
            PG8_BAR; PG8_WAIT_L(0); PG8_MMA(0, 1, At, B1); PG8_BAR;
            PG8_LDA(At, 0, 1); PG8_STAGE_A(PG8_SA(0, 0), last, 0, k2);
            PG8_BAR; PG8_WAIT_L(0); PG8_MMA(1, 0, At, B0); PG8_BAR; PG8_SCHED;
            PG8_STAGE(PG8_SB(0, 1), b2 + hstepB, voffB);
            PG8_WAIT_V(6); PG8_BAR; PG8_MMA(1, 1, At, B1); PG8_BAR;
            PG8_LDB(B0, 1, 0); PG8_SCHED; PG8_LDA(At, 1, 0); PG8_STAGE_A(PG8_SA(0, 1), last, 1, k2);
            PG8_WAIT_L(8); PG8_BAR; PG8_WAIT_L(0); PG8_MMA(0, 0, At, B0); PG8_BAR; PG8_SCHED;
            PG8_LDB(B1, 1, 1); PG8_STAGE(PG8_SB(1, 0), b3, voffB);
            PG8_BAR; PG8_WAIT_L(0); PG8_MMA(0, 1, At, B1); PG8_BAR;
            PG8_LDA(At, 1, 1); PG8_STAGE_A(PG8_SA(1, 0), last, 0, k3);
            PG8_BAR; PG8_WAIT_L(0); PG8_MMA(1, 0, At, B0); PG8_BAR; PG8_SCHED;
            PG8_STAGE(PG8_SB(1, 1), b3 + hstepB, voffB);
            PG8_WAIT_V(6); PG8_BAR; PG8_MMA(1, 1, At, B1); PG8_BAR;
            }
                }
        if constexpr (ALIGN_EPI) { if (wr == 0) PG8_BAR; }
        if constexpr (!Epi::AFTER_DRAIN) { E(acc, cur, wr, wc, fr, fq); S.done(cur); }
        if (!has_next) break;
        if constexpr (SP2) PG8_ACC_UNDEF();
        if constexpr (!SP2) {
#pragma unroll
        for (int a = 0; a < 2; ++a)
#pragma unroll
            for (int b = 0; b < 2; ++b)
#pragma unroll
                for (int m = 0; m < 4; ++m)
#pragma unroll
                    for (int n = 0; n < 2; ++n) acc[a][b][m][n] = (f32x4){0.f, 0.f, 0.f, 0.f};
        }
        cur = nxt; cA = nA; cB = nB; ++ui;
        if constexpr (GATHER) { gC[0][0] = gN[0][0]; gC[0][1] = gN[0][1]; gC[1][0] = gN[1][0]; gC[1][1] = gN[1][1]; }
        if constexpr (ALIGN_EPI) { if (wr == 1) PG8_BAR; }
    }
    PG8_WAIT_V(0);
    if constexpr (!ALIGN_EPI) { if (wr == 0) PG8_BAR; }
    PG8_BAR;
    if constexpr (Epi::AFTER_DRAIN) { E.fused(acc, cur, wr, wc, fr, fq, lds, wid, lane); S.done(cur); }
#undef PG8_SA
#undef PG8_SB
#undef PG8_STAGE
#undef PG8_BBASE
#undef PG8_STAGE_A
#undef PG8_LDA
#undef PG8_LD16
#undef PG8_LDB
#undef PG8_MMA
#undef PG8_MMA8
#undef PG8_MMA8Z
#undef PG8_MMAZ
#undef PG8_WAIT_V
#undef PG8_WAIT_L
#undef PG8_BAR
#undef PG8_SCHED
}
}
constexpr int BATCH = 2, SEQ = 8192, DM = 1024, MTOK = BATCH * SEQ;
constexpr int RH = 4, RQK = 64, RV = 128, CHK = 128, NCH = SEQ / CHK;
constexpr int AH = 8, AD = 64;
constexpr int NE = 16, CAP = 1024, FF = 2048, NSLOT = NE * BATCH * CAP;
constexpr int NPROJ = 3072;
constexpr int C_RQ = 0, C_RK = 256, C_RV = 512, C_RG = 1024, C_AQ = 1536, C_AK = 2048, C_AV = 2560;
constexpr float RMS_EPS = 1e-6f, GN_EPS = 1e-5f;
constexpr float LOG2E = 1.4426950408889634f;
constexpr int NWAVES = 8;
#ifndef MK_ONE_LAUNCH
#define MK_ONE_LAUNCH 1
#endif
constexpr int NPHASE = 13;
constexpr size_t MiB = 1u << 20;
constexpr size_t WS_CTL = 0, CTL_ZERO_BYTES = 32768;
constexpr size_t WS_MOD = 1 * MiB;
constexpr size_t WS_AFF = 2 * MiB;
constexpr size_t WS_TOK = 3 * MiB;
constexpr size_t WS_GATEV = 3 * MiB + 128 * 1024;
constexpr size_t WS_SLOTOF = 3 * MiB + 256 * 1024;
constexpr size_t WS_LSE = 5 * MiB;
constexpr size_t WS_WIN = 8 * MiB;
constexpr size_t WS_WOUT = 14 * MiB;
constexpr size_t WS_WGU = 16 * MiB;
constexpr size_t WS_WDN = 144 * MiB;
constexpr size_t WS_XN = 208 * MiB;
constexpr size_t WS_R = 240 * MiB;
constexpr size_t WS_PROJ = WS_R;
constexpr size_t WS_KV = WS_R + 96 * MiB;
constexpr size_t WS_PREV = WS_R + 128 * MiB;
constexpr size_t WS_ATTO = WS_R + 144 * MiB;
constexpr size_t WS_Y = WS_R + 192 * MiB;
constexpr size_t WS_MIXED = WS_R;
constexpr size_t WS_XE = WS_R + 64 * MiB;
constexpr size_t WS_HH = WS_R + 128 * MiB;
constexpr size_t WS_YE = WS_R;
constexpr size_t WS_END = WS_R + 256 * MiB;
constexpr int CW_MODCNT = 1024, CW_KVCNT = 1088, CW_TMO2 = 1152, CW_Q0 = 1280;
constexpr int CW_BAR = 4096;
constexpr int RING_BYTES = 131072;
constexpr int LDSCTL_OFF = RING_BYTES, MISC_OFF = LDSCTL_OFF + 320;
constexpr int LDS_BYTES = 147456;

#define GAS __attribute__((address_space(1)))
#define LAS __attribute__((address_space(3)))
typedef unsigned short bf16;
typedef unsigned v4u __attribute__((ext_vector_type(4)));
typedef unsigned v2u __attribute__((ext_vector_type(2)));
typedef float f32x4 __attribute__((ext_vector_type(4)));
typedef float f32x16 __attribute__((ext_vector_type(16)));
typedef short bf16x8 __attribute__((ext_vector_type(8)));
typedef short s16x4 __attribute__((ext_vector_type(4)));
typedef GAS unsigned gu32;
#define RLX_AGENT __ATOMIC_RELAXED, __HIP_MEMORY_SCOPE_AGENT
#define LDS_WAIT() asm volatile("s_waitcnt lgkmcnt(0)" ::: "memory")
typedef float f32x2_t __attribute__((ext_vector_type(2))); typedef __bf16 bf16x2_t __attribute__((ext_vector_type(2)));
__device__ __forceinline__ unsigned pk2(float lo, float hi) { f32x2_t v = {lo, hi}; bf16x2_t b = __builtin_convertvector(v, bf16x2_t); return __builtin_bit_cast(unsigned, b); }
__device__ __forceinline__ float bflo(unsigned w) { return __uint_as_float(w << 16); }
__device__ __forceinline__ float bfhi(unsigned w) { return __uint_as_float(w & 0xffff0000u); }
__device__ __forceinline__ float ex2(float x) { return __builtin_amdgcn_exp2f(x); }
__device__ __forceinline__ int crow(int r, int hi) { return (r & 3) + 8 * (r >> 2) + 4 * hi; }
__device__ __forceinline__ s16x4 vtr(const LAS unsigned char* p) { typedef short v4i16_t __attribute__((ext_vector_type(4))); return __builtin_bit_cast(s16x4, __builtin_amdgcn_ds_read_tr16_b64_v4i16((LAS v4i16_t*)p)); }
__device__ __forceinline__ bf16x8 cat8(s16x4 a, s16x4 b) { return (bf16x8){a[0], a[1], a[2], a[3], b[0], b[1], b[2], b[3]}; }
__device__ __forceinline__ unsigned long long rt_now() { unsigned long long t; asm volatile("s_memrealtime %0\n\ts_waitcnt lgkmcnt(0)" : "=s"(t) :: "memory"); return t; }
__device__ __forceinline__ unsigned long long clk_now() { unsigned long long t; asm volatile("s_memtime %0\n\ts_waitcnt lgkmcnt(0)" : "=s"(t) :: "memory"); return t; }
__device__ __forceinline__ float wave_sum(float v) {
#define WS_DPP(ctrl, rmask, bc) v += __int_as_float(__builtin_amdgcn_update_dpp(0, __float_as_int(v), ctrl, rmask, 0xf, bc))
    WS_DPP(0x111, 0xf, true); WS_DPP(0x112, 0xf, true); WS_DPP(0x114, 0xf, true); WS_DPP(0x118, 0xf, true); WS_DPP(0x142, 0xa, false); WS_DPP(0x143, 0xc, false);
#undef WS_DPP
    return __int_as_float(__builtin_amdgcn_readlane(__float_as_int(v), 63));
}

constexpr float YS8 = 16.f;
__device__ __forceinline__ float y8c(float x) { return __builtin_amdgcn_fmed3f(x * YS8, -448.f, 448.f); }
constexpr int COEF_OFF = 16384;
typedef float f32x2p __attribute__((ext_vector_type(2)));
__device__ __forceinline__ float sum_xor32(float v) { const auto s = __builtin_amdgcn_permlane32_swap(__float_as_uint(v), __float_as_uint(v), false, false); return __uint_as_float(s[0]) + __uint_as_float(s[1]); }
__device__ __forceinline__ float max_xor32(float v) { const auto s = __builtin_amdgcn_permlane32_swap(__float_as_uint(v), __float_as_uint(v), false, false); return fmaxf(__uint_as_float(s[0]), __uint_as_float(s[1])); }
#define XB_TMO      128
#define XB_XCNT(j)  (256  + 64 * (j))
#define XB_XSUB(j)  (1280 + 64 * (j))
#define XB_XGEN(j)  (2304 + 64 * (j))
#define XB_TOP      3328
#define XB_TOPGEN   3392
#define XCD_BAR_WORDS 3456
#define XB_SPIN_CAP (1u << 18)

__device__ __forceinline__ unsigned xb_ld(unsigned* p)              { return __hip_atomic_load(p, __ATOMIC_RELAXED, __HIP_MEMORY_SCOPE_AGENT); }
__device__ __forceinline__ unsigned xb_add(unsigned* p, unsigned v) { return __hip_atomic_fetch_add(p, v, __ATOMIC_RELAXED, __HIP_MEMORY_SCOPE_AGENT); }
__device__ __forceinline__ unsigned xb_xcc_id() { return (unsigned)__builtin_amdgcn_s_getreg((3 << 11) | 20) & 0xFu; }
#define XB_SPIN(cond, bar) do { unsigned _sp = 0; while (cond) { __builtin_amdgcn_s_sleep(1); \
    if ((++_sp & 255u) == 0u) { if (xb_ld(&(bar)[XB_TMO])) break; if (_sp > XB_SPIN_CAP) { atomicAdd(&(bar)[XB_TMO], 1u); break; } } } } while (0)

struct XcdBarrier {
    unsigned* bar; unsigned x;
    volatile LAS unsigned* st;
};

__device__ __forceinline__ XcdBarrier xcd_barrier_post(unsigned* bar, volatile LAS unsigned* st) {
    XcdBarrier b; b.bar = bar; b.x = xb_xcc_id(); b.st = st;
    if (threadIdx.x == 0) (void)xb_add(&bar[XB_XCNT(b.x)], 1u);
    return b;
}
__device__ __forceinline__ void xcd_barrier_complete(unsigned* bar, unsigned x, unsigned& nloc, unsigned& nx) {
    const unsigned G = gridDim.x * gridDim.y * gridDim.z;
    unsigned sum, cnt, mine, sp = 0u;
    for (;;) {
        sum = 0u; cnt = 0u; mine = 0u;
#pragma unroll
        for (unsigned j = 0; j < 16; ++j) { const unsigned c = xb_ld(&bar[XB_XCNT(j)]); sum += c; cnt += (c > 0u) ? 1u : 0u; mine = (j == x) ? c : mine; }
        if (sum == G) break;
        __builtin_amdgcn_s_sleep(1);
        if ((++sp & 255u) == 0u) { if (xb_ld(&bar[XB_TMO])) break; if (sp > XB_SPIN_CAP) { atomicAdd(&bar[XB_TMO], 1u); break; } }
    }
    nloc = mine > 0u ? mine : 1u; nx = cnt > 0u ? cnt : 1u;
}

__device__ __forceinline__ void xcd_barrier(const XcdBarrier& b) {
    asm volatile("s_waitcnt vmcnt(0)" ::: "memory");
    __syncthreads();
    if (threadIdx.x == 0) {
        unsigned* bar = b.bar;
        __builtin_amdgcn_s_waitcnt(0);
        unsigned nloc = b.st[0], nx = b.st[1];
        if (nloc == 0u) { xcd_barrier_complete(bar, b.x, nloc, nx); b.st[0] = nloc; b.st[1] = nx; }
        const unsigned old = xb_add(&bar[XB_XSUB(b.x)], 1u);
        const unsigned gen = old / nloc;
        if (old + 1u == (gen + 1u) * nloc) {
            __builtin_amdgcn_fence(__ATOMIC_RELEASE, "agent");
            asm volatile("s_waitcnt vmcnt(0)" ::: "memory");
            const unsigned og = xb_add(&bar[XB_TOP], 1u);
            const unsigned tg = og / nx;
            if (og + 1u == (tg + 1u) * nx) xb_add(&bar[XB_TOPGEN], 1u);
            else XB_SPIN(xb_ld(&bar[XB_TOPGEN]) == tg, bar);
            __builtin_amdgcn_fence(__ATOMIC_ACQUIRE, "agent");
            xb_add(&bar[XB_XGEN(b.x)], 1u);
            asm volatile("s_waitcnt vmcnt(0)" ::: "memory");
        } else {
            XB_SPIN(xb_ld(&bar[XB_XGEN(b.x)]) == gen, bar);
            __builtin_amdgcn_fence(__ATOMIC_ACQUIRE, "agent");
            asm volatile("s_waitcnt vmcnt(0)" ::: "memory");
        }
    }
    __syncthreads();
}
struct Frame {
    LAS unsigned char* lds;
    volatile LAS unsigned* MISC;
    gu32* ctl;
    int tid, lane, wave;
    int vcu, G;
    unsigned long long ts_a, ts_b;
    const float *x, *c, *w_ada, *b_ada, *g_pre_mix, *g_post_mix, *g_pre_ffn, *g_post_ffn, *w_in, *dec_f, *dec_b, *w_out, *w_router, *w_gate, *w_up, *w_down;
    float* out;
    float *MOD, *AFF, *GATEV, *LSE, *KV, *MIXED;
    int *TOK, *SLOTOF;
    bf16 *WIN, *WOUT, *WGU, *WDN, *XN, *PROJ, *PREV, *ATTO, *Y, *XE, *HH, *YE, *MIXB, *X1B;
};

struct ConvItem { const float* W; void* WT; int K, N, k0, n0, drow0, fp8, nrows; float ws; };
__device__ __forceinline__ void p0_load(const ConvItem& ci, f32x4 (&v)[16], int lane) {
    const int kr = lane >> 3, n4 = lane & 7;
#pragma unroll
    for (int i = 0; i < 16; ++i) v[i] = __builtin_nontemporal_load((const f32x4*)(ci.W + (size_t)(ci.k0 + 8 * i + kr) * ci.N + ci.n0 + 4 * n4));
}
__device__ __forceinline__ void p0_finish(const ConvItem& ci, const f32x4 (&v)[16], LAS float* scr, int lane) {
    const int kr = lane >> 3, n4 = lane & 7;
#pragma unroll
    for (int i = 0; i < 16; ++i) { const int k = 8 * i + kr; *(LAS f32x4*)(scr + k * 32 + (((n4 + (k >> 4)) & 7) << 2)) = v[i]; }
    LDS_WAIT(); asm volatile("" ::: "memory");
    const int kq = lane & 7;
#pragma unroll 1
    for (int j = 0; j < 4; ++j) { const int n = (lane >> 3) + 8 * j; const LAS float* sp = scr + (16 * kq) * 32 + ((n + 4 * kq) & 31);
        float t[16];
#pragma unroll
        for (int u = 0; u < 16; ++u) t[u] = sp[u * 32];
        if (ci.fp8) { v4u o; o.x = pg8::cvt4_fp8(t[0] * 32.f, t[1] * 32.f, t[2] * 32.f, t[3] * 32.f); o.y = pg8::cvt4_fp8(t[4] * 32.f, t[5] * 32.f, t[6] * 32.f, t[7] * 32.f);
            o.z = pg8::cvt4_fp8(t[8] * 32.f, t[9] * 32.f, t[10] * 32.f, t[11] * 32.f); o.w = pg8::cvt4_fp8(t[12] * 32.f, t[13] * 32.f, t[14] * 32.f, t[15] * 32.f);
            *(GAS v4u*)((unsigned char*)ci.WT + ((size_t)(ci.k0 >> 7) * (ci.nrows >> 5) + (ci.drow0 >> 5)) * 4096 + (size_t)n * 128 + 16 * kq) = o; }
        else { const float s_ = ci.ws; v4u o0, o1; o0.x = pk2(t[0] * s_, t[1] * s_); o0.y = pk2(t[2] * s_, t[3] * s_); o0.z = pk2(t[4] * s_, t[5] * s_); o0.w = pk2(t[6] * s_, t[7] * s_); o1.x = pk2(t[8] * s_, t[9] * s_); o1.y = pk2(t[10] * s_, t[11] * s_); o1.z = pk2(t[12] * s_, t[13] * s_); o1.w = pk2(t[14] * s_, t[15] * s_);
            GAS v4u* dp = (GAS v4u*)((bf16*)ci.WT + (size_t)(ci.drow0 + n) * ci.K + ci.k0 + 16 * kq); dp[0] = o0; dp[1] = o1; } }
    LDS_WAIT(); asm volatile("" ::: "memory");
}
__device__ __forceinline__ void p8_load(const ConvItem& ci, f32x4 (&v)[16], int lane) {
#pragma unroll
    for (int i = 0; i < 16; ++i) v[i] = __builtin_nontemporal_load((const f32x4*)(ci.W + (size_t)(ci.k0 + 2 * i + (lane >> 5)) * ci.N + ci.n0 + 4 * (lane & 31)));
}
__device__ __forceinline__ void p8_finish(const ConvItem& ci, const f32x4 (&v)[16], LAS float* scr, int lane) {
    const float ws_ = ci.ws;
#pragma unroll
    for (int i = 0; i < 16; ++i) { const int k = 2 * i + (lane >> 5); *(LAS f32x4*)(scr + k * 128 + ((4 * (lane & 31) + 16 * (k >> 4)) & 127)) = v[i]; }
    LDS_WAIT(); asm volatile("" ::: "memory");
    unsigned char* dst = (unsigned char*)ci.WT + ((size_t)(ci.k0 >> 5) * (ci.nrows >> 7) + (ci.drow0 >> 7)) * 4096;
#pragma unroll 1
    for (int j = 0; j < 4; ++j) { const int ch = 64 * j + lane, n = ch >> 1, kh = ch & 1; const LAS float* sp = scr + (16 * kh) * 128 + ((n + 16 * kh) & 127);
        float t[16];
#pragma unroll
        for (int u = 0; u < 16; ++u) t[u] = sp[u * 128];
        v4u o; o.x = pg8::cvt4_fp8(t[0] * ws_, t[1] * ws_, t[2] * ws_, t[3] * ws_); o.y = pg8::cvt4_fp8(t[4] * ws_, t[5] * ws_, t[6] * ws_, t[7] * ws_);
        o.z = pg8::cvt4_fp8(t[8] * ws_, t[9] * ws_, t[10] * ws_, t[11] * ws_); o.w = pg8::cvt4_fp8(t[12] * ws_, t[13] * ws_, t[14] * ws_, t[15] * ws_);
        __builtin_nontemporal_store(o, (v4u*)(dst + (size_t)ch * 16)); }
    LDS_WAIT(); asm volatile("" ::: "memory");
}
constexpr int CI_IN = (DM / 128) * (NPROJ / 32), CI_OUT = (DM / 32) * (DM / 128), CI_G1 = (DM / 32) * (FF / 128), CI_G = NE * CI_G1, CI_D1 = (FF / 32) * (DM / 128), CI_D = NE * CI_D1;
constexpr int CI_N = CI_IN + CI_OUT + 2 * CI_G + CI_D;
#ifndef CI_DEFER
#define CI_DEFER 12288
#endif
#ifndef CI_DEFER2
#define CI_DEFER2 6144
#endif
constexpr int CI_P0 = CI_N - CI_DEFER - CI_DEFER2;
__device__ __forceinline__ ConvItem p0_decode(Frame& F, int it) {
    ConvItem ci; int r = it;
    if (r < CI_IN) { const int nblk = NPROJ / 32, kb = r / nblk, nb = r % nblk; const int pn_ = (32 * nb) >> 8; ci = ConvItem{F.w_in, F.WIN, DM, NPROJ, 128 * kb, 32 * nb, 32 * nb, 0, 0, (pn_ == 1) ? 0.125f : ((pn_ == 6 || pn_ == 7) ? 0.125f * LOG2E : 1.f)}; return ci; } r -= CI_IN;
    if (r < CI_OUT) { const int nblk = DM / 128, kb = r / nblk, nb = r % nblk; ci = ConvItem{F.w_out, F.WOUT, DM, DM, 32 * kb, 128 * nb, 128 * nb, 1, DM, 32.f}; return ci; } r -= CI_OUT;
    if (r < 2 * CI_G) { const int half = r / CI_G; r -= half * CI_G; const int e = r / CI_G1, q = r % CI_G1, nblk = FF / 128, kb = q / nblk, nb = q % nblk, n0 = 128 * nb;
        ci = ConvItem{(half ? F.w_up : F.w_gate) + (size_t)e * DM * FF, (unsigned char*)F.WGU + (size_t)e * (2 * FF) * DM, DM, FF, 32 * kb, n0, nb * 256 + half * 128, 1, 2 * FF, half ? (-32.f / LOG2E) : (-32.f * LOG2E)}; return ci; } r -= 2 * CI_G;
    { const int e = r / CI_D1, q = r % CI_D1, nblk = DM / 128, kb = q / nblk, nb = q % nblk;
      ci = ConvItem{F.w_down + (size_t)e * FF * DM, (unsigned char*)F.WDN + (size_t)e * DM * FF, FF, DM, 32 * kb, 128 * nb, 128 * nb, 1, DM, 32.f}; return ci; }
}
__device__ __forceinline__ void phase_p0a(Frame& F) {
#if defined(TIME_SUB)
    if (TIME_SUB == 1) F.ts_a = rt_now();
#endif
    int it, stride, itend;
    { const int nA = (F.G >= 6 * DM / 32) ? 6 * DM / 32 : F.G, nB = F.G - nA;
      const int wA = nA * NWAVES, wB = nB * NWAVES; const int split = (nB > 0) ? ((CI_P0 / (wA + wB)) * wA) : CI_P0;
      if (F.vcu < nA) { it = F.vcu * NWAVES + F.wave; stride = wA; itend = split; } else { it = split + (F.vcu - nA) * NWAVES + F.wave; stride = wB; itend = CI_P0; } }
#if defined(CONV_ON_64)
    if ((F.vcu & 3) == 0) { it = (F.vcu >> 2) * NWAVES + F.wave; stride = (F.G >> 2) * NWAVES; itend = CI_N; } else { it = 0; itend = 0; stride = 1; }
#endif
    f32x4 vA[16], vB[16]; ConvItem ca, cb;
    if (it < itend) { ca = p0_decode(F, it); if (ca.fp8) p8_load(ca, vA, F.lane); else p0_load(ca, vA, F.lane); }
    LAS float* sc = (LAS float*)F.lds;
    LAS float* red = sc + 2 * DM;
    if (F.vcu < 6 * DM / 32) {
        for (int i = F.tid; i < 2 * DM; i += NWAVES * 64) { const float v = F.c[i]; sc[i] = v / (1.f + __expf(-v)); }
        __syncthreads();
        const int col0 = 32 * F.vcu, kk = F.lane >> 3, c4 = F.lane & 7, kb = 128 * F.wave;
        f32x4 w[16];
#pragma unroll
        for (int i = 0; i < 16; ++i) w[i] = __builtin_nontemporal_load((const f32x4*)(F.w_ada + (size_t)(kb + 8 * i + kk) * (6 * DM) + col0 + 4 * c4));
        f32x4 a0 = {0.f, 0.f, 0.f, 0.f}, a1 = {0.f, 0.f, 0.f, 0.f};
#pragma unroll
        for (int i = 0; i < 16; ++i) { const int k = kb + 8 * i + kk; a0 += w[i] * sc[k]; a1 += w[i] * sc[DM + k]; }
#pragma unroll
        for (int o = 8; o < 64; o <<= 1) {
            a0.x += __shfl_xor(a0.x, o); a0.y += __shfl_xor(a0.y, o); a0.z += __shfl_xor(a0.z, o); a0.w += __shfl_xor(a0.w, o);
            a1.x += __shfl_xor(a1.x, o); a1.y += __shfl_xor(a1.y, o); a1.z += __shfl_xor(a1.z, o); a1.w += __shfl_xor(a1.w, o); }
        if (kk == 0) { *(LAS f32x4*)(red + (F.wave * 2 + 0) * 32 + 4 * c4) = a0; *(LAS f32x4*)(red + (F.wave * 2 + 1) * 32 + 4 * c4) = a1; }
        __syncthreads();
        if (F.tid < 64) { const int b = F.tid >> 5, cc = F.tid & 31; float sum = 0.f;
#pragma unroll
            for (int wv = 0; wv < NWAVES; ++wv) sum += red[(wv * 2 + b) * 32 + cc];
            __hip_atomic_store(F.MOD + b * 6 * DM + col0 + cc, sum + F.b_ada[col0 + cc], RLX_AGENT);
            asm volatile("s_waitcnt vmcnt(0)" ::: "memory");
            if (F.tid == 0) __hip_atomic_fetch_add((unsigned*)(F.ctl + CW_MODCNT), 1u, RLX_AGENT); }
        __syncthreads();
    }
#if defined(TIME_SUB)
    if (TIME_SUB == 1) F.ts_b = rt_now();
    if (TIME_SUB == 2) F.ts_a = rt_now();
#endif
    LAS float* scr = (LAS float*)(F.lds + F.wave * 16384);
    while (it < itend) {
        int itn = it + stride;
        if (itn < itend) { cb = p0_decode(F, itn); if (cb.fp8) p8_load(cb, vB, F.lane); else p0_load(cb, vB, F.lane); }
        if (ca.fp8) p8_finish(ca, vA, scr, F.lane); else p0_finish(ca, vA, scr, F.lane);
        it = itn; if (it >= itend) break;
        itn = it + stride;
        if (itn < itend) { ca = p0_decode(F, itn); if (ca.fp8) p8_load(ca, vA, F.lane); else p0_load(ca, vA, F.lane); }
        if (cb.fp8) p8_finish(cb, vB, scr, F.lane); else p0_finish(cb, vB, scr, F.lane);
        it = itn;
    }
}
__device__ __forceinline__ void wait_counter(Frame& F, gu32* cnt, unsigned want) {
    if (F.tid == 0) {
        unsigned sp = 0;
        while (__hip_atomic_load(cnt, RLX_AGENT) < want) { __builtin_amdgcn_s_sleep(2);
            if (++sp > (1u << 22)) { __hip_atomic_store(F.ctl + CW_TMO2, 1u, RLX_AGENT); break; } }
        __builtin_amdgcn_fence(__ATOMIC_ACQUIRE, "agent");
        asm volatile("s_waitcnt vmcnt(0)" ::: "memory");
    }
    __syncthreads();
}
__device__ __forceinline__ void phase_p0b(Frame& F) {
    const int gw = F.vcu * NWAVES + F.wave, NGW = F.G * NWAVES;
    constexpr int RB = 8;
    for (int m0 = gw; m0 < MTOK; m0 += RB * NGW) {
        f32x4 v[RB][4]; float s[RB];
#pragma unroll
        for (int q = 0; q < RB; ++q) { const int m = m0 + q * NGW; const GAS f32x4* xr = (const GAS f32x4*)(F.x + (size_t)(m < MTOK ? m : m0) * DM) + F.lane;
#pragma unroll
            for (int j = 0; j < 4; ++j) v[q][j] = __builtin_nontemporal_load((const f32x4*)xr + 64 * j); }
#pragma unroll
        for (int q = 0; q < RB; ++q) { float t = 0.f;
#pragma unroll
            for (int j = 0; j < 4; ++j) t += (v[q][j].x * v[q][j].x + v[q][j].y * v[q][j].y) + (v[q][j].z * v[q][j].z + v[q][j].w * v[q][j].w);
            s[q] = __builtin_amdgcn_rsqf(wave_sum(t) * (1.f / DM) + RMS_EPS); }
#pragma unroll
        for (int j = 0; j < 4; ++j) { const int c = 4 * F.lane + 256 * j;
            const f32x4 g = *(const f32x4*)(F.g_pre_mix + c);
            const f32x4 a0 = g * (*(const f32x4*)(F.MOD + DM + c) + 1.f), h0 = *(const f32x4*)(F.MOD + c);
            const f32x4 a1 = g * (*(const f32x4*)(F.MOD + 6 * DM + DM + c) + 1.f), h1 = *(const f32x4*)(F.MOD + 6 * DM + c);
#pragma unroll
            for (int q = 0; q < RB; ++q) { const int m = m0 + q * NGW; if (m < MTOK) { const bool b1 = m >= SEQ;
                const f32x4 h = v[q][j] * s[q] * (b1 ? a1 : a0) + (b1 ? h1 : h0);
                v2u w; w.x = pk2(h.x, h.y); w.y = pk2(h.z, h.w); *((GAS v2u*)(F.XN + (size_t)m * DM) + F.lane + 64 * j) = w; } } }
    }
}

__device__ __forceinline__ void phase_side_convert(Frame& F, int j, int nside, int ibeg, int iend) {
    LAS float* scr = (LAS float*)(F.lds + F.wave * 16384);
    int it = ibeg + j * NWAVES + F.wave; const int stride = nside * NWAVES, itend = iend;
    f32x4 vA[16], vB[16]; ConvItem ca, cb;
    if (it < itend) { ca = p0_decode(F, it); p8_load(ca, vA, F.lane); }
    while (it < itend) {
        int itn = it + stride;
        if (itn < itend) { cb = p0_decode(F, itn); p8_load(cb, vB, F.lane); }
        p8_finish(ca, vA, scr, F.lane);
        it = itn; if (it >= itend) break;
        itn = it + stride;
        if (itn < itend) { ca = p0_decode(F, itn); p8_load(ca, vA, F.lane); }
        p8_finish(cb, vB, scr, F.lane);
        it = itn;
    }
}
__device__ __forceinline__ float lg2_sigmoid(float x) { return -log1pf(__expf(-x)) * LOG2E; }
__device__ __forceinline__ float lgdec(Frame& F, int h, int dir) { return __uint_as_float(F.MISC[16 + 2 * h + dir]); }
struct AttnDesc { int b, h, cfg, r, qblk; };
__device__ __forceinline__ AttnDesc attn_decode(int u) {
    AttnDesc a; const int blk = u & 31; a.h = (u >> 5) & 7; a.b = (u >> 8) & 1; a.cfg = u >> 9;
    const int d = (a.cfg == 0) ? 1 : ((a.cfg == 1) ? 4 : 16), nq = (SEQ / d) / 256; a.r = blk / nq; a.qblk = blk % nq; return a;
}
constexpr int ATT_KOFF = 0, ATT_VOFF = 49152;
__device__ __forceinline__ void attn_prefetch(Frame& F, const AttnDesc& a, v4u (&kr)[6], v4u (&vr)[6], bf16x8 (&qn)[4]) {
    const int d = (a.cfg == 0) ? 1 : ((a.cfg == 1) ? 4 : 16), L = SEQ / d;
    const bf16* P = F.PROJ + (size_t)a.b * SEQ * NPROJ;
    const int wl0 = 256 * a.qblk - 64, ch = F.tid & 7;
#pragma unroll
    for (int p = 0; p < 6; ++p) {
        int l = wl0 + p * 64 + (F.tid >> 3); l = l < 0 ? 0 : (l > L - 1 ? L - 1 : l);
        const bf16* rp = P + (unsigned)((l * d + a.r) * NPROJ + a.h * AD + ch * 8);
        kr[p] = *(const v4u*)(rp + C_AK); vr[p] = *(const v4u*)(rp + C_AV);
    }
    { const int ql = 256 * a.qblk + 32 * F.wave + (F.lane & 31);
      const bf16* qp = P + (unsigned)((ql * d + a.r) * NPROJ + C_AQ + a.h * AD + (F.lane >> 5) * 8);
#pragma unroll
      for (int s = 0; s < 4; ++s) qn[s] = *(const bf16x8*)(qp + 16 * s); }
}
__device__ __forceinline__ void attn_stage(Frame& F, const v4u (&kr)[6], const v4u (&vr)[6]) {
    const int ch = F.tid & 7;
#pragma unroll
    for (int p = 0; p < 6; ++p) { const int kidx = p * 64 + (F.tid >> 3);
        *(LAS v4u*)(F.lds + ATT_KOFF + kidx * 128 + ((ch ^ (kidx & 7)) << 4)) = kr[p];
        *(LAS v4u*)(F.lds + ATT_VOFF + (ch >> 2) * (384 * 64) + (kidx >> 3) * 512 + (kidx & 7) * 64 + (ch & 3) * 16) = vr[p]; }
}
__device__ __forceinline__ void attn_compute(Frame& F, const AttnDesc& a, const bf16x8 (&qf)[4]) {
    const int cfg = a.cfg, h = a.h, b = a.b, r = a.r, qblk = a.qblk;
    const int d = (cfg == 0) ? 1 : ((cfg == 1) ? 4 : 16), L = SEQ / d;
    const int wave = F.wave; int lane = F.lane; asm volatile("" : "+v"(lane));
    const int i = lane & 31, hi = lane >> 5;
    const bf16* P = F.PROJ + (size_t)b * SEQ * NPROJ;
    const int lw0 = 256 * qblk + 32 * wave - 64;
    const int ql = 256 * qblk + 32 * wave + i;
    const float slope2 = ex2(-(float)(h + 1)) * (float)d * LOG2E;
    f32x16 acc[5];
    const int a0 = i + 64 - 4 * hi;
    const LAS unsigned char* Kl = F.lds + ATT_KOFF;
#define ATT_QK(T, CINIT) do { f32x16 c_; _Pragma("unroll") for (int rr_ = 0; rr_ < 16; ++rr_) c_[rr_] = (CINIT); const int key_ = 32 * wave + 32 * (T) + i; \
        _Pragma("unroll") for (int s_ = 0; s_ < 4; ++s_) { const bf16x8 kf_ = *(const LAS bf16x8*)(Kl + key_ * 128 + (((2 * s_ + hi) ^ (key_ & 7)) << 4)); \
            c_ = __builtin_amdgcn_mfma_f32_32x32x16_bf16(kf_, qf[s_], c_, 0, 0, 0); } acc[T] = c_; } while (0)
    ATT_QK(2, 0.f);
    const float fa2 = (float)(a0 - 64);
    float mx = -3.0e38f;
#pragma unroll
    for (int rr = 0; rr < 16; ++rr) { const int c0 = (rr & 3) + 8 * (rr >> 2); const float v2 = acc[2][rr] - slope2 * fabsf(fa2 - (float)c0); acc[2][rr] = v2; mx = fmaxf(mx, v2); }
    mx = max_xor32(mx);
#define ATT_C0 ((float)((rr_ & 3) + 8 * (rr_ >> 2)))
    { const float b0 = -slope2 * (float)a0 - mx, b1 = -slope2 * (float)(a0 - 32) - mx, b3 = slope2 * (float)(a0 - 96) - mx, b4 = slope2 * (float)(a0 - 128) - mx;
      ATT_QK(0, __builtin_fmaf(slope2, ATT_C0, b0)); ATT_QK(1, __builtin_fmaf(slope2, ATT_C0, b1)); ATT_QK(3, __builtin_fmaf(-slope2, ATT_C0, b3)); ATT_QK(4, __builtin_fmaf(-slope2, ATT_C0, b4)); }
#undef ATT_C0
#undef ATT_QK
    if (lw0 < 0 || lw0 + 160 > L) {
#pragma unroll
        for (int T = 0; T < 5; ++T)
#pragma unroll
            for (int rr = 0; rr < 16; ++rr) { const int kl = lw0 + 32 * T + crow(rr, hi); if (T != 2 && (kl < 0 || kl >= L)) acc[T][rr] = -1.0e30f; }
    }
    const int th0 = i - 4 * hi;
    float lsum = 0.f;
#pragma unroll
    for (int rr = 0; rr < 16; ++rr) { const int c0 = (rr & 3) + 8 * (rr >> 2);
        const float v0 = (c0 >= th0) ? acc[0][rr] : -1.0e30f;
        const float v1 = acc[1][rr];
        const float v2 = acc[2][rr] - mx;
        const float v3 = acc[3][rr];
        const float v4 = (c0 <= th0) ? acc[4][rr] : -1.0e30f;
        const float p0 = ex2(v0), p1 = ex2(v1), p2 = ex2(v2), p3 = ex2(v3), p4 = ex2(v4);
        acc[0][rr] = p0; acc[1][rr] = p1; acc[2][rr] = p2; acc[3][rr] = p3; acc[4][rr] = p4;
        lsum += (p0 + p1) + (p2 + p3) + p4; }
    lsum = sum_xor32(lsum);
    f32x16 o[2]; o[0] = f32x16{}; o[1] = f32x16{};
    const LAS unsigned char* vb = F.lds + ATT_VOFF + ((lane >> 4) & 1) * 32 + (lane & 3) * 8 + (4 * hi + ((lane & 15) >> 2)) * 64;
#pragma unroll
    for (int T = 0; T < 5; ++T)
#pragma unroll
        for (int u = 0; u < 2; ++u) {
            v4u pw; pw.x = pk2(acc[T][8 * u + 0], acc[T][8 * u + 1]); pw.y = pk2(acc[T][8 * u + 2], acc[T][8 * u + 3]); pw.z = pk2(acc[T][8 * u + 4], acc[T][8 * u + 5]); pw.w = pk2(acc[T][8 * u + 6], acc[T][8 * u + 7]);
            const bf16x8 pb = __builtin_bit_cast(bf16x8, pw);
            const int kbase = 32 * wave + 32 * T + 16 * u;
#pragma unroll
            for (int dt = 0; dt < 2; ++dt) {
                const LAS unsigned char* aa = vb + dt * (384 * 64) + (kbase >> 3) * 512;
                const bf16x8 va = cat8(vtr(aa), vtr(aa + 512));
                o[dt] = __builtin_amdgcn_mfma_f32_32x32x16_bf16(va, pb, o[dt], 0, 0, 0);
            }
        }
    const float inv = __builtin_amdgcn_rcpf(lsum);
    const unsigned row = (unsigned)(b * SEQ + ql * d + r);
    bf16* op = F.ATTO + (size_t)cfg * MTOK * (AH * AD) + (unsigned)(row * (AH * AD) + h * AD);
#pragma unroll
    for (int dt = 0; dt < 2; ++dt) { unsigned wx[4], wy[4];
#pragma unroll
        for (int g = 0; g < 4; ++g) { wx[g] = pk2(o[dt][4 * g] * inv, o[dt][4 * g + 1] * inv); wy[g] = pk2(o[dt][4 * g + 2] * inv, o[dt][4 * g + 3] * inv); }
#pragma unroll
        for (int pr = 0; pr < 2; ++pr) { const auto sx = __builtin_amdgcn_permlane32_swap(wx[2 * pr], wx[2 * pr + 1], false, false), sy = __builtin_amdgcn_permlane32_swap(wy[2 * pr], wy[2 * pr + 1], false, false);
            v4u w; w.x = sx[0]; w.y = sy[0]; w.z = sx[1]; w.w = sy[1];
            *(v4u*)(op + 32 * dt + 16 * pr + 8 * hi) = w; } }
    if (hi == 0) F.LSE[(size_t)cfg * MTOK * AH + (unsigned)(row * AH + h)] = mx + __builtin_amdgcn_logf(lsum);
}
__device__ __forceinline__ void kv_unit(Frame& F, int b, int h, int n) {
    const int tid = F.tid, wave = F.wave; int lane = F.lane; asm volatile("" : "+v"(lane));
    const int hi = lane >> 5;
    const float lgf = lgdec(F, h, 0), lgb = lgdec(F, h, 1);
    const size_t row0 = (size_t)b * SEQ + (size_t)n * CHK;
    LAS unsigned char* Vl = F.lds;
    LAS unsigned char* Kl = F.lds + 32768;
#pragma unroll
    for (int p = 0; p < 4; ++p) { const int idx = p * 512 + tid, key = idx >> 4, ch = idx & 15;
        const v4u val = *(const v4u*)(F.PROJ + (row0 + key) * NPROJ + C_RV + h * RV + ch * 8);
        *(LAS v4u*)(Vl + (ch >> 2) * (128 * 64) + (key >> 3) * 512 + (key & 7) * 64 + (ch & 3) * 16) = val; }
#pragma unroll
    for (int p = 0; p < 2; ++p) { const int idx = p * 512 + tid, key = idx >> 3, ch = idx & 7;
        const v4u val = *(const v4u*)(F.PROJ + (row0 + key) * NPROJ + C_RK + h * RQK + ch * 8);
        const float sf = ex2(lgf * (float)(127 - key)), sb = ex2(lgb * (float)key);
        v4u wf, wb;
        wf.x = pk2(bflo(val.x) * sf, bfhi(val.x) * sf); wf.y = pk2(bflo(val.y) * sf, bfhi(val.y) * sf); wf.z = pk2(bflo(val.z) * sf, bfhi(val.z) * sf); wf.w = pk2(bflo(val.w) * sf, bfhi(val.w) * sf);
        wb.x = pk2(bflo(val.x) * sb, bfhi(val.x) * sb); wb.y = pk2(bflo(val.y) * sb, bfhi(val.y) * sb); wb.z = pk2(bflo(val.z) * sb, bfhi(val.z) * sb); wb.w = pk2(bflo(val.w) * sb, bfhi(val.w) * sb);
        const int off = (ch >> 2) * (128 * 64) + (key >> 3) * 512 + (key & 7) * 64 + (ch & 3) * 16;
        *(LAS v4u*)(Kl + off) = wf; *(LAS v4u*)(Kl + 16384 + off) = wb; }
    __syncthreads();
    const int dir = wave >> 2, dvt = wave & 3;
    const int lofs = ((lane >> 4) & 1) * 32 + (lane & 3) * 8 + (4 * hi + ((lane & 15) >> 2)) * 64;
    const LAS unsigned char* va = Vl + dvt * (128 * 64) + lofs;
    bf16* kvout = (bf16*)F.KV + ((size_t)(((b * RH + h) * 2 + dir) * NCH + n)) * (RV * RQK);
#pragma unroll
    for (int dkt = 0; dkt < 2; ++dkt) {
        const LAS unsigned char* ka = Kl + dir * 16384 + dkt * (128 * 64) + lofs;
        f32x16 a = {};
#pragma unroll
        for (int s = 0; s < 8; ++s) {
            const bf16x8 A = cat8(vtr(va + s * 1024), vtr(va + s * 1024 + 512));
            const bf16x8 B = cat8(vtr(ka + s * 1024), vtr(ka + s * 1024 + 512));
            a = __builtin_amdgcn_mfma_f32_32x32x16_bf16(B, A, a, 0, 0, 0);
        }
#pragma unroll
        for (int pr = 0; pr < 2; ++pr) {
            const unsigned x0 = pk2(a[8 * pr], a[8 * pr + 1]), y0 = pk2(a[8 * pr + 2], a[8 * pr + 3]), x1 = pk2(a[8 * pr + 4], a[8 * pr + 5]), y1 = pk2(a[8 * pr + 6], a[8 * pr + 7]);
            const auto sx = __builtin_amdgcn_permlane32_swap(x0, x1, false, false), sy = __builtin_amdgcn_permlane32_swap(y0, y1, false, false);
            v4u w; w.x = sx[0]; w.y = sy[0]; w.z = sx[1]; w.w = sy[1];
            *(v4u*)(kvout + (32 * dvt + (lane & 31)) * RQK + 32 * dkt + 16 * pr + 8 * hi) = w; }
    }
    __syncthreads();
}
__device__ __forceinline__ void phase_p2(Frame& F) {
    constexpr int NKV = BATCH * RH * NCH;
    for (int u = F.vcu; u < NKV; u += F.G) kv_unit(F, u >> 8, (u >> 6) & 3, u & 63);
    constexpr int NATT = BATCH * AH * 3 * (SEQ / 256);
    if (F.vcu < NATT) {
        v4u kr[6], vr[6]; bf16x8 qn[4], qc[4];
        attn_prefetch(F, attn_decode(F.vcu), kr, vr, qn);
        for (int u = F.vcu; u < NATT; u += F.G) {
            attn_stage(F, kr, vr);
#pragma unroll
            for (int s = 0; s < 4; ++s) qc[s] = qn[s];
            __syncthreads();
            if (u + F.G < NATT) attn_prefetch(F, attn_decode(u + F.G), kr, vr, qn);
            attn_compute(F, attn_decode(u), qc);
            __syncthreads();
        }
    }
}
#ifndef SCAN_R
#define SCAN_R 32
#endif
__device__ __forceinline__ void phase_p3a(Frame& F) {
    if (F.vcu < 8) {
        const int idx = F.vcu * (NWAVES * 64) + F.tid, b = idx >> 11, which = (idx >> 10) & 1, c = idx & (DM - 1); const float* mod = F.MOD + b * 6 * DM;
        F.MOD[COEF_OFF + (b * 2 + which) * DM + c] = which ? F.g_pre_ffn[c] * (1.f + mod[4 * DM + c]) : mod[2 * DM + c] * F.g_post_mix[c]; }
    if (F.tid == 0) *(LAS int*)F.lds = 0;
    __syncthreads();
    if (F.tid < 256)
    for (int g = F.vcu * 256 + F.tid; g < BATCH * RH * 2 * (RV * RQK) / 2; g += F.G * 256) {
        const int bhd = g >> 12, e = (g & 4095) * 2, dir = bhd & 1, h = (bhd >> 1) & 3;
        const float lam = ex2(128.f * lgdec(F, h, dir));
        const unsigned* kv = (const unsigned*)((const bf16*)F.KV + (size_t)bhd * NCH * 8192 + e); unsigned* pv = (unsigned*)(F.PREV + (size_t)bhd * NCH * 8192 + e);
        float s0 = 0.f, s1 = 0.f;
#pragma unroll 1
        for (int k0 = 0; k0 < NCH; k0 += SCAN_R) {
            unsigned v[SCAN_R];
#pragma unroll
            for (int k = 0; k < SCAN_R; ++k) { const int n = dir ? (NCH - 1 - (k0 + k)) : (k0 + k); v[k] = kv[(size_t)n * 4096]; }
#pragma unroll
            for (int k = 0; k < SCAN_R; ++k) { const int n = dir ? (NCH - 1 - (k0 + k)) : (k0 + k); pv[(size_t)n * 4096] = pk2(s0, s1); s0 = lam * s0 + bflo(v[k]); s1 = lam * s1 + bfhi(v[k]); }
        }
    }
}
__device__ __forceinline__ void phase_p3b(Frame& F) {
    constexpr int RB = 4;
    LAS int* ctr = (LAS int*)F.lds;
    for (;;) {
        int k = 0; if (F.lane == 0) k = __hip_atomic_fetch_add(ctr, 1, __ATOMIC_RELAXED, __HIP_MEMORY_SCOPE_WORKGROUP);
        k = __builtin_amdgcn_readfirstlane(k);
        const int m0 = (k * F.G + F.vcu) * RB; if (m0 >= MTOK) break;
        constexpr int NGW = 1;
        v4u a[RB][3]; float l[RB][3];
#pragma unroll
        for (int q = 0; q < RB; ++q) { const int mm = m0 + q * NGW; const size_t m = mm < MTOK ? mm : m0;
#pragma unroll
            for (int c = 0; c < 3; ++c) { a[q][c] = *(const v4u*)(F.ATTO + ((size_t)c * MTOK + m) * 512 + F.lane * 8); l[q][c] = F.LSE[((size_t)c * MTOK + m) * AH + (F.lane >> 3)]; } }
#pragma unroll
        for (int q = 0; q < RB; ++q) { const int m = m0 + q * NGW; if (m >= MTOK) break;
            const float mx = fmaxf(l[q][0], fmaxf(l[q][1], l[q][2])); float w0 = ex2(l[q][0] - mx), w1 = ex2(l[q][1] - mx), w2 = ex2(l[q][2] - mx); const float inv = __builtin_amdgcn_rcpf(w0 + w1 + w2); w0 *= inv; w1 *= inv; w2 *= inv;
            const v4u x = a[q][0], y = a[q][1], z = a[q][2]; v2u o;
#define MIX8(f, c) y8c(w0 * f(x.c) + w1 * f(y.c) + w2 * f(z.c))
            o.x = pg8::cvt4_fp8(MIX8(bflo, x), MIX8(bfhi, x), MIX8(bflo, y), MIX8(bfhi, y));
            o.y = pg8::cvt4_fp8(MIX8(bflo, z), MIX8(bfhi, z), MIX8(bflo, w), MIX8(bfhi, w));
#undef MIX8
            *(v2u*)((unsigned char*)F.Y + (size_t)m * DM + 512 + F.lane * 8) = o; }
    }
}
__device__ __forceinline__ bf16x8 scale8(bf16x8 q, float s) {
    const v4u w = __builtin_bit_cast(v4u, q); v4u o;
    o.x = pk2(bflo(w.x) * s, bfhi(w.x) * s); o.y = pk2(bflo(w.y) * s, bfhi(w.y) * s); o.z = pk2(bflo(w.z) * s, bfhi(w.z) * s); o.w = pk2(bflo(w.w) * s, bfhi(w.w) * s);
    return __builtin_bit_cast(bf16x8, o);
}
__device__ __forceinline__ void ret_front(Frame& F, int pair) {
    const int tid = F.tid, wave = F.wave; int lane = F.lane; asm volatile("" : "+v"(lane));
    const int i = lane & 31, hi = lane >> 5, grp = wave >> 2, w4 = wave & 3;
    const int cid = 2 * pair + grp, n = cid & 63, h = (cid >> 6) & 3, b = cid >> 8;
    const size_t row0 = (size_t)b * SEQ + (size_t)n * CHK;
    LAS unsigned char* Vl = F.lds + grp * 65536;
    { const int t4 = tid & 255;
        v4u vreg[8];
#pragma unroll
        for (int p = 0; p < 8; ++p) { const int idx = p * 256 + t4, key = idx >> 4, ch = idx & 15;
            vreg[p] = *(const v4u*)(F.PROJ + (row0 + key) * NPROJ + C_RV + h * RV + ch * 8); }
#pragma unroll
        for (int p = 0; p < 8; ++p) { const int idx = p * 256 + t4, key = idx >> 4, ch = idx & 15;
            *(LAS v4u*)(Vl + (ch >> 2) * (128 * 64) + (key >> 3) * 512 + (key & 7) * 64 + (ch & 3) * 16) = vreg[p]; } }
}
__device__ __forceinline__ void ret_front_part(Frame& F, int pair, int t) {
    v4u vreg[10];
#pragma unroll
    for (int p = 0; p < 10; ++p) { const int idx = p * 448 + t; if (idx < 4096) { const int grp = idx >> 11, pc = idx & 2047, key = pc >> 4, ch = pc & 15;
        const int cid = 2 * pair + grp, n = cid & 63, h = (cid >> 6) & 3, b = cid >> 8; const size_t row0 = (size_t)b * SEQ + (size_t)n * CHK;
        vreg[p] = *(const v4u*)(F.PROJ + (row0 + key) * NPROJ + C_RV + h * RV + ch * 8); } }
#pragma unroll
    for (int p = 0; p < 10; ++p) { const int idx = p * 448 + t; if (idx < 4096) { const int grp = idx >> 11, pc = idx & 2047, key = pc >> 4, ch = pc & 15;
        *(LAS v4u*)(F.lds + grp * 65536 + (ch >> 2) * (128 * 64) + (key >> 3) * 512 + (key & 7) * 64 + (ch & 3) * 16) = vreg[p]; } }
}
__device__ __forceinline__ void xcd_barrier_retfront(const XcdBarrier& b, Frame& F, int pair) {
    asm volatile("s_waitcnt vmcnt(0)" ::: "memory");
    __syncthreads();
    if (threadIdx.x == 0) {
        unsigned* bar = b.bar;
        __builtin_amdgcn_s_waitcnt(0);
        unsigned nloc = b.st[0], nx = b.st[1];
        if (nloc == 0u) { xcd_barrier_complete(bar, b.x, nloc, nx); b.st[0] = nloc; b.st[1] = nx; }
        const unsigned old = xb_add(&bar[XB_XSUB(b.x)], 1u);
        const unsigned gen = old / nloc;
        if (old + 1u == (gen + 1u) * nloc) {
            __builtin_amdgcn_fence(__ATOMIC_RELEASE, "agent");
            asm volatile("s_waitcnt vmcnt(0)" ::: "memory");
            const unsigned og = xb_add(&bar[XB_TOP], 1u);
            const unsigned tg = og / nx;
            if (og + 1u == (tg + 1u) * nx) xb_add(&bar[XB_TOPGEN], 1u);
            else XB_SPIN(xb_ld(&bar[XB_TOPGEN]) == tg, bar);
            __builtin_amdgcn_fence(__ATOMIC_ACQUIRE, "agent");
            xb_add(&bar[XB_XGEN(b.x)], 1u);
            asm volatile("s_waitcnt vmcnt(0)" ::: "memory");
        } else {
            XB_SPIN(xb_ld(&bar[XB_XGEN(b.x)]) == gen, bar);
            __builtin_amdgcn_fence(__ATOMIC_ACQUIRE, "agent");
            asm volatile("s_waitcnt vmcnt(0)" ::: "memory");
        }
    } else if (threadIdx.x >= 64) ret_front_part(F, pair, (int)threadIdx.x - 64);
    __syncthreads();
}
__device__ __forceinline__ void ret_back(Frame& F, int pair) {
    const int tid = F.tid, wave = F.wave; int lane = F.lane; asm volatile("" : "+v"(lane));
    const int i = lane & 31, hi = lane >> 5, grp = wave >> 2, w4 = wave & 3;
    const int cid = 2 * pair + grp, n = cid & 63, h = (cid >> 6) & 3, b = cid >> 8;
    const float lgf = lgdec(F, h, 0), lgb = lgdec(F, h, 1);
    const size_t row0 = (size_t)b * SEQ + (size_t)n * CHK;
    LAS unsigned char* Vl = F.lds + grp * 65536;
    LAS unsigned char* Pl = Vl + 32768;
    const int qi = 32 * w4 + i; const size_t qrow = row0 + qi;
    bf16x8 qf[4], kf[4][4];
    { const bf16* qp = F.PROJ + qrow * NPROJ + C_RQ + h * RQK + hi * 8;
#pragma unroll
      for (int s = 0; s < 4; ++s) qf[s] = *(const bf16x8*)(qp + 16 * s);
#pragma unroll
      for (int T = 0; T < 4; ++T) { const bf16* kp_ = F.PROJ + (row0 + 32 * T + i) * NPROJ + C_RK + h * RQK + hi * 8;
#pragma unroll
          for (int s_ = 0; s_ < 4; ++s_) kf[T][s_] = *(const bf16x8*)(kp_ + 16 * s_); } }
    {
        const int t4 = tid & 255;
        v4u preg[8];
        const bf16* pf = F.PREV + ((size_t)(((b * RH + h) * 2 + 0) * NCH + n)) * (RV * RQK);
#pragma unroll
        for (int p = 0; p < 4; ++p) { const unsigned idx = p * 256 + t4;
            preg[p] = *(const v4u*)(pf + idx * 8u); preg[4 + p] = *(const v4u*)(pf + (unsigned)(NCH * RV * RQK) + idx * 8u); }
#pragma unroll
        for (int p = 0; p < 4; ++p) { const int idx = p * 256 + t4, rw = idx >> 3, ch = idx & 7; const int off = rw * 128 + ((ch ^ (rw & 7)) << 4);
            *(LAS v4u*)(Pl + off) = preg[p]; *(LAS v4u*)(Pl + 16384 + off) = preg[4 + p]; }
    }
    f32x16 acc[4];
    __syncthreads();
#pragma unroll
    for (int T = 0; T < 4; ++T) {
        f32x16 a = {};
#pragma unroll
        for (int s = 0; s < 4; ++s) a = __builtin_amdgcn_mfma_f32_32x32x16_bf16(kf[T][s], qf[s], a, 0, 0, 0);
        acc[T] = a;
    }
    v2u gw[4][4];
    { const bf16* gp = F.PROJ + qrow * NPROJ + C_RG + h * RV + 4 * hi;
#pragma unroll
      for (int dvt = 0; dvt < 4; ++dvt)
#pragma unroll
          for (int g = 0; g < 4; ++g) gw[dvt][g] = *(const v2u*)(gp + 32 * dvt + 8 * g); }
#pragma unroll
    for (int T = 0; T < 4; ++T)
#pragma unroll
        for (int rr = 0; rr < 16; ++rr) { const int rel = qi - (32 * T + crow(rr, hi)); const float e = rel >= 0 ? lgf * (float)rel : -lgb * (float)rel; acc[T][rr] *= ex2(e); }
    f32x16 o[4]; o[0] = f32x16{}; o[1] = f32x16{}; o[2] = f32x16{}; o[3] = f32x16{};
    const LAS unsigned char* vb = Vl + ((lane >> 4) & 1) * 32 + (lane & 3) * 8 + (4 * hi + ((lane & 15) >> 2)) * 64;
#pragma unroll
    for (int T = 0; T < 4; ++T)
#pragma unroll
        for (int u = 0; u < 2; ++u) {
            v4u pw; pw.x = pk2(acc[T][8 * u + 0], acc[T][8 * u + 1]); pw.y = pk2(acc[T][8 * u + 2], acc[T][8 * u + 3]); pw.z = pk2(acc[T][8 * u + 4], acc[T][8 * u + 5]); pw.w = pk2(acc[T][8 * u + 6], acc[T][8 * u + 7]);
            const bf16x8 pb = __builtin_bit_cast(bf16x8, pw);
#pragma unroll
            for (int dvt = 0; dvt < 4; ++dvt) {
                const LAS unsigned char* a = vb + dvt * (128 * 64) + (4 * T + 2 * u) * 512;
                o[dvt] = __builtin_amdgcn_mfma_f32_32x32x16_bf16(cat8(vtr(a), vtr(a + 512)), pb, o[dvt], 0, 0, 0);
            }
            asm volatile("" ::: "memory");
        }
    {
        const float sf = ex2(lgf * (float)(qi + 1)), sb = ex2(lgb * (float)(CHK - qi));
#pragma unroll
        for (int s = 0; s < 4; ++s) {
            const bf16x8 qs_f = scale8(qf[s], sf), qs_b = scale8(qf[s], sb);
#pragma unroll
            for (int dvt = 0; dvt < 4; ++dvt) { const int rw = 32 * dvt + i; const int off = rw * 128 + (((2 * s + hi) ^ (rw & 7)) << 4);
                const bf16x8 af = *(const LAS bf16x8*)(Pl + off), ab = *(const LAS bf16x8*)(Pl + 16384 + off);
                o[dvt] = __builtin_amdgcn_mfma_f32_32x32x16_bf16(af, qs_f, o[dvt], 0, 0, 0);
                o[dvt] = __builtin_amdgcn_mfma_f32_32x32x16_bf16(ab, qs_b, o[dvt], 0, 0, 0);
            }
            asm volatile("" ::: "memory");
        }
    }
    float s1 = 0.f;
#pragma unroll
    for (int dvt = 0; dvt < 4; ++dvt)
#pragma unroll
        for (int rr = 0; rr < 16; ++rr) s1 += o[dvt][rr];
    s1 = sum_xor32(s1); const float mean = s1 * (1.f / RV);
    float s2 = 0.f;
#pragma unroll
    for (int dvt = 0; dvt < 4; ++dvt)
#pragma unroll
        for (int rr = 0; rr < 16; ++rr) { const float dlt = o[dvt][rr] - mean; s2 += dlt * dlt; }
    s2 = sum_xor32(s2); const float rstd = __builtin_amdgcn_rsqf(s2 * (1.f / RV) + GN_EPS);
    unsigned char* yp = (unsigned char*)F.Y + qrow * DM + h * RV;
    const float r16_ = rstd * YS8, mr16_ = -mean * r16_;
#pragma unroll
    for (int dvt = 0; dvt < 4; ++dvt) { unsigned W[4];
#pragma unroll
        for (int g = 0; g < 4; ++g) { const v2u gwv = gw[dvt][g];
            float gv[4] = {bflo(gwv.x), bfhi(gwv.x), bflo(gwv.y), bfhi(gwv.y)}; float yv[4];
#pragma unroll
            for (int k = 0; k < 4; ++k) { const float sg = gv[k] * __builtin_amdgcn_rcpf(1.f + ex2(-gv[k] * LOG2E)); yv[k] = __builtin_amdgcn_fmed3f(sg * __builtin_fmaf(o[dvt][4 * g + k], r16_, mr16_), -448.f, 448.f); }
            W[g] = pg8::cvt4_fp8(yv[0], yv[1], yv[2], yv[3]); }
        const auto s02 = __builtin_amdgcn_permlane32_swap(W[0], W[2], false, false), s13 = __builtin_amdgcn_permlane32_swap(W[1], W[3], false, false);
        v4u w; w.x = s02[0]; w.y = s02[1]; w.z = s13[0]; w.w = s13[1];
        *(v4u*)(yp + 32 * dvt + 16 * hi) = w; }
    __syncthreads();
}
constexpr int NRETU = BATCH * RH * NCH / 2;
__device__ __forceinline__ void phase_p4(Frame& F, bool pre) {
    for (int p = F.vcu; p < NRETU; p += F.G) { if (!(pre && p == F.vcu)) { ret_front(F, p); } ret_back(F, p); } }
constexpr int WR_PITCH = DM + 4;
#define DPPF(v, ctrl) __int_as_float(__builtin_amdgcn_update_dpp(0, __float_as_int(v), ctrl, 0xf, 0xf, false))
__device__ __forceinline__ float lane_xor4(float t) {
    int u = __builtin_amdgcn_update_dpp(0, __float_as_int(t), 0x12c, 0xf, 0x5, false); u = __builtin_amdgcn_update_dpp(u, __float_as_int(t), 0x124, 0xf, 0xa, false); return __int_as_float(u); }
__device__ __forceinline__ float pair32(float a, float b) { const auto s = __builtin_amdgcn_permlane32_swap(__float_as_uint(a), __float_as_uint(b), false, false); return __uint_as_float(s[0]) + __uint_as_float(s[1]); }
__device__ __forceinline__ float pair16(float a, float b) { const auto s = __builtin_amdgcn_permlane16_swap(__float_as_uint(a), __float_as_uint(b), false, false); return __uint_as_float(s[0]) + __uint_as_float(s[1]); }
__device__ __forceinline__ float fold16(const float (&p)[NE], int lane) {
    float a[8], b[4], c[2], d;
#pragma unroll
    for (int i = 0; i < 8; ++i) a[i] = pair32(p[i], p[8 + i]);
#pragma unroll
    for (int i = 0; i < 4; ++i) b[i] = pair16(a[i], a[4 + i]);
    { const bool hi = (lane & 8) != 0;
#pragma unroll
      for (int i = 0; i < 2; ++i) { const float send = hi ? b[i] : b[2 + i], keep = hi ? b[2 + i] : b[i]; c[i] = keep + DPPF(send, 0x128); } }
    { const bool hi = (lane & 4) != 0; const float send = hi ? c[0] : c[1], keep = hi ? c[1] : c[0]; d = keep + lane_xor4(send); }
    d += DPPF(d, 0x4e); d += DPPF(d, 0xb1);
    return d;
}
__device__ __forceinline__ float max_mod4(float v) {
    v = fmaxf(v, DPPF(v, 0x124)); v = fmaxf(v, DPPF(v, 0x128));
    { const auto s = __builtin_amdgcn_permlane16_swap(__float_as_uint(v), __float_as_uint(v), false, false); v = fmaxf(__uint_as_float(s[0]), __uint_as_float(s[1])); }
    { const auto s = __builtin_amdgcn_permlane32_swap(__float_as_uint(v), __float_as_uint(v), false, false); v = fmaxf(__uint_as_float(s[0]), __uint_as_float(s[1])); }
    return v;
}
__device__ __forceinline__ float sum_mod4(float v) {
    v += DPPF(v, 0x124); v += DPPF(v, 0x128);
    { const auto s = __builtin_amdgcn_permlane16_swap(__float_as_uint(v), __float_as_uint(v), false, false); v = __uint_as_float(s[0]) + __uint_as_float(s[1]); }
    { const auto s = __builtin_amdgcn_permlane32_swap(__float_as_uint(v), __float_as_uint(v), false, false); v = __uint_as_float(s[0]) + __uint_as_float(s[1]); }
    return v;
}
__device__ __forceinline__ void p6_fill_part(Frame& F, int t0, int nt) {
    LAS float* wr = (LAS float*)F.lds;
    for (int idx = t0; idx < DM * NE; idx += nt) wr[(idx & 15) * WR_PITCH + (idx >> 4)] = F.w_router[idx];
    LAS float* cl = (LAS float*)(F.lds + 69632);
    for (int idx = t0; idx < BATCH * 3 * DM; idx += nt) { const int b = idx / (3 * DM), r = idx % (3 * DM), which = r / DM, c = r % DM;
        cl[idx] = (which == 2) ? F.MOD[b * 6 * DM + 3 * DM + c] : F.MOD[COEF_OFF + (b * 2 + which) * DM + c]; }
}
__device__ __forceinline__ void p6_fill(Frame& F) { p6_fill_part(F, F.tid, NWAVES * 64); }
__device__ __forceinline__ void xcd_barrier_p6fill(const XcdBarrier& b, Frame& F) {
    asm volatile("s_waitcnt vmcnt(0)" ::: "memory");
    __syncthreads();
    if (threadIdx.x == 0) {
        unsigned* bar = b.bar;
        __builtin_amdgcn_s_waitcnt(0);
        unsigned nloc = b.st[0], nx = b.st[1];
        if (nloc == 0u) { xcd_barrier_complete(bar, b.x, nloc, nx); b.st[0] = nloc; b.st[1] = nx; }
        const unsigned old = xb_add(&bar[XB_XSUB(b.x)], 1u);
        const unsigned gen = old / nloc;
        if (old + 1u == (gen + 1u) * nloc) {
            __builtin_amdgcn_fence(__ATOMIC_RELEASE, "agent");
            asm volatile("s_waitcnt vmcnt(0)" ::: "memory");
            const unsigned og = xb_add(&bar[XB_TOP], 1u);
            const unsigned tg = og / nx;
            if (og + 1u == (tg + 1u) * nx) xb_add(&bar[XB_TOPGEN], 1u);
            else XB_SPIN(xb_ld(&bar[XB_TOPGEN]) == tg, bar);
            __builtin_amdgcn_fence(__ATOMIC_ACQUIRE, "agent");
            xb_add(&bar[XB_XGEN(b.x)], 1u);
            asm volatile("s_waitcnt vmcnt(0)" ::: "memory");
        } else {
            XB_SPIN(xb_ld(&bar[XB_XGEN(b.x)]) == gen, bar);
            __builtin_amdgcn_fence(__ATOMIC_ACQUIRE, "agent");
            asm volatile("s_waitcnt vmcnt(0)" ::: "memory");
        }
    } else if (threadIdx.x >= 64) p6_fill_part(F, (int)threadIdx.x - 64, NWAVES * 64 - 64);
    __syncthreads();
}
__device__ __forceinline__ void phase_p6(Frame& F, bool filled) {
    LAS float* wr = (LAS float*)F.lds; LAS float* cl = (LAS float*)(F.lds + 69632);
    if (!filled) p6_fill(F);
    __syncthreads();
    const int gw = F.vcu * NWAVES + F.wave, NGW = F.G * NWAVES, lane = F.lane;
    constexpr int RB = 2;
    for (int m0 = gw; m0 < MTOK; m0 += RB * NGW) {
        v2u mw[RB][4]; f32x4 xv[RB][4]; int mrow[RB]; float r2[RB];
#pragma unroll
        for (int q = 0; q < RB; ++q) { mrow[q] = m0 + q * NGW; const size_t m = mrow[q];
#pragma unroll
            for (int j = 0; j < 4; ++j) { mw[q][j] = *(const v2u*)(F.MIXB + m * DM + 4 * lane + 256 * j); xv[q][j] = __builtin_nontemporal_load((const f32x4*)(F.x + m * DM + 4 * lane + 256 * j)); } }
#pragma unroll
        for (int q = 0; q < RB; ++q) { const int m = mrow[q]; const LAS float* cf = cl + (m / SEQ) * 3 * DM;
            f32x4 mv[4]; float s = 0.f;
#pragma unroll
            for (int j = 0; j < 4; ++j) { const v2u w = mw[q][j]; mv[j] = (f32x4){bflo(w.x), bfhi(w.x), bflo(w.y), bfhi(w.y)}; s += (mv[j].x * mv[j].x + mv[j].y * mv[j].y) + (mv[j].z * mv[j].z + mv[j].w * mv[j].w); }
            const float r1 = __builtin_amdgcn_rsqf(wave_sum(s) * (1.f / DM) + RMS_EPS);
            float s2 = 0.f;
#pragma unroll
            for (int j = 0; j < 4; ++j) { const int c = 4 * lane + 256 * j;
                const f32x4 a1 = *(const LAS f32x4*)(cf + c);
                const f32x4 x1 = xv[q][j] + a1 * (mv[j] * r1); xv[q][j] = x1;
                { v2u w; w.x = pk2(x1.x, x1.y); w.y = pk2(x1.z, x1.w); __builtin_nontemporal_store(w, (v2u*)(F.X1B + (size_t)m * DM + c)); }
                s2 += (x1.x * x1.x + x1.y * x1.y) + (x1.z * x1.z + x1.w * x1.w); }
            r2[q] = __builtin_amdgcn_rsqf(wave_sum(s2) * (1.f / DM) + RMS_EPS); asm volatile("" ::: "memory"); }
        f32x2p lg2[NE];
#pragma unroll
        for (int e = 0; e < NE; ++e) lg2[e] = (f32x2p){0.f, 0.f};
#pragma unroll
        for (int j = 0; j < 4; ++j) { const int c = 4 * lane + 256 * j; f32x4 h[RB];
#pragma unroll
            for (int q = 0; q < RB; ++q) { const int m = mrow[q], b = m / SEQ;
                const f32x4 a2 = *(const LAS f32x4*)(cl + (b * 3 + 1) * DM + c), sh = *(const LAS f32x4*)(cl + (b * 3 + 2) * DM + c);
                h[q] = xv[q][j] * r2[q] * a2 + sh;
                *(unsigned*)((unsigned char*)F.XN + (size_t)m * DM + c) = pg8::cvt4_fp8(h[q].x, h[q].y, h[q].z, h[q].w); }
            const f32x2p hx = {h[0].x, h[1].x}, hy = {h[0].y, h[1].y}, hz = {h[0].z, h[1].z}, hw = {h[0].w, h[1].w};
#pragma unroll
            for (int e = 0; e < NE; ++e) { const f32x4 wv = *(const LAS f32x4*)(wr + e * WR_PITCH + c);
                lg2[e] += hx * wv.x; lg2[e] += hy * wv.y; lg2[e] += hz * wv.z; lg2[e] += hw * wv.w;
                if ((e & 3) == 3) asm volatile("" ::: "memory"); } }
        float lg[RB][NE];
#pragma unroll
        for (int e = 0; e < NE; ++e) { lg[0][e] = lg2[e].x; lg[1][e] = lg2[e].y; }
#pragma unroll
        for (int q = 0; q < RB; ++q) { const int m = mrow[q], b = m / SEQ, spos = m % SEQ;
            const float tot = fold16(lg[q], lane);
            const float mxl = max_mod4(tot);
            const float ex = __expf(tot - mxl); const float den = sum_mod4(ex);
            const int eL = ((lane >> 5) & 1) * 8 + ((lane >> 4) & 1) * 4 + ((lane >> 3) & 1) * 2 + ((lane >> 2) & 1);
            if ((lane & 3) == 0) F.AFF[((size_t)b * NE + eL) * SEQ + spos] = ex / den; }
    }
}
#undef DPPF
__device__ __forceinline__ int block_excl_scan(int v, LAS int* wsum, int tid, int lane, int wave, int& total) {
    int inc = v;
    inc += __builtin_amdgcn_update_dpp(0, inc, 0x111, 0xf, 0xf, true);
    inc += __builtin_amdgcn_update_dpp(0, inc, 0x112, 0xf, 0xf, true);
    inc += __builtin_amdgcn_update_dpp(0, inc, 0x114, 0xf, 0xf, true);
    inc += __builtin_amdgcn_update_dpp(0, inc, 0x118, 0xf, 0xf, true);
    inc += __builtin_amdgcn_update_dpp(0, inc, 0x142, 0xa, 0xf, false);
    inc += __builtin_amdgcn_update_dpp(0, inc, 0x143, 0xc, 0xf, false);
    (void)lane;
    __syncthreads();
    if (lane == 63) wsum[wave] = inc;
    __syncthreads();
    int base = 0, tot = 0;
#pragma unroll
    for (int w = 0; w < NWAVES; ++w) { const int t = wsum[w]; if (w < wave) base += t; tot += t; }
    total = tot; (void)tid;
    return base + inc - v;
}
__device__ __forceinline__ void topk_pair(Frame& F, int be, bool write_slotof) {
    const int b = be / NE, e = be % NE, tid = F.tid;
    LAS int* hist = (LAS int*)F.lds; LAS int* wsum = hist + 2048; LAS int* bc = hist + 2064;
    const float* a = F.AFF + (size_t)be * SEQ;
    unsigned v[16];
#pragma unroll
    for (int q = 0; q < 4; ++q) { const v4u t = *(const v4u*)(a + tid * 16 + q * 4); v[4 * q] = t.x; v[4 * q + 1] = t.y; v[4 * q + 2] = t.z; v[4 * q + 3] = t.w; }
    unsigned prefix = 0u; int kk = CAP;
#pragma unroll
    for (int pass = 0; pass < 3; ++pass) {
        constexpr int SH[3] = {21, 10, 0}, NB[3] = {2048, 2048, 1024};
        const int shift = SH[pass], nb = NB[pass], per = nb / 512; const unsigned hmask = (pass == 0) ? 0u : (0xffffffffu << SH[pass == 0 ? 0 : pass - 1]);
#pragma unroll
        for (int j = 0; j < 4; ++j) if (j < per) hist[tid * per + j] = 0;
        __syncthreads();
#pragma unroll
        for (int q = 0; q < 16; ++q) { if (((v[q] ^ prefix) & hmask) == 0u) __hip_atomic_fetch_add(&hist[(v[q] >> shift) & (unsigned)(nb - 1)], 1, __ATOMIC_RELAXED, __HIP_MEMORY_SCOPE_WORKGROUP); }
        __syncthreads();
        {
            int h[4]; int loc = 0;
#pragma unroll
            for (int j = 0; j < 4; ++j) { h[j] = (j < per) ? hist[nb - 1 - (tid * per + j)] : 0; loc += h[j]; }
            int tot_; int cum = block_excl_scan(loc, wsum, tid, F.lane, F.wave, tot_);
#pragma unroll
            for (int j = 0; j < 4; ++j) { if (j < per && cum < kk && kk <= cum + h[j]) { bc[0] = nb - 1 - (tid * per + j); bc[1] = kk - cum; } cum += h[j]; }
        }
        __syncthreads();
        prefix |= (unsigned)bc[0] << shift; kk = bc[1];
        __syncthreads();
    }
    int ceq = 0;
#pragma unroll
    for (int q = 0; q < 16; ++q) ceq += (v[q] == prefix) ? 1 : 0;
    int tot; int eqbase = block_excl_scan(ceq, wsum, tid, F.lane, F.wave, tot);
    unsigned selmask = 0u; int csel = 0;
#pragma unroll
    for (int q = 0; q < 16; ++q) { bool s = v[q] > prefix; if (v[q] == prefix) { s = eqbase < kk; ++eqbase; } if (s) { selmask |= 1u << q; ++csel; } }
    __syncthreads();
    int slot = block_excl_scan(csel, wsum, tid, F.lane, F.wave, tot);
    const int rowbase = (e * BATCH + b) * CAP;
#pragma unroll
    for (int q = 0; q < 16; ++q) { const int tok = b * SEQ + tid * 16 + q; int so = -1;
        if (selmask & (1u << q)) { const int row = rowbase + (slot < CAP ? slot : CAP - 1); so = row; F.TOK[row] = tok; F.GATEV[row] = __uint_as_float(v[q]); ++slot; }
        if (write_slotof) F.SLOTOF[(size_t)be * SEQ + tid * 16 + q] = so; }
    __syncthreads();
}
__device__ __forceinline__ void topk_pair2(Frame& F, int be0, int be1, int mtq, bool wg, int slo0, int shi0, int slo1, int shi1, bool wtok) {
    const int tid = F.tid;
    LAS int* hist = (LAS int*)F.lds; LAS int* wsum = hist + 2048; LAS int* bc = hist + 2064;
    const float* a0 = F.AFF + (size_t)be0 * SEQ; const float* a1 = F.AFF + (size_t)be1 * SEQ;
    unsigned v[16], w[16];
#pragma unroll
    for (int q = 0; q < 4; ++q) { const v4u t = *(const v4u*)(a0 + tid * 16 + q * 4); v[4 * q] = t.x; v[4 * q + 1] = t.y; v[4 * q + 2] = t.z; v[4 * q + 3] = t.w;
                                  const v4u s = *(const v4u*)(a1 + tid * 16 + q * 4); w[4 * q] = s.x; w[4 * q + 1] = s.y; w[4 * q + 2] = s.z; w[4 * q + 3] = s.w; }
    unsigned pf0 = 0u, pf1 = 0u; int k0 = CAP, k1 = CAP;
#pragma unroll
    for (int pass = 0; pass < 3; ++pass) {
        constexpr int SH[3] = {21, 10, 0}, NB[3] = {2048, 2048, 1024};
        const int shift = SH[pass], nb = NB[pass], per = nb / 512; const unsigned hmask = (pass == 0) ? 0u : (0xffffffffu << SH[pass == 0 ? 0 : pass - 1]);
        if (pass == 0) {
#pragma unroll
            for (int j = 0; j < 4; ++j) if (j < per) hist[tid * per + j] = 0;
            __syncthreads(); }
#pragma unroll
        for (int q = 0; q < 16; ++q) {
            if (((v[q] ^ pf0) & hmask) == 0u) __hip_atomic_fetch_add(&hist[(v[q] >> shift) & (unsigned)(nb - 1)], 1, __ATOMIC_RELAXED, __HIP_MEMORY_SCOPE_WORKGROUP);
            if (((w[q] ^ pf1) & hmask) == 0u) __hip_atomic_fetch_add(&hist[(w[q] >> shift) & (unsigned)(nb - 1)], 0x10000, __ATOMIC_RELAXED, __HIP_MEMORY_SCOPE_WORKGROUP); }
        __syncthreads();
        {
            int h[4]; int loc = 0;
#pragma unroll
            for (int j = 0; j < 4; ++j) { h[j] = (j < per) ? hist[nb - 1 - (tid * per + j)] : 0; loc += h[j]; if (j < per) hist[nb - 1 - (tid * per + j)] = 0; }
            int tot_; const int cum = block_excl_scan(loc, wsum, tid, F.lane, F.wave, tot_);
            int c0 = cum & 0xffff, c1 = cum >> 16;
#pragma unroll
            for (int j = 0; j < 4; ++j) { const int h0 = h[j] & 0xffff, h1 = h[j] >> 16;
                if (j < per && c0 < k0 && k0 <= c0 + h0) { bc[4 * pass + 0] = nb - 1 - (tid * per + j); bc[4 * pass + 1] = k0 - c0; }
                if (j < per && c1 < k1 && k1 <= c1 + h1) { bc[4 * pass + 2] = nb - 1 - (tid * per + j); bc[4 * pass + 3] = k1 - c1; }
                c0 += h0; c1 += h1; }
        }
        __syncthreads();
        pf0 |= (unsigned)bc[4 * pass + 0] << shift; k0 = bc[4 * pass + 1]; pf1 |= (unsigned)bc[4 * pass + 2] << shift; k1 = bc[4 * pass + 3];
    }
    int ceq = 0;
#pragma unroll
    for (int q = 0; q < 16; ++q) ceq += ((v[q] == pf0) ? 1 : 0) + ((w[q] == pf1) ? 0x10000 : 0);
    int tot; const int eqb = block_excl_scan(ceq, wsum, tid, F.lane, F.wave, tot);
    int eq0 = eqb & 0xffff, eq1 = eqb >> 16;
    unsigned sm0 = 0u, sm1 = 0u; int csel = 0;
#pragma unroll
    for (int q = 0; q < 16; ++q) {
        bool s = v[q] > pf0; if (v[q] == pf0) { s = eq0 < k0; ++eq0; } if (s) { sm0 |= 1u << q; csel += 1; }
        bool t = w[q] > pf1; if (w[q] == pf1) { t = eq1 < k1; ++eq1; } if (t) { sm1 |= 1u << q; csel += 0x10000; } }
    __syncthreads();
    const int sl = block_excl_scan(csel, wsum, tid, F.lane, F.wave, tot);
    int s0 = sl & 0xffff, s1 = sl >> 16;
    const int b0 = be0 / NE, e0 = be0 % NE, b1 = be1 / NE, e1 = be1 % NE;
    const int rb0 = (e0 * BATCH + b0) * CAP, rb1 = (e1 * BATCH + b1) * CAP;
    int so0[16], so1[16];
    LAS int* tokl = (LAS int*)(F.lds + 16384);
#pragma unroll
    for (int q = 0; q < 16; ++q) { so0[q] = -1; so1[q] = -1;
        if (sm0 & (1u << q)) { const int sc = (s0 < CAP ? s0 : CAP - 1); so0[q] = rb0 + sc; tokl[sc] = b0 * SEQ + tid * 16 + q; tokl[2 * CAP + sc] = (int)v[q]; ++s0; }
        if (sm1 & (1u << q)) { const int sc = (s1 < CAP ? s1 : CAP - 1); so1[q] = rb1 + sc; tokl[CAP + sc] = b1 * SEQ + tid * 16 + q; tokl[3 * CAP + sc] = (int)w[q]; ++s1; } }
    __syncthreads();
    if (mtq >= 0) { const int pr = tid >> 8, sc = mtq * 256 + (tid & 255), row = (pr ? rb1 : rb0) + sc;
        if (wtok) F.TOK[row] = tokl[pr * CAP + sc]; if (wg) F.GATEV[row] = __int_as_float(tokl[(2 + pr) * CAP + sc]); }
    else {
#pragma unroll
        for (int it = 0; it < 4; ++it) { const int pr = it >> 1, sc = (it & 1) * 512 + tid, row = (pr ? rb1 : rb0) + sc;
            F.TOK[row] = tokl[pr * CAP + sc]; if (wg) F.GATEV[row] = __int_as_float(tokl[(2 + pr) * CAP + sc]); } }
    if (tid >= slo0 && tid < shi0) {
#pragma unroll
        for (int q = 0; q < 4; ++q) { v4u o; o.x = (unsigned)so0[4 * q]; o.y = (unsigned)so0[4 * q + 1]; o.z = (unsigned)so0[4 * q + 2]; o.w = (unsigned)so0[4 * q + 3]; *(v4u*)(F.SLOTOF + (size_t)be0 * SEQ + tid * 16 + 4 * q) = o; } }
    if (tid >= slo1 && tid < shi1) {
#pragma unroll
        for (int q = 0; q < 4; ++q) { v4u o; o.x = (unsigned)so1[4 * q]; o.y = (unsigned)so1[4 * q + 1]; o.z = (unsigned)so1[4 * q + 2]; o.w = (unsigned)so1[4 * q + 3]; *(v4u*)(F.SLOTOF + (size_t)be1 * SEQ + tid * 16 + 4 * q) = o; } }
    __syncthreads();
}
__device__ __forceinline__ void phase_p10(Frame& F) {
    const int gw = F.vcu * NWAVES + F.wave, NGW = F.G * NWAVES, lane = F.lane;
    constexpr int RB = 2;
    f32x4 GF[4]; int curb = -1;
    int nslot[RB];
#define P10_SLOTS(M0) do { _Pragma("unroll") for (int q = 0; q < RB; ++q) { const int mm = (M0) + q * NGW; const size_t m = mm < MTOK ? mm : (M0); \
        nslot[q] = (lane < NE) ? F.SLOTOF[((m / SEQ) * NE + lane) * SEQ + (m % SEQ)] : -1; } } while (0)
    if (gw < MTOK) P10_SLOTS(gw);
    for (int m0 = gw; m0 < MTOK; m0 += RB * NGW) {
        f32x4 acc[RB][4]; int myslot[RB]; f32x4 x1[RB][4];
#pragma unroll
        for (int q = 0; q < RB; ++q) myslot[q] = nslot[q];
        if (m0 + RB * NGW < MTOK) P10_SLOTS(m0 + RB * NGW);
#pragma unroll
        for (int q = 0; q < RB; ++q) { const int mm = m0 + q * NGW; const size_t m = mm < MTOK ? mm : m0;
#pragma unroll
            for (int j = 0; j < 4; ++j) { const v2u w = __builtin_nontemporal_load((const v2u*)(F.X1B + m * DM + 4 * lane + 256 * j)); x1[q][j] = (f32x4){bflo(w.x), bfhi(w.x), bflo(w.y), bfhi(w.y)}; acc[q][j] = (f32x4){0.f, 0.f, 0.f, 0.f}; } }
        unsigned mk[RB];
#pragma unroll
        for (int q = 0; q < RB; ++q) mk[q] = (unsigned)__ballot(myslot[q] >= 0);
        while (mk[0] | mk[1]) {
            unsigned w[RB][2][4]; float g[RB][2];
#pragma unroll
            for (int q = 0; q < RB; ++q) {
                int e0 = 0, e1 = 0; bool v0 = false, v1 = false;
                if (mk[q]) { e0 = __builtin_ctz(mk[q]); mk[q] &= mk[q] - 1; v0 = true; }
                if (mk[q]) { e1 = __builtin_ctz(mk[q]); mk[q] &= mk[q] - 1; v1 = true; }
                int r0 = __builtin_amdgcn_readlane(myslot[q], e0), r1 = __builtin_amdgcn_readlane(myslot[q], e1);
                r0 = v0 ? r0 : 0; r1 = v1 ? r1 : r0;
                const float g0 = F.GATEV[r0], g1 = F.GATEV[r1]; g[q][0] = v0 ? g0 : 0.f; g[q][1] = v1 ? g1 : 0.f;
                const unsigned* y0 = (const unsigned*)((const unsigned char*)F.YE + (size_t)r0 * DM) + lane; const unsigned* y1 = (const unsigned*)((const unsigned char*)F.YE + (size_t)r1 * DM) + lane;
#pragma unroll
                for (int j = 0; j < 4; ++j) { w[q][0][j] = __builtin_nontemporal_load(y0 + 64 * j); w[q][1][j] = __builtin_nontemporal_load(y1 + 64 * j); } }
#pragma unroll
            for (int q = 0; q < RB; ++q)
#pragma unroll
                for (int k = 0; k < 2; ++k)
#pragma unroll
                    for (int j = 0; j < 4; ++j) { const auto lo = __builtin_amdgcn_cvt_pk_f32_fp8(w[q][k][j], false), hi = __builtin_amdgcn_cvt_pk_f32_fp8(w[q][k][j], true);
                        acc[q][j] += (f32x4){lo[0], lo[1], hi[0], hi[1]} * g[q][k]; }
        }
#pragma unroll
        for (int q = 0; q < RB; ++q) { const int m = m0 + q * NGW; if (m >= MTOK) break;
            { const int b = m / SEQ; if (b != curb) { const float* mod = F.MOD + b * 6 * DM;
#pragma unroll
                for (int j = 0; j < 4; ++j) { const int c = 4 * lane + 256 * j; GF[j] = *(const f32x4*)(F.g_post_ffn + c) * *(const f32x4*)(mod + 5 * DM + c); } curb = b; } }
            float s = 0.f;
#pragma unroll
            for (int j = 0; j < 4; ++j) s += (acc[q][j].x * acc[q][j].x + acc[q][j].y * acc[q][j].y) + (acc[q][j].z * acc[q][j].z + acc[q][j].w * acc[q][j].w);
            const float rr = __builtin_amdgcn_rsqf(wave_sum(s) * (1.f / DM) + RMS_EPS);
            float* orow = F.out + (size_t)m * DM;
#pragma unroll
            for (int j = 0; j < 4; ++j) { const int c = 4 * lane + 256 * j;
                __builtin_nontemporal_store(x1[q][j] + GF[j] * (acc[q][j] * rr), (f32x4*)(orow + c)); } }
    }
}
#undef P10_SLOTS
struct Args { const float* in[16]; float* out; unsigned char* ws; int ph_lo, ph_hi; };
__global__ void __launch_bounds__(NWAVES * 64, 2) mk_fwd(Args args) {
    extern __shared__ __attribute__((aligned(16))) unsigned char lds[];
    Frame F; F.ts_a = 0; F.ts_b = 0;
    F.lds = (LAS unsigned char*)lds;
    F.MISC = (volatile LAS unsigned*)(F.lds + MISC_OFF);
    F.tid = threadIdx.x; F.lane = F.tid & 63; F.wave = __builtin_amdgcn_readfirstlane(F.tid >> 6);
    F.G = gridDim.x; { const int bx = blockIdx.x; F.vcu = (F.G % 8 == 0) ? (bx % 8) * (F.G / 8) + bx / 8 : bx; }
    unsigned char* ws = args.ws;
    F.ctl = (gu32*)(ws + WS_CTL);
    F.x = args.in[0]; F.c = args.in[1]; F.w_ada = args.in[2]; F.b_ada = args.in[3]; F.g_pre_mix = args.in[4]; F.g_post_mix = args.in[5]; F.g_pre_ffn = args.in[6]; F.g_post_ffn = args.in[7];
    F.w_in = args.in[8]; F.dec_f = args.in[9]; F.dec_b = args.in[10]; F.w_out = args.in[11]; F.w_router = args.in[12]; F.w_gate = args.in[13]; F.w_up = args.in[14]; F.w_down = args.in[15];
    F.out = args.out;
    F.MOD = (float*)(ws + WS_MOD); F.AFF = (float*)(ws + WS_AFF); F.GATEV = (float*)(ws + WS_GATEV); F.LSE = (float*)(ws + WS_LSE); F.KV = (float*)(ws + WS_KV); F.MIXED = (float*)(ws + WS_MIXED);
    F.TOK = (int*)(ws + WS_TOK); F.SLOTOF = (int*)(ws + WS_SLOTOF);
    F.WIN = (bf16*)(ws + WS_WIN); F.WOUT = (bf16*)(ws + WS_WOUT); F.WGU = (bf16*)(ws + WS_WGU); F.WDN = (bf16*)(ws + WS_WDN); F.XN = (bf16*)(ws + WS_XN); F.PROJ = (bf16*)(ws + WS_PROJ);
    F.PREV = (bf16*)(ws + WS_PREV); F.ATTO = (bf16*)(ws + WS_ATTO); F.Y = (bf16*)(ws + WS_Y); F.XE = (bf16*)(ws + WS_XE); F.HH = (bf16*)(ws + WS_HH); F.YE = (bf16*)(ws + WS_YE); F.MIXB = (bf16*)(ws + WS_MIXED); F.X1B = (bf16*)(ws + WS_Y);
    for (int u = F.tid; u < (LDS_BYTES - LDSCTL_OFF) / 4; u += NWAVES * 64) ((LAS unsigned*)(F.lds + LDSCTL_OFF))[u] = 0u;
    __syncthreads();
    if (F.tid < 2 * RH) F.MISC[16 + F.tid] = __float_as_uint(lg2_sigmoid((F.tid & 1) ? F.dec_b[F.tid >> 1] : F.dec_f[F.tid >> 1]));
    const int lo = args.ph_lo, hi = args.ph_hi;
    XcdBarrier bar; bar.bar = (unsigned*)(F.ctl + CW_BAR); bar.x = 0; bar.st = nullptr;
    if (hi - lo > 1) bar = xcd_barrier_post((unsigned*)(F.ctl + CW_BAR), F.MISC + 8);
#ifndef PHASE_MASK
#define PHASE_MASK 0xffff
#endif
#define IN(k) (((PHASE_MASK >> (k)) & 1) && lo <= (k) && (k) < hi)
#ifndef REP_MASK
#define REP_MASK 0
#endif
#define NREP(k) ((((REP_MASK) >> (k)) & 1) ? 2 : 1)
#ifndef TIME_PHASE
#define TIME_PHASE -1
#endif
#ifndef TIME_AMP
#define TIME_AMP 4
#endif
    unsigned long long t0_ = 0, t1_ = 0; int pos_ = 0;
#define TSTAMP() do { if (TIME_PHASE >= 0) { if (pos_ == TIME_PHASE) t0_ = rt_now(); if (pos_ == TIME_PHASE + 1) t1_ = rt_now(); } ++pos_; } while (0)
#define SEAM(k) do { if (IN(k) && IN((k) + 1)) xcd_barrier(bar); TSTAMP(); } while (0)
    TSTAMP();
    if (IN(0)) for (int rep_ = 0; rep_ < NREP(0); ++rep_) {
#if defined(TIME_SUB)
        const unsigned long long tks_ = rt_now();
#endif
        phase_p0a(F);
#if defined(TIME_SUB)
        if (TIME_SUB == 2) F.ts_b = rt_now(); if (TIME_SUB == 3) F.ts_a = rt_now();
        if (TIME_SUB == 4 && F.tid == 0) atomicMax((unsigned long long*)(F.ctl + 1216), rt_now() - tks_);
#endif
        if (F.tid == 0 && bar.st != nullptr && bar.st[0] == 0u) { unsigned nl_, nx_; xcd_barrier_complete(bar.bar, bar.x, nl_, nx_); bar.st[0] = nl_; bar.st[1] = nx_; }
        wait_counter(F, F.ctl + CW_MODCNT, 6 * DM / 32); phase_p0b(F);
#if defined(TIME_SUB)
        if (TIME_SUB == 3) F.ts_b = rt_now();
        if (TIME_SUB == 5 && F.tid == 0) atomicMax((unsigned long long*)(F.ctl + 1216), rt_now() - tks_);
#endif
    } SEAM(0);
    if (IN(2)) for (int rep_ = 0; rep_ < NREP(2); ++rep_) {
        const int bx_ = (int)blockIdx.x, xcd_ = bx_ & 7, slot_ = bx_ >> 3; const bool split_ = (F.G & 31) == 0;
        if (split_ && (slot_ & 3) == 3) phase_side_convert(F, (slot_ >> 2) * 8 + xcd_, F.G >> 2, CI_P0, CI_P0 + CI_DEFER);
        else {
            if (!split_) { phase_side_convert(F, F.vcu, F.G, CI_P0, CI_N); __syncthreads(); }
            const int Gg = split_ ? (F.G >> 2) * 3 : F.G, cg = split_ ? (slot_ - (slot_ >> 2)) * 8 + xcd_ : bx_;
            pg8::Gemm g{F.XN, F.WIN, MTOK, NPROJ, DM, 0}; pg8::StaticOrder S; S.init(MTOK, NPROJ, Gg, cg);
            pg8::EpiBf16S E{F.PROJ, NPROJ, 0xffff, 0.125f, 0.125f * LOG2E, 1};
            pg8::gemm_phase<pg8::EpiBf16S, pg8::StaticOrder, true, true>(F.lds, g, S, E);
        }
    } SEAM(2);
    if (IN(3)) for (int rep_ = 0; rep_ < NREP(3); ++rep_) {
        const int bx_ = (int)blockIdx.x, xcd_ = bx_ & 7, slot_ = bx_ >> 3; const bool split_ = (F.G & 31) == 0;
        if (split_ && (slot_ & 3) == 3) phase_side_convert(F, (slot_ >> 2) * 8 + xcd_, F.G >> 2, CI_P0 + CI_DEFER, CI_N);
        else if (split_) { const int G0 = F.G, v0 = F.vcu; F.G = (G0 >> 2) * 3; F.vcu = xcd_ * (F.G >> 3) + (slot_ - (slot_ >> 2)); phase_p2(F); F.G = G0; F.vcu = v0; }
        else phase_p2(F);
    } SEAM(3);
#if defined(DUP_P3A)
    if (IN(4)) { phase_p3a(F); asm volatile("" ::: "memory"); }
#endif
#if defined(DUP_P3B)
    if (IN(4)) { phase_p3b(F); asm volatile("" ::: "memory"); }
#endif
    bool rpre_ = false;
    if (IN(4)) for (int rep_ = 0; rep_ < NREP(4); ++rep_) { phase_p3a(F); phase_p3b(F); }
    if (IN(4) && IN(5) && F.vcu < NRETU) { xcd_barrier_retfront(bar, F, F.vcu); rpre_ = true; TSTAMP(); } else SEAM(4);
    if (IN(5)) for (int rep_ = 0; rep_ < NREP(5); ++rep_) { phase_p4(F, rpre_ && rep_ == 0); }
#ifdef PROBE_COPY_P4
    if (IN(5)) { asm volatile("" ::: "memory"); phase_p4(F, false); }
#endif
    SEAM(5);
    if (IN(6)) for (int rep_ = 0; rep_ < NREP(6); ++rep_) {
        pg8::Gemm g{F.Y, F.WOUT, MTOK, DM, DM / 2, DM}; pg8::StaticOrder S; S.init(MTOK, DM, F.G, (int)blockIdx.x);
        pg8::EpiBf16S E{F.MIXB, DM, 0xffff, 1.f, 1.f, 0};
        pg8::gemm_phase<pg8::EpiBf16S, pg8::StaticOrder, false, true, false, true>(F.lds, g, S, E, nullptr, nullptr, 0x7a7a7a7a, 0x7b7b7b7b);
    }
    bool p6pre_ = false;
    if (IN(6) && IN(7)) { xcd_barrier_p6fill(bar, F); p6pre_ = true; TSTAMP(); } else SEAM(6);
    if (IN(7)) for (int rep_ = 0; rep_ < NREP(7); ++rep_) { phase_p6(F, p6pre_ && rep_ == 0); } SEAM(7);
    if (IN(10)) for (int rep_ = 0; rep_ < NREP(10); ++rep_) {
        pg8::Gemm g{F.XN, F.WGU, NSLOT, NE * 2 * FF, DM / 2, 2 * FF}; pg8::MoeOrder S{16, F.G, F.vcu};
        bool ldsrows_ = false;
        { pg8::Unit uu; int last = -1, pend = -1, pendmt = -1, ndist_ = 0, nother_ = 0; bool pendw = false;
          const bool dist_ = (F.G == 256); const int cq_ = (F.vcu & 31) >> 3;
          for (int ui_ = 0; ui_ < 8; ++ui_) { if (!S.next(ui_, uu)) break; const int e_ = uu.pm >> 3, mt_ = uu.pm & 7, be_ = (mt_ >> 2) * NE + e_;
              if (be_ != last) { const bool wr_ = (mt_ & 3) == 0 && (uu.pn & 15) == 0; last = be_;
                  if (pend < 0) { pend = be_; pendw = wr_; pendmt = mt_; }
                  else { if (dist_ && (pendmt & 3) == (mt_ & 3)) { const int j_ = (mt_ & 3) * 4 + cq_; topk_pair2(F, pend, be_, mt_ & 3, cq_ == 0, 32 * j_, 32 * j_ + 32, 32 * j_, 32 * j_ + 32, false); ++ndist_; }
                         else { topk_pair2(F, pend, be_, -1, true, 0, pendw ? 512 : 0, 0, wr_ ? 512 : 0, true); nother_ = 1; }
                         pend = -1; } } }
          if (pend >= 0) { topk_pair(F, pend, pendw); nother_ = 1; }
          ldsrows_ = (ndist_ == 1 && nother_ == 0);
          if (!ldsrows_) asm volatile("s_waitcnt vmcnt(0)" ::: "memory");
          __syncthreads(); }
        pg8::EpiSwiGLU8 E{(unsigned char*)F.HH, FF};
        pg8::gemm_phase<pg8::EpiSwiGLU8, pg8::MoeOrder, true, true, true, true>(F.lds, g, S, E, F.TOK, (LAS int*)(F.lds + MISC_OFF + 256), 0x7a7a7a7a, 0x7f7f7f7f, ldsrows_ ? (const LAS int*)(F.lds + 16384) : nullptr);
    } SEAM(10);
    if (IN(11)) for (int rep_ = 0; rep_ < NREP(11); ++rep_) {
        pg8::Gemm g{F.HH, F.WDN, NSLOT, NE * DM, FF / 2, DM}; pg8::MoeOrder S{4, F.G, F.vcu};
        pg8::EpiFp8 E{(unsigned char*)F.YE, DM, 3};
        pg8::gemm_phase<pg8::EpiFp8, pg8::MoeOrder, true, true, false, true>(F.lds, g, S, E, nullptr, nullptr, 0x7a7a7a7a, 0x7f7f7f7f);
    } SEAM(11);
    if (IN(12)) for (int rep_ = 0; rep_ < NREP(12); ++rep_) { phase_p10(F); }
    if (TIME_PHASE >= 0) {
        __syncthreads(); TSTAMP();
        if (blockIdx.x == 0 && F.tid == 0) {
#if defined(TIME_SUB)
            t0_ = F.ts_a; t1_ = F.ts_b;
            if (TIME_SUB >= 4) { t0_ = 0; t1_ = __hip_atomic_load((unsigned long long*)(F.ctl + 1216), __ATOMIC_RELAXED, __HIP_MEMORY_SCOPE_AGENT); }
#endif
            const unsigned long long target = rt_now() + (unsigned long long)TIME_AMP * (t1_ - t0_);
            while (rt_now() < target) __builtin_amdgcn_s_sleep(8); }
    }
#undef IN
#undef SEAM
}

extern "C" void kernel_launch(void* const* d_in, const int* in_sizes, int n_in, void* d_out, int out_size, void* d_ws, size_t ws_size, hipStream_t stream) {
    static int grid = 0;
    if (grid == 0) {
        if (n_in != 16 || in_sizes[0] != MTOK * DM || out_size != MTOK * DM || ws_size < WS_END) { fprintf(stderr, "kernel_launch: unexpected shapes: n_in %d in0 %d out %d ws %zu (need %zu)\n", n_in, n_in > 0 ? in_sizes[0] : -1, out_size, ws_size, (size_t)WS_END); grid = -1; return; }
        int dev = 0, cus = 0;
        if (hipGetDevice(&dev) != hipSuccess || hipDeviceGetAttribute(&cus, hipDeviceAttributeMultiprocessorCount, dev) != hipSuccess) { grid = -1; return; }
        if (hipFuncSetAttribute((const void*)mk_fwd, hipFuncAttributeMaxDynamicSharedMemorySize, LDS_BYTES) != hipSuccess) { fprintf(stderr, "kernel_launch: hipFuncSetAttribute failed\n"); grid = -1; return; }
        int per_cu = 0;
        if (hipOccupancyMaxActiveBlocksPerMultiprocessor(&per_cu, (const void*)mk_fwd, NWAVES * 64, LDS_BYTES) != hipSuccess || per_cu < 1) fprintf(stderr, "kernel_launch: occupancy query says %d blocks per CU\n", per_cu);
        (void)hipGetLastError();
        grid = 1; while (grid * 2 <= cus && grid < 256) grid *= 2;
    }
    if (grid < 0) return;
    (void)hipMemsetAsync((char*)d_ws + WS_CTL, 0, CTL_ZERO_BYTES, stream);
    Args a{};
    for (int i = 0; i < 16; ++i) a.in[i] = (const float*)d_in[i];
    a.out = (float*)d_out; a.ws = (unsigned char*)d_ws;
#if MK_ONE_LAUNCH
    a.ph_lo = 0; a.ph_hi = NPHASE;
    hipLaunchKernelGGL(mk_fwd, dim3(grid), dim3(NWAVES * 64), LDS_BYTES, stream, a);
#else
    for (int p = 0; p < NPHASE; ++p) { a.ph_lo = p; a.ph_hi = p + 1; hipLaunchKernelGGL(mk_fwd, dim3(grid), dim3(NWAVES * 64), LDS_BYTES, stream, a); }
#endif
}
```
